# Optimizing an MI355X kernel written in HIP

```python
import math
import jax, jax.numpy as jnp
from jax import lax
import numpy as np

D_MODEL = 1024
BATCH = 8
SEQ = 2048
DEPTH = 2
DEC_BATCH = 128
DEC_SEQ = 4
PAST_LEN = 16384
PAGE_SIZE = 128

MIX_WIDTH = D_MODEL
RET_WIDTH = MIX_WIDTH // 2
CONV_WIDTH = MIX_WIDTH - RET_WIDTH
RET_HEADS = 4
RET_DK = RET_WIDTH // RET_HEADS
RET_DV = RET_WIDTH // RET_HEADS
RET_CHUNK = 128
ROPE_BASE = 10000.0
CONV_K = 31
IN_WIDTH = 4 * RET_WIDTH + 2 * CONV_WIDTH
PEER_HEADS = 8
N_KEYS = 128
N_EXPERTS = N_KEYS * N_KEYS
PEER_DQ = 256
PEER_TOPK = 16
PEER_BLOCK = 128
ALPHA = (2.0 * DEPTH) ** 0.25
BETA = (8.0 * DEPTH) ** -0.25
LN_EPS = 1e-5

kernel_name = "hymba_retnet_conformer_peer_step"


def layer_norm(x, g, b):
    xf = x.astype(jnp.float32)
    mu = jnp.mean(xf, axis=-1, keepdims=True)
    var = jnp.mean(jnp.square(xf - mu), axis=-1, keepdims=True)
    y = (xf - mu) * lax.rsqrt(var + LN_EPS)
    return (y * g.astype(jnp.float32) + b.astype(jnp.float32)).astype(x.dtype)


def head_norm(x):
    xf = x.astype(jnp.float32)
    mu = jnp.mean(xf, axis=-1, keepdims=True)
    var = jnp.mean(jnp.square(xf - mu), axis=-1, keepdims=True)
    return ((xf - mu) * lax.rsqrt(var + LN_EPS)).astype(x.dtype)


def rope_tables(pos, dtype):
    inv_freq = ROPE_BASE ** (-jnp.arange(0, RET_DK, 2, dtype=jnp.float32) / RET_DK)
    ang = pos.astype(jnp.float32)[:, None] * inv_freq[None, :]
    return jnp.cos(ang)[:, None, :].astype(dtype), jnp.sin(ang)[:, None, :].astype(dtype)


def apply_rope(t, cos, sin):
    t1, t2 = t[..., : RET_DK // 2], t[..., RET_DK // 2:]
    return jnp.concatenate([t1 * cos - t2 * sin, t1 * sin + t2 * cos], axis=-1)


def retention(q, k, v, r0, log_gamma):
    b, t, h, _ = q.shape
    c = min(t, RET_CHUNK)
    n = t // c
    dt = q.dtype
    qc = q.reshape(b, n, c, h, RET_DK)
    kc = k.reshape(b, n, c, h, RET_DK)
    vc = v.reshape(b, n, c, h, RET_DV)
    i = jnp.arange(c, dtype=jnp.float32)
    rel = i[:, None] - i[None, :]
    lg = log_gamma[:, None, None]
    dmask = jnp.where(rel >= 0, jnp.exp(jnp.maximum(rel, 0.0) * lg), 0.0).astype(dt)
    decay_in = jnp.exp((i[None, :] + 1.0) * log_gamma[:, None]).astype(dt)
    decay_out = jnp.exp((c - 1.0 - i[None, :]) * log_gamma[:, None]).astype(dt)
    chunk_decay = jnp.exp(c * log_gamma)[:, None, None].astype(dt)
    scores = jnp.einsum('bnihd,bnjhd->bnhij', qc, kc) * dmask
    o_intra = jnp.einsum('bnhij,bnjhe->bnihe', scores, vc)
    kv = jnp.einsum('bnjhd,bnjhe,hj->bnhde', kc, vc, decay_out)

    def step(r, kv_n):
        return chunk_decay * r + kv_n, r

    r_final, r_prev = lax.scan(step, r0, jnp.moveaxis(kv, 1, 0))
    r_prev = jnp.moveaxis(r_prev, 0, 1)
    o_cross = jnp.einsum('bnihd,bnhde,hi->bnihe', qc, r_prev, decay_in)
    return (o_intra + o_cross).reshape(b, t, h, RET_DV), r_final


def conformer_conv(ca, cg, buf, dw_kernel, dw_bias, ln_g, ln_b):
    u = ca * jax.nn.sigmoid(cg)
    xpad = jnp.concatenate([buf, u], axis=1)
    y = lax.conv_general_dilated(
        xpad, dw_kernel[:, None, :], window_strides=(1,), padding='VALID',
        dimension_numbers=('NWC', 'WIO', 'NWC'), feature_group_count=CONV_WIDTH) + dw_bias
    y = jax.nn.silu(layer_norm(y, ln_g, ln_b))
    return y, xpad[:, -(CONV_K - 1):]


def peer(x2d, w_query, sub_keys_1, sub_keys_2, peer_u, peer_v):
    t = x2d.shape[0]
    nb = -(-t // PEER_BLOCK)
    xp = jnp.pad(x2d, ((0, nb * PEER_BLOCK - t), (0, 0))).reshape(nb, PEER_BLOCK, D_MODEL)

    def block(xb):
        q = (xb @ w_query).reshape(PEER_BLOCK, PEER_HEADS, PEER_DQ)
        q1, q2 = q[..., : PEER_DQ // 2], q[..., PEER_DQ // 2:]
        s1 = jnp.einsum('phd,hkd->phk', q1, sub_keys_1)
        s2 = jnp.einsum('phd,hkd->phk', q2, sub_keys_2)
        v1, i1 = lax.top_k(s1, PEER_TOPK)
        v2, i2 = lax.top_k(s2, PEER_TOPK)
        cand = (v1[..., :, None] + v2[..., None, :]).reshape(PEER_BLOCK, PEER_HEADS, PEER_TOPK * PEER_TOPK)
        sv, ci = lax.top_k(cand, PEER_TOPK)
        e1 = jnp.take_along_axis(i1, ci // PEER_TOPK, axis=-1)
        e2 = jnp.take_along_axis(i2, ci % PEER_TOPK, axis=-1)
        idx = e1 * N_KEYS + e2
        gate = jax.nn.softmax(sv.astype(jnp.float32), axis=-1).astype(xb.dtype)
        u = jnp.take(peer_u, idx, axis=0)
        act = jax.nn.gelu(jnp.einsum('phkd,pd->phk', u, xb), approximate=False)
        vv = jnp.take(peer_v, idx, axis=0)
        return jnp.einsum('phk,phkd->pd', gate * act, vv)

    out = lax.map(block, xp)
    return out.reshape(nb * PEER_BLOCK, D_MODEL)[:t]


def decoder_layer(x, r0, buf, cos, sin, log_gamma, w_in, b_in, dw_kernel, dw_bias,
                  conv_ln_g, conv_ln_b, w_out, ln1_g, ln1_b, w_query, sub_keys_1,
                  sub_keys_2, peer_u, peer_v, ln2_g, ln2_b):
    b, t, _ = x.shape
    proj = jnp.einsum('btd,de->bte', x, w_in) + b_in
    q, k, v, g, ca, cg = jnp.split(proj, 6, axis=-1)
    q = apply_rope(q.reshape(b, t, RET_HEADS, RET_DK), cos, sin)
    k = apply_rope(k.reshape(b, t, RET_HEADS, RET_DK), cos, sin) * (RET_DK ** -0.5)
    v = v.reshape(b, t, RET_HEADS, RET_DV)
    o, r_new = retention(q, k, v, r0, log_gamma)
    ret_out = jax.nn.silu(g) * head_norm(o).reshape(b, t, RET_WIDTH)
    conv_out, buf_new = conformer_conv(ca, cg, buf, dw_kernel, dw_bias, conv_ln_g, conv_ln_b)
    mix = jnp.einsum('bte,ed->btd', jnp.concatenate([ret_out, conv_out], axis=-1), w_out)
    x = layer_norm(ALPHA * x + mix, ln1_g, ln1_b)
    ffn = peer(x.reshape(b * t, D_MODEL), w_query, sub_keys_1, sub_keys_2, peer_u, peer_v)
    x = layer_norm(ALPHA * x + ffn.reshape(b, t, D_MODEL), ln2_g, ln2_b)
    return x, r_new, buf_new


def setup_inputs(seed: int = 0) -> dict:
    key = jax.random.key(seed)
    ks = jax.random.split(key, 24)

    def nrm(k, shape, scale):
        return jax.random.normal(k, shape, jnp.float32) * scale

    s_in = D_MODEL ** -0.5
    w_in = jnp.concatenate([
        nrm(ks[0], (DEPTH, D_MODEL, RET_WIDTH), s_in),
        nrm(ks[1], (DEPTH, D_MODEL, RET_WIDTH), s_in),
        nrm(ks[2], (DEPTH, D_MODEL, RET_WIDTH), s_in * BETA),
        nrm(ks[3], (DEPTH, D_MODEL, RET_WIDTH), s_in),
        nrm(ks[4], (DEPTH, D_MODEL, CONV_WIDTH), s_in),
        nrm(ks[5], (DEPTH, D_MODEL, CONV_WIDTH), s_in),
    ], axis=-1)
    return {
        "x_prompt": nrm(ks[6], (BATCH, SEQ, D_MODEL), 1.0),
        "x_sample": nrm(ks[7], (DEC_BATCH, DEC_SEQ, D_MODEL), 1.0),
        "state_retention": nrm(ks[8], (DEPTH, DEC_BATCH, RET_HEADS, RET_DK, RET_DV), 0.3),
        "cache_conv": nrm(ks[9], (DEPTH, DEC_BATCH, CONV_K - 1, CONV_WIDTH), 0.5),
        "w_in": w_in,
        "b_in": nrm(ks[10], (DEPTH, IN_WIDTH), 0.02),
        "dw_kernel": nrm(ks[11], (DEPTH, CONV_K, CONV_WIDTH), CONV_K ** -0.5),
        "dw_bias": nrm(ks[12], (DEPTH, CONV_WIDTH), 0.02),
        "conv_ln_g": 1.0 + nrm(ks[13], (DEPTH, CONV_WIDTH), 0.02),
        "conv_ln_b": nrm(ks[14], (DEPTH, CONV_WIDTH), 0.02),
        "w_out": nrm(ks[15], (DEPTH, MIX_WIDTH, D_MODEL), MIX_WIDTH ** -0.5 * BETA),
        "ln1_g": 1.0 + nrm(ks[16], (DEPTH, D_MODEL), 0.02),
        "ln1_b": nrm(ks[17], (DEPTH, D_MODEL), 0.02),
        "w_query": nrm(ks[18], (DEPTH, D_MODEL, PEER_HEADS * PEER_DQ), s_in),
        "sub_keys_1": nrm(ks[19], (DEPTH, PEER_HEADS, N_KEYS, PEER_DQ // 2), (PEER_DQ // 2) ** -0.5),
        "sub_keys_2": nrm(ks[20], (DEPTH, PEER_HEADS, N_KEYS, PEER_DQ // 2), (PEER_DQ // 2) ** -0.5),
        "peer_u": nrm(ks[21], (DEPTH, N_EXPERTS, D_MODEL), s_in),
        "peer_v": nrm(ks[22], (DEPTH, N_EXPERTS, D_MODEL), BETA * PEER_HEADS ** -0.5),
        "ln2_g": 1.0 + nrm(ks[23], (DEPTH, D_MODEL), 0.02),
        "ln2_b": nrm(jax.random.fold_in(key, 99), (DEPTH, D_MODEL), 0.02),
    }


def reference(x_prompt, x_sample, state_retention, cache_conv, w_in, b_in, dw_kernel,
              dw_bias, conv_ln_g, conv_ln_b, w_out, ln1_g, ln1_b, w_query, sub_keys_1,
              sub_keys_2, peer_u, peer_v, ln2_g, ln2_b):
    dt = x_prompt.dtype
    log_gamma = jnp.log(1.0 - 2.0 ** (-5.0 - jnp.arange(RET_HEADS, dtype=jnp.float32)))
    cos_p, sin_p = rope_tables(jnp.arange(x_prompt.shape[1]), dt)
    cos_s, sin_s = rope_tables(PAST_LEN + jnp.arange(x_sample.shape[1]), dt)
    bp = x_prompt.shape[0]
    yp, ys = x_prompt, x_sample
    ret_p, conv_p, ret_s, conv_s = [], [], [], []
    for l in range(DEPTH):
        params = (w_in[l], b_in[l], dw_kernel[l], dw_bias[l], conv_ln_g[l], conv_ln_b[l],
                  w_out[l], ln1_g[l], ln1_b[l], w_query[l], sub_keys_1[l], sub_keys_2[l],
                  peer_u[l], peer_v[l], ln2_g[l], ln2_b[l])
        r0 = jnp.zeros((bp, RET_HEADS, RET_DK, RET_DV), dt)
        buf0 = jnp.zeros((bp, CONV_K - 1, CONV_WIDTH), dt)
        yp, rp, cp = decoder_layer(yp, r0, buf0, cos_p, sin_p, log_gamma, *params)
        ys, rs, cs = decoder_layer(ys, state_retention[l], cache_conv[l], cos_s, sin_s, log_gamma, *params)
        ret_p.append(rp)
        conv_p.append(cp)
        ret_s.append(rs)
        conv_s.append(cs)
    return (yp, ys, jnp.stack(ret_p), jnp.stack(conv_p), jnp.stack(ret_s), jnp.stack(conv_s))
```

```cpp
#include <hip/hip_runtime.h>
#include <cstdio>
#include <cstdint>
#define MK_PER_PHASE 1
namespace pg8 {
#define PG8_LAS __attribute__((address_space(3)))
typedef unsigned short bf16_t;
typedef short bf16x8 __attribute__((ext_vector_type(8)));
typedef float f32x4 __attribute__((ext_vector_type(4)));
typedef unsigned u32x4 __attribute__((ext_vector_type(4)));
constexpr int BM = 256, BK = 64, HALF = 128, HTB = HALF * BK * 2  , STAGE_BYTES = 8 * HTB, NXCD = 8, WGM = 8;

__host__ __device__ __forceinline__ int lds_byte(int r, int c) { const int st = (r >> 4) * 2 + (c >> 5), rr = r & 15, cc = c & 31, ob = rr * 64 + cc * 2; return st * 1024 + (ob ^ (((ob >> 9) & 1) << 5)); }
__host__ __device__ __forceinline__ void stage_rc(int b, int& R, int& C) { const int st = b / 1024, sb = b % 1024, swz = sb ^ (((sb >> 9) & 1) << 5); R = (st >> 1) * 16 + swz / 64; C = (st & 1) * 32 + (swz % 64) / 2; }
__host__ __device__ __forceinline__ int perm32(int rho) { const int n = rho >> 4, i = rho & 15; return 8 * (i >> 2) + 4 * n + (i & 3); }

struct Unit { int pm, pn; };
struct Gemm { const bf16_t* A; const bf16_t* Bt; int M, N, K; };

struct StaticOrder {
    int nM, nN, nwg, G, c;
    __host__ __device__ void init(int M, int N, int G_, int c_) { nM = M / BM; nN = N / BM; nwg = nM * nN; G = G_; c = c_; }
    __host__ __device__ bool next(int i, Unit& u) const {
        const long L = (long)i * G + c; if (L >= nwg) return false;
        int wgid = (int)L; { const int q = nwg / NXCD, r = nwg % NXCD, xcd = wgid % NXCD, off = wgid / NXCD; wgid = (xcd < r ? xcd * (q + 1) : r * (q + 1) + (xcd - r) * q) + off; }
        const int nig = WGM * nN, gid = wgid / nig, fm = gid * WGM, gsz = (nM - fm) < WGM ? (nM - fm) : WGM;
        u.pm = fm + ((wgid % nig) % gsz); u.pn = (wgid % nig) / gsz; return true;
    }
    __device__ __forceinline__ void a_ready(const Unit&) const {}
    __device__ __forceinline__ void done(const Unit&) const {}
};

__device__ __forceinline__ unsigned cvt_pk_bf16(float lo, float hi) { unsigned r; asm volatile("v_cvt_pk_bf16_f32 %0, %1, %2" : "=v"(r) : "v"(lo), "v"(hi)); return r; }
typedef float f32x2 __attribute__((ext_vector_type(2)));
__device__ __forceinline__ f32x2 gelu_pk(f32x2 v) {
    const f32x2 av = __builtin_elementwise_abs(v), d = av * 0.2316418882f + 1.0f;
    f32x2 t; t.x = __builtin_amdgcn_rcpf(d.x); t.y = __builtin_amdgcn_rcpf(d.y);
    f32x2 q = t * 0.5307027145f + (-0.7265760135f); q = q * t + 0.7107068705f; q = q * t + (-0.142248368f); q = q * t + 0.127414796f; q = q * t;
    const f32x2 s = (v * v) * (-0.72134752044f);
    f32x2 e; e.x = __builtin_amdgcn_exp2f(s.x); e.y = __builtin_amdgcn_exp2f(s.y);
    const f32x2 m = v * (q * e), r = v - m;
    f32x2 o; o.x = v.x < 0.f ? m.x : r.x; o.y = v.y < 0.f ? m.y : r.y; return o;
}

template <int ACT  > struct EpiBf16 {
    static constexpr bool PERM = true, AFTER_DRAIN = false; static_assert(ACT == 0 || ACT == 1, "EpiBf16: ACT is 0 (none) or 1 (gelu_pk)");
    bf16_t* O; int ldc; const float* bias; int split_cols; size_t split_stride; float scale0;
    __device__ __forceinline__ void operator()(const f32x4 (&acc)[2][2][4][2], const Unit& u, int wr, int wc, int fr, int fq) const {
        const int row0 = u.pm * BM + wr * 64 + fr; int colt = u.pn * BM; bf16_t* base = O;
        float sc = 1.f; if (split_cols) { const int t = colt / split_cols; base += (size_t)t * split_stride; colt -= t * split_cols; if (t == 0) sc = scale0; }
        const int col0 = colt + wc * 32 + 8 * fq, bcol0 = u.pn * BM + wc * 32 + 8 * fq;
        f32x4 bv[2][2];
#pragma unroll
        for (int bj = 0; bj < 2; ++bj)
#pragma unroll
            for (int n = 0; n < 2; ++n) bv[bj][n] = bias ? *(const f32x4*)(bias + bcol0 + bj * HALF + 4 * n) : (f32x4){0.f, 0.f, 0.f, 0.f};
#pragma unroll
        for (int ai = 0; ai < 2; ++ai)
#pragma unroll
            for (int m = 0; m < 4; ++m) { bf16_t* rowp = base + (size_t)(row0 + ai * HALF + m * 16) * ldc + col0;
#pragma unroll
                for (int bj = 0; bj < 2; ++bj) { f32x4 v0 = acc[ai][bj][m][0] + bv[bj][0], v1 = acc[ai][bj][m][1] + bv[bj][1];
                    if (ACT == 1) { f32x2 a = gelu_pk((f32x2){v0[0], v0[1]}), b = gelu_pk((f32x2){v0[2], v0[3]}), c = gelu_pk((f32x2){v1[0], v1[1]}), d = gelu_pk((f32x2){v1[2], v1[3]});
                        v0 = (f32x4){a.x, a.y, b.x, b.y}; v1 = (f32x4){c.x, c.y, d.x, d.y}; }
                    v0 = v0 * sc; v1 = v1 * sc; u32x4 w; w.x = cvt_pk_bf16(v0[0], v0[1]); w.y = cvt_pk_bf16(v0[2], v0[3]); w.z = cvt_pk_bf16(v1[0], v1[1]); w.w = cvt_pk_bf16(v1[2], v1[3]);
                    *(u32x4*)(rowp + bj * HALF) = w; } }
    }
};


template <class Epi, class Sched, bool ALIGN_EPI = false, bool SP2 = false>
__device__ __forceinline__ void gemm_phase(PG8_LAS unsigned char* lds, const Gemm g, const Sched& S, const Epi& E, const int tid) {
    const int wid = __builtin_amdgcn_readfirstlane(tid >> 6), lane = tid & 63, wr = wid >> 2, wc = wid & 3, fr = lane & 15, fq = lane >> 4;
    const int K = g.K, nt = K / BK;
    unsigned voffA[2], voffB[2];
#pragma unroll
    for (int i = 0; i < 2; ++i) { int R, C; stage_rc(tid * 16 + i * 8192, R, C); const int Rb = Epi::PERM ? ((R & ~31) + perm32(R & 31)) : R;
        voffA[i] = (unsigned)(R * K + C) * 2u; voffB[i] = (unsigned)(Rb * K + C) * 2u; }
    const size_t kstep = (size_t)(BK * 2);
    const size_t hstep = (size_t)HALF * K * 2;
    const size_t tstep = 2 * hstep;
    const unsigned ldsw = (unsigned)wid * 1024u;
    const int aoff = lds_byte(wr * 64 + fr, fq * 8), boff = lds_byte(wc * 32 + fr, fq * 8);
#define PG8_SA(b, h) (((b) * 2 + (h)) * HTB)
#define PG8_SB(b, h) ((4 + (b) * 2 + (h)) * HTB)
#define PG8_STAGE(bufoff, gbase, voff) do { _Pragma("unroll") for (int _i = 0; _i < 2; ++_i) \
        __builtin_amdgcn_global_load_lds((const unsigned*)((const char*)(gbase) + (voff)[_i]), (PG8_LAS unsigned*)(lds + (bufoff) + ldsw + _i * 8192), 16, 0, 0); } while (0)
#define PG8_LDA(dst, b, h) do { _Pragma("unroll") for (int m = 0; m < 4; ++m) _Pragma("unroll") for (int k = 0; k < 2; ++k) dst[m][k] = *(const PG8_LAS bf16x8*)(lds + PG8_SA(b, h) + aoff + m * 2048 + k * 1024); } while (0)
#define PG8_LDB(dst, b, h) do { _Pragma("unroll") for (int n = 0; n < 2; ++n) _Pragma("unroll") for (int k = 0; k < 2; ++k) dst[n][k] = *(const PG8_LAS bf16x8*)(lds + PG8_SB(b, h) + boff + n * 2048 + k * 1024); } while (0)
#define PG8_MMA(ai, bj, At, Bt) do { __builtin_amdgcn_s_setprio(1); _Pragma("unroll") for (int m = 0; m < 4; ++m) _Pragma("unroll") for (int n = 0; n < 2; ++n) _Pragma("unroll") for (int k = 0; k < 2; ++k) \
        acc[ai][bj][m][n] = __builtin_amdgcn_mfma_f32_16x16x32_bf16(Bt[n][k], At[m][k], acc[ai][bj][m][n], 0, 0, 0); __builtin_amdgcn_s_setprio(0); } while (0)
#define PG8_WAIT_V(n) asm volatile("s_waitcnt vmcnt(" #n ")" ::: "memory")
#define PG8_WAIT_L(n) asm volatile("s_waitcnt lgkmcnt(" #n ")" ::: "memory")
#define PG8_BAR __builtin_amdgcn_s_barrier()
#define PG8_SCHED __builtin_amdgcn_sched_barrier(0)
    Unit cur, nxt; int ui = 0;
    if (!S.next(0, cur)) return;
    f32x4 acc[2][2][4][2];
#pragma unroll
    for (int a = 0; a < 2; ++a)
#pragma unroll
        for (int b = 0; b < 2; ++b)
#pragma unroll
            for (int m = 0; m < 4; ++m)
#pragma unroll
                for (int n = 0; n < 2; ++n) acc[a][b][m][n] = (f32x4){0.f, 0.f, 0.f, 0.f};
    bf16x8 At[4][2], B0[2][2], B1[2][2];
    const char* cA = (const char*)g.A + (size_t)cur.pm * tstep; const char* cB = (const char*)g.Bt + (size_t)cur.pn * tstep;
    S.a_ready(cur);
    if constexpr (SP2) {
        PG8_STAGE(PG8_SB(0, 0), cB, voffB); PG8_STAGE(PG8_SB(0, 1), cB + hstep, voffB); PG8_STAGE(PG8_SA(0, 0), cA, voffA); PG8_STAGE(PG8_SA(0, 1), cA + hstep, voffA);
        if (wr == 1) PG8_BAR;
        PG8_WAIT_V(2); PG8_BAR;
        PG8_STAGE(PG8_SB(1, 0), cB + kstep, voffB); PG8_STAGE(PG8_SA(1, 0), cA + kstep, voffA); PG8_STAGE(PG8_SB(1, 1), cB + hstep + kstep, voffB);
        PG8_WAIT_V(6); PG8_BAR;
    } else {
        PG8_STAGE(PG8_SB(0, 0), cB, voffB); PG8_STAGE(PG8_SA(0, 0), cA, voffA); PG8_STAGE(PG8_SB(0, 1), cB + hstep, voffB); PG8_STAGE(PG8_SA(0, 1), cA + hstep, voffA);
        if (wr == 1) PG8_BAR;
        PG8_WAIT_V(4); PG8_BAR;
        PG8_STAGE(PG8_SB(1, 0), cB + kstep, voffB); PG8_STAGE(PG8_SA(1, 0), cA + kstep, voffA); PG8_STAGE(PG8_SB(1, 1), cB + hstep + kstep, voffB);
        PG8_WAIT_V(6); PG8_BAR;
    }
    for (;;) {
        const bool has_next = S.next(ui + 1, nxt);
        const char* nA = has_next ? (const char*)g.A + (size_t)nxt.pm * tstep : cA; const char* nB = has_next ? (const char*)g.Bt + (size_t)nxt.pn * tstep : cB;
        for (int t = 0; t < nt; t += 2) {
            const bool last = (t == nt - 2);
            const char* a1 = cA + (size_t)(t + 1) * kstep;
            const char* a2 = last ? nA : cA + (size_t)(t + 2) * kstep; const char* b2 = last ? nB : cB + (size_t)(t + 2) * kstep;
            const char* a3 = a2 + kstep; const char* b3 = b2 + kstep;
            if (last && has_next) S.a_ready(nxt);
            if constexpr (SP2) {
            PG8_LDB(B0, 0, 0); PG8_LDB(B1, 0, 1); PG8_SCHED; PG8_LDA(At, 0, 0); PG8_STAGE(PG8_SA(1, 1), a1 + hstep, voffA);
            PG8_WAIT_V(8); PG8_WAIT_L(0); PG8_BAR; PG8_MMA(0, 0, At, B0); PG8_MMA(0, 1, At, B1); PG8_BAR; PG8_SCHED;
            PG8_LDA(At, 0, 1); PG8_STAGE(PG8_SB(0, 0), b2, voffB); PG8_STAGE(PG8_SB(0, 1), b2 + hstep, voffB); PG8_STAGE(PG8_SA(0, 0), a2, voffA);
            PG8_WAIT_V(8); PG8_WAIT_L(0); PG8_BAR; PG8_MMA(1, 0, At, B0); PG8_MMA(1, 1, At, B1); PG8_BAR; PG8_SCHED;
            PG8_LDB(B0, 1, 0); PG8_LDB(B1, 1, 1); PG8_SCHED; PG8_LDA(At, 1, 0); PG8_STAGE(PG8_SA(0, 1), a2 + hstep, voffA);
            PG8_WAIT_V(8); PG8_WAIT_L(0); PG8_BAR; PG8_MMA(0, 0, At, B0); PG8_MMA(0, 1, At, B1); PG8_BAR; PG8_SCHED;
            PG8_LDA(At, 1, 1); PG8_STAGE(PG8_SB(1, 0), b3, voffB); PG8_STAGE(PG8_SB(1, 1), b3 + hstep, voffB); PG8_STAGE(PG8_SA(1, 0), a3, voffA);
            PG8_WAIT_V(8); PG8_WAIT_L(0); PG8_BAR; PG8_MMA(1, 0, At, B0); PG8_MMA(1, 1, At, B1); PG8_BAR; PG8_SCHED;
            } else {
            PG8_LDB(B0, 0, 0); PG8_SCHED; PG8_LDA(At, 0, 0); PG8_STAGE(PG8_SA(1, 1), a1 + hstep, voffA);
            PG8_WAIT_L(8); PG8_BAR; PG8_WAIT_L(0); PG8_MMA(0, 0, At, B0); PG8_BAR; PG8_SCHED;
            PG8_LDB(B1, 0, 1); PG8_STAGE(PG8_SB(0, 0), b2, voffB);
            PG8_BAR; PG8_WAIT_L(0); PG8_MMA(0, 1, At, B1); PG8_BAR;
            PG8_LDA(At, 0, 1); PG8_STAGE(PG8_SA(0, 0), a2, voffA);
            PG8_BAR; PG8_WAIT_L(0); PG8_MMA(1, 0, At, B0); PG8_BAR; PG8_SCHED;
            PG8_STAGE(PG8_SB(0, 1), b2 + hstep, voffB);
            PG8_WAIT_V(6); PG8_BAR; PG8_MMA(1, 1, At, B1); PG8_BAR;
            PG8_LDB(B0, 1, 0); PG8_SCHED; PG8_LDA(At, 1, 0); PG8_STAGE(PG8_SA(0, 1), a2 + hstep, voffA);
            PG8_WAIT_L(8); PG8_BAR; PG8_WAIT_L(0); PG8_MMA(0, 0, At, B0); PG8_BAR; PG8_SCHED;
            PG8_LDB(B1, 1, 1); PG8_STAGE(PG8_SB(1, 0), b3, voffB);
            PG8_BAR; PG8_WAIT_L(0); PG8_MMA(0, 1, At, B1); PG8_BAR;
            PG8_LDA(At, 1, 1); PG8_STAGE(PG8_SA(1, 0), a3, voffA);
            PG8_BAR; PG8_WAIT_L(0); PG8_MMA(1, 0, At, B0); PG8_BAR; PG8_SCHED;
            PG8_STAGE(PG8_SB(1, 1), b3 + hstep, voffB);
            PG8_WAIT_V(6); PG8_BAR; PG8_MMA(1, 1, At, B1); PG8_BAR;
            }
        }
        if constexpr (ALIGN_EPI) { if (wr == 0) PG8_BAR; }
        if constexpr (!Epi::AFTER_DRAIN) { E(acc, cur, wr, wc, fr, fq); S.done(cur); }
        if (!has_next) break;
#pragma unroll
        for (int a = 0; a < 2; ++a)
#pragma unroll
            for (int b = 0; b < 2; ++b)
#pragma unroll
                for (int m = 0; m < 4; ++m)
#pragma unroll
                    for (int n = 0; n < 2; ++n) acc[a][b][m][n] = (f32x4){0.f, 0.f, 0.f, 0.f};
        cur = nxt; cA = nA; cB = nB; ++ui;
        if constexpr (ALIGN_EPI) { if (wr == 1) PG8_BAR; }
    }
    PG8_WAIT_V(0);
    if constexpr (!ALIGN_EPI) { if (wr == 0) PG8_BAR; }
    PG8_BAR;
    if constexpr (Epi::AFTER_DRAIN) { E.fused(acc, cur, wr, wc, fr, fq, lds, wid, lane); S.done(cur); }
#undef PG8_SA
#undef PG8_SB
#undef PG8_STAGE
#undef PG8_LDA
#undef PG8_LDB
#undef PG8_MMA
#undef PG8_WAIT_V
#undef PG8_WAIT_L
#undef PG8_BAR
#undef PG8_SCHED
}
}
#define GAS __attribute__((address_space(1)))
#define LAS __attribute__((address_space(3)))
typedef unsigned short bf16;
typedef unsigned v4u __attribute__((ext_vector_type(4)));
typedef float f32x4 __attribute__((ext_vector_type(4)));
typedef short bf16x8 __attribute__((ext_vector_type(8)));
typedef GAS unsigned gu32;
typedef GAS unsigned long long gu64;
#define RLX_AGENT __ATOMIC_RELAXED, __HIP_MEMORY_SCOPE_AGENT
#define LDS_WAIT() asm volatile("s_waitcnt lgkmcnt(0)" ::: "memory")
#define VM_WAIT() asm volatile("s_waitcnt vmcnt(0)" ::: "memory")
__device__ __forceinline__ unsigned long long rt() { return __builtin_amdgcn_s_memrealtime(); }
__device__ __forceinline__ unsigned f2bf(float f) { unsigned u = __builtin_bit_cast(unsigned, f); return (u + 0x7fffu + ((u >> 16) & 1u)) >> 16; }
__device__ __forceinline__ unsigned pk2(float lo, float hi) { return f2bf(lo) | (f2bf(hi) << 16); }

#define XB_TMO      128
#define XB_XCNT(j)  (256  + 64 * (j))
#define XB_XSUB(j)  (1280 + 64 * (j))
#define XB_XGEN(j)  (2304 + 64 * (j))
#define XB_TOP      3328
#define XB_TOPGEN   3392
#define XCD_BAR_WORDS 3456
#define XB_SPIN_CAP (1u << 18)

__device__ __forceinline__ unsigned xb_ld(unsigned* p)              { return __hip_atomic_load(p, __ATOMIC_RELAXED, __HIP_MEMORY_SCOPE_AGENT); }
__device__ __forceinline__ unsigned xb_add(unsigned* p, unsigned v) { return __hip_atomic_fetch_add(p, v, __ATOMIC_RELAXED, __HIP_MEMORY_SCOPE_AGENT); }
__device__ __forceinline__ unsigned xb_xcc_id() { return (unsigned)__builtin_amdgcn_s_getreg((3 << 11) | 20) & 0xFu; }
#define XB_SPIN(cond, bar) do { unsigned _sp = 0; while (cond) { __builtin_amdgcn_s_sleep(1); \
    if ((++_sp & 255u) == 0u) { if (xb_ld(&(bar)[XB_TMO])) break; if (_sp > XB_SPIN_CAP) { atomicAdd(&(bar)[XB_TMO], 1u); break; } } } } while (0)

struct XcdBarrier {
    unsigned* bar; unsigned x;
    volatile LAS unsigned* st;
};

__device__ __forceinline__ XcdBarrier xcd_barrier_post(unsigned* bar, volatile LAS unsigned* st) {
    XcdBarrier b; b.bar = bar; b.x = xb_xcc_id(); b.st = st;
    if (threadIdx.x == 0) (void)xb_add(&bar[XB_XCNT(b.x)], 1u);
    return b;
}
__device__ __forceinline__ void xcd_barrier_complete(unsigned* bar, unsigned x, unsigned& nloc, unsigned& nx) {
    const unsigned G = gridDim.x * gridDim.y * gridDim.z;
    unsigned sum, cnt, mine, sp = 0u;
    for (;;) {
        sum = 0u; cnt = 0u; mine = 0u;
#pragma unroll
        for (unsigned j = 0; j < 16; ++j) { const unsigned c = xb_ld(&bar[XB_XCNT(j)]); sum += c; cnt += (c > 0u) ? 1u : 0u; mine = (j == x) ? c : mine; }
        if (sum == G) break;
        __builtin_amdgcn_s_sleep(1);
        if ((++sp & 255u) == 0u) { if (xb_ld(&bar[XB_TMO])) break; if (sp > XB_SPIN_CAP) { atomicAdd(&bar[XB_TMO], 1u); break; } }
    }
    nloc = mine > 0u ? mine : 1u; nx = cnt > 0u ? cnt : 1u;
}

__device__ __forceinline__ void xcd_barrier(const XcdBarrier& b) {
    asm volatile("s_waitcnt vmcnt(0)" ::: "memory");
    __syncthreads();
    if (threadIdx.x == 0) {
        unsigned* bar = b.bar;
        __builtin_amdgcn_s_waitcnt(0);
        unsigned nloc = b.st[0], nx = b.st[1];
        if (nloc == 0u) { xcd_barrier_complete(bar, b.x, nloc, nx); b.st[0] = nloc; b.st[1] = nx; }
        const unsigned old = xb_add(&bar[XB_XSUB(b.x)], 1u);
        const unsigned gen = old / nloc;
        if (old + 1u == (gen + 1u) * nloc) {
            __builtin_amdgcn_fence(__ATOMIC_RELEASE, "agent");
            asm volatile("s_waitcnt vmcnt(0)" ::: "memory");
            const unsigned og = xb_add(&bar[XB_TOP], 1u);
            const unsigned tg = og / nx;
            if (og + 1u == (tg + 1u) * nx) xb_add(&bar[XB_TOPGEN], 1u);
            else XB_SPIN(xb_ld(&bar[XB_TOPGEN]) == tg, bar);
            __builtin_amdgcn_fence(__ATOMIC_ACQUIRE, "agent");
            xb_add(&bar[XB_XGEN(b.x)], 1u);
            asm volatile("s_waitcnt vmcnt(0)" ::: "memory");
        } else {
            XB_SPIN(xb_ld(&bar[XB_XGEN(b.x)]) == gen, bar);
            __builtin_amdgcn_fence(__ATOMIC_ACQUIRE, "agent");
            asm volatile("s_waitcnt vmcnt(0)" ::: "memory");
        }
    }
    __syncthreads();
}
#ifndef PG8_SP2
#define PG8_SP2 true
#endif
#ifndef PG8_ALIGN
#define PG8_ALIGN true
#endif
#ifndef DIS
#define DIS 0
#endif
#define EN(k) (!((DIS >> (k)) & 1))
#ifndef MK_PER_PHASE
#define MK_PER_PHASE 0
#endif

constexpr int NWAVES = 8, NTHR = 512;
constexpr int D = 1024, TP = 16384, TS = 512, T = TP + TS, NL = 2;
constexpr int INW = 3072, RW = 512;
constexpr int PHD = 8, NSEL = 128;
constexpr float ALPHA = 1.4142135623730951f, LN_EPS = 1e-5f;
constexpr int N_PHASES = 17;
constexpr size_t O_YP = 0, O_YS = 16777216, O_SRP = 17301504, O_CCP = 18350080, O_SRS = 18595840, O_CCS = 35373056, O_END = 39305216;
constexpr size_t MiB = 1u << 20;
constexpr size_t WS_CTL = 0, CTL_ZERO_BYTES = 1 * MiB;
constexpr size_t WS_ROPE = 1 * MiB;
constexpr size_t WS_WIN = 4 * MiB, WS_WOUT = 16 * MiB, WS_WQ = 20 * MiB, WS_KEYS = 28 * MiB;
constexpr size_t WS_UB = 32 * MiB, WS_VB = 96 * MiB;
constexpr size_t WS_XB = 160 * MiB, WS_XF = 194 * MiB;
constexpr size_t WS_Q = 260 * MiB, WS_K = 277 * MiB, WS_V = 294 * MiB, WS_G = 311 * MiB, WS_U = 328 * MiB;
constexpr size_t WS_KV = 345 * MiB, WS_A2 = 377 * MiB, WS_Z1 = 411 * MiB, WS_X1B = 477 * MiB, WS_END = 511 * MiB;
constexpr size_t WS_QP = 260 * MiB;
constexpr size_t WS_RI = 345 * MiB, WS_RG = 354 * MiB;
constexpr int CW_BAR = 4096;
constexpr int RING_BYTES = 131072, LDSCTL_OFF = 139264, MISC_OFF = LDSCTL_OFF + 320, LDS_BYTES = 147456;
constexpr int PST = 272;

typedef float v4f __attribute__((ext_vector_type(4)));
typedef unsigned v2u __attribute__((ext_vector_type(2)));
typedef float f32x16 __attribute__((ext_vector_type(16)));

__device__ __forceinline__ float bflo(unsigned w) { return __uint_as_float(w << 16); }
__device__ __forceinline__ float bfhi(unsigned w) { return __uint_as_float(w & 0xffff0000u); }
__device__ __forceinline__ float bf2f(bf16 b) { return __uint_as_float((unsigned)b << 16); }
__device__ __forceinline__ float wave_sum(float v) {
#pragma unroll
    for (int o = 1; o < 64; o <<= 1) v += __shfl_xor(v, o);
    return v;
}
__device__ __forceinline__ float silu_f(float x) { return x / (1.f + __expf(-x)); }
__device__ __forceinline__ float l2gamma(int h) { return h == 0 ? -0.04580368961312479f : h == 1 ? -0.02272007650008353f : h == 2 ? -0.011315313227834146f : -0.005646563141142063f; }
__device__ __forceinline__ void unpack8(const v4u w, float (&f)[8]) {
    f[0] = bflo(w.x); f[1] = bfhi(w.x); f[2] = bflo(w.y); f[3] = bfhi(w.y); f[4] = bflo(w.z); f[5] = bfhi(w.z); f[6] = bflo(w.w); f[7] = bfhi(w.w);
}
__device__ __forceinline__ v4u pack8(const float (&f)[8]) { v4u w; w.x = pk2(f[0], f[1]); w.y = pk2(f[2], f[3]); w.z = pk2(f[4], f[5]); w.w = pk2(f[6], f[7]); return w; }

__device__ const double INV_FREQ[64] = {
1.0, 0.8659643233600653, 0.7498942093324559, 0.6493816315762113, 0.5623413251903491, 0.4869675251658631, 0.4216965034285822, 0.3651741272548377, 0.31622776601683794, 0.27384196342643613, 0.23713737056616552, 0.2053525026457146, 0.1778279410038923, 0.1539926526059492, 0.1333521432163324, 0.11547819846894582, 0.1, 0.08659643233600653, 0.07498942093324558, 0.06493816315762113, 0.05623413251903491, 0.04869675251658631, 0.042169650342858224, 0.03651741272548377, 0.03162277660168379, 0.027384196342643614, 0.023713737056616554, 0.02053525026457146, 0.01778279410038923, 0.01539926526059492, 0.01333521432163324, 0.011547819846894581, 0.01, 0.008659643233600654, 0.007498942093324558, 0.006493816315762113, 0.005623413251903491, 0.004869675251658631, 0.004216965034285823, 0.003651741272548377, 0.0031622776601683794, 0.0027384196342643613, 0.0023713737056616554, 0.002053525026457146, 0.0017782794100389228, 0.001539926526059492, 0.001333521432163324, 0.0011547819846894581, 0.001, 0.0008659643233600654, 0.0007498942093324559, 0.0006493816315762113, 0.0005623413251903491, 0.0004869675251658631, 0.00042169650342858224, 0.0003651741272548377, 0.00031622776601683794, 0.0002738419634264361, 0.00023713737056616554, 0.0002053525026457146, 0.00017782794100389227, 0.0001539926526059492, 0.0001333521432163324, 0.00011547819846894582};

__device__ __forceinline__ int inproj_slot(int c) {
    if (c < 1024) { const int reg = c >> 9, cc = c & 511, head = cc >> 7, half = (cc >> 6) & 1, dd = cc & 63; return reg * 512 + (head >> 1) * 256 + half * 128 + (head & 1) * 64 + dd; }
    if (c < 2048) return c;
    const int cg = (c >= 2560) ? 1 : 0, ch = (c - 2048) & 511;
    return 2048 + (ch >> 7) * 256 + cg * 128 + (ch & 127);
}
__device__ __forceinline__ void transpose_item(const float* W, int K, int N, bf16* WT, int k0, int n0s, int n0d, LAS float* scr, int lane) {
#pragma unroll 8
    for (int i = 0; i < 32; ++i) { const int kk = 2 * i + (lane >> 5); scr[kk * 33 + (lane & 31)] = W[(size_t)(k0 + kk) * N + n0s + (lane & 31)]; }
    LDS_WAIT(); asm volatile("" ::: "memory");
    const int c = lane & 7;
#pragma unroll
    for (int j = 0; j < 4; ++j) { const int n = (lane >> 3) + 8 * j; const LAS float* s = scr + (8 * c) * 33 + n;
        v4u o; o.x = pk2(s[0 * 33], s[1 * 33]); o.y = pk2(s[2 * 33], s[3 * 33]); o.z = pk2(s[4 * 33], s[5 * 33]); o.w = pk2(s[6 * 33], s[7 * 33]);
        *(GAS v4u*)(WT + (size_t)(n0d + n) * K + k0 + 8 * c) = o; }
    LDS_WAIT(); asm volatile("" ::: "memory");
}
__device__ __forceinline__ void cvt_flat(const float* src, bf16* dst, size_t n, size_t gtid, size_t nthr) {
    for (size_t i = gtid * 8; i < n; i += nthr * 8) {
        const v4f a = *(const v4f*)(src + i), b = *(const v4f*)(src + i + 4);
        v4u o; o.x = pk2(a.x, a.y); o.y = pk2(a.z, a.w); o.z = pk2(b.x, b.y); o.w = pk2(b.z, b.w);
        *(v4u*)(dst + i) = o;
    }
}

struct EpiInProj {
    static constexpr bool PERM = true, AFTER_DRAIN = false;
    const float* bias; bf16 *Q, *K, *V, *G, *U; const float *cosT, *sinT; float *ccp, *ccs;
    __device__ __forceinline__ void operator()(const pg8::f32x4 (&acc)[2][2][4][2], const pg8::Unit& u, int wr, int wc, int fr, int fq) const {
        const int s0 = wc * 32 + 8 * fq, pn = u.pn;
        const int rowb = u.pm * 256 + wr * 64 + fr;
        if (pn < 4) {
            const int reg = pn >> 1, head = 2 * (pn & 1) + (s0 >> 6), dd0 = s0 & 63;
            const int c0 = reg * 512 + head * 128 + dd0;
            float b0[8], b1[8];
            { const v4f x0 = *(const v4f*)(bias + c0), x1 = *(const v4f*)(bias + c0 + 4), y0 = *(const v4f*)(bias + c0 + 64), y1 = *(const v4f*)(bias + c0 + 68);
#pragma unroll
              for (int i = 0; i < 4; ++i) { b0[i] = x0[i]; b0[4 + i] = x1[i]; b1[i] = y0[i]; b1[4 + i] = y1[i]; } }
            bf16* dst = reg ? K : Q; const float sc = reg ? 0.08838834764831845f : 1.f;
#pragma unroll
            for (int ai = 0; ai < 2; ++ai)
#pragma unroll
                for (int m = 0; m < 4; ++m) {
                    const int row = rowb + ai * 128 + m * 16;
                    const int pidx = row < TP ? (row & 2047) : 2048 + ((row - TP) & 3);
                    const v4f c0v = *(const v4f*)(cosT + pidx * 64 + dd0), c1v = *(const v4f*)(cosT + pidx * 64 + dd0 + 4);
                    const v4f s0v = *(const v4f*)(sinT + pidx * 64 + dd0), s1v = *(const v4f*)(sinT + pidx * 64 + dd0 + 4);
                    float o1[8], o2[8];
#pragma unroll
                    for (int i = 0; i < 8; ++i) {
                        const float t1 = acc[ai][0][m][i >> 2][i & 3] + b0[i], t2 = acc[ai][1][m][i >> 2][i & 3] + b1[i];
                        const float cc = (i < 4) ? c0v[i & 3] : c1v[i & 3], ss = (i < 4) ? s0v[i & 3] : s1v[i & 3];
                        o1[i] = (t1 * cc - t2 * ss) * sc; o2[i] = (t1 * ss + t2 * cc) * sc;
                    }
                    bf16* p = dst + (size_t)row * RW + head * 128 + dd0;
                    *(v4u*)p = pack8(o1); *(v4u*)(p + 64) = pack8(o2);
                }
        } else if (pn < 8) {
            const bool isg = pn >= 6; bf16* dst = isg ? G : V;
#pragma unroll
            for (int bj = 0; bj < 2; ++bj) {
                const int c0 = 256 * pn + 128 * bj + s0, dcol = c0 - (isg ? 1536 : 1024);
                const v4f x0 = *(const v4f*)(bias + c0), x1 = *(const v4f*)(bias + c0 + 4);
#pragma unroll
                for (int ai = 0; ai < 2; ++ai)
#pragma unroll
                    for (int m = 0; m < 4; ++m) {
                        const int row = rowb + ai * 128 + m * 16;
                        float o[8];
#pragma unroll
                        for (int i = 0; i < 8; ++i) { float v = acc[ai][bj][m][i >> 2][i & 3] + ((i < 4) ? x0[i & 3] : x1[i & 3]); o[i] = isg ? silu_f(v) : v; }
                        *(v4u*)(dst + (size_t)row * RW + dcol) = pack8(o);
                    }
            }
        } else {
            const int ch0 = 128 * (pn - 8) + s0;
            const v4f a0 = *(const v4f*)(bias + 2048 + ch0), a1 = *(const v4f*)(bias + 2048 + ch0 + 4), g0 = *(const v4f*)(bias + 2560 + ch0), g1 = *(const v4f*)(bias + 2560 + ch0 + 4);
#pragma unroll
            for (int ai = 0; ai < 2; ++ai)
#pragma unroll
                for (int m = 0; m < 4; ++m) {
                    const int row = rowb + ai * 128 + m * 16;
                    float o[8];
#pragma unroll
                    for (int i = 0; i < 8; ++i) {
                        const float a = acc[ai][0][m][i >> 2][i & 3] + ((i < 4) ? a0[i & 3] : a1[i & 3]), g = acc[ai][1][m][i >> 2][i & 3] + ((i < 4) ? g0[i & 3] : g1[i & 3]);
                        o[i] = a / (1.f + __expf(-g));
                    }
                    *(v4u*)(U + (size_t)row * RW + ch0) = pack8(o);
                    float* cp = nullptr;
                    if (row < TP) { const int t = row & 2047; if (t >= 2018) cp = ccp + ((size_t)(row >> 11) * 30 + (t - 2018)) * 512 + ch0; }
                    else { const int rs = row - TP; cp = ccs + ((size_t)(rs >> 2) * 30 + 26 + (rs & 3)) * 512 + ch0; }
                    if (cp) { *(v4f*)cp = (v4f){o[0], o[1], o[2], o[3]}; *(v4f*)(cp + 4) = (v4f){o[4], o[5], o[6], o[7]}; }
                }
        }
    }
};
struct EpiOutProj {
    static constexpr bool PERM = false, AFTER_DRAIN = false;
    const float* res_p; const float* res_s; float* Z;
    __device__ __forceinline__ void operator()(const pg8::f32x4 (&acc)[2][2][4][2], const pg8::Unit& u, int wr, int wc, int fr, int fq) const {
        const int col0 = u.pn * 256 + wc * 32 + 4 * fq;
#pragma unroll
        for (int ai = 0; ai < 2; ++ai)
#pragma unroll
            for (int m = 0; m < 4; ++m) {
                const int row = u.pm * 256 + ai * 128 + wr * 64 + m * 16 + fr;
                const float* rp = row < TP ? res_p + (size_t)row * D : res_s + (size_t)(row - TP) * D;
#pragma unroll
                for (int bj = 0; bj < 2; ++bj)
#pragma unroll
                    for (int n = 0; n < 2; ++n) { const int c = col0 + bj * 128 + n * 16; const v4f r = *(const v4f*)(rp + c); const pg8::f32x4 a = acc[ai][bj][m][n];
                        *(v4f*)(Z + (size_t)row * D + c) = (v4f){ALPHA * r.x + a[0], ALPHA * r.y + a[1], ALPHA * r.z + a[2], ALPHA * r.w + a[3]}; }
            }
    }
};

__device__ __forceinline__ void load_tile128(LAS unsigned char* dst, int stride, const bf16* src, size_t row0, int coff, int tid) {
#pragma unroll
    for (int i = 0; i < 4; ++i) { const int idx = tid + 512 * i, j = idx >> 4, c16 = idx & 15;
        *(LAS v4u*)(dst + j * stride + c16 * 16) = *(const v4u*)(src + (row0 + j) * RW + coff + c16 * 8); }
}
__device__ __forceinline__ void kv_unit(LAS unsigned char* lds, int uidx, const bf16* Kb, const bf16* Vb, float* KV, int tid) {
    const int h = uidx & 3, bn = uidx >> 2; const size_t row0 = (size_t)bn * 128;
    load_tile128(lds, 256, Kb, row0, h * 128, tid); load_tile128(lds + 32768, 256, Vb, row0, h * 128, tid);
    __syncthreads();
    const int td = tid >> 4, te = tid & 15, d0 = td * 4, e0 = te * 8; const float lg2 = l2gamma(h);
    float acc[4][8];
#pragma unroll
    for (int a = 0; a < 4; ++a)
#pragma unroll
        for (int c = 0; c < 8; ++c) acc[a][c] = 0.f;
#pragma unroll 4
    for (int j = 0; j < 128; ++j) {
        const float dec = exp2f((float)(127 - j) * lg2);
        const v2u kk = *(const LAS v2u*)(lds + j * 256 + d0 * 2); const v4u vv = *(const LAS v4u*)(lds + 32768 + j * 256 + e0 * 2);
        const float kd[4] = {bflo(kk.x) * dec, bfhi(kk.x) * dec, bflo(kk.y) * dec, bfhi(kk.y) * dec};
        float vf[8]; unpack8(vv, vf);
#pragma unroll
        for (int a = 0; a < 4; ++a)
#pragma unroll
            for (int c = 0; c < 8; ++c) acc[a][c] += kd[a] * vf[c];
    }
    float* dst = KV + (size_t)uidx * 16384;
#pragma unroll
    for (int a = 0; a < 4; ++a) { *(v4f*)(dst + (d0 + a) * 128 + e0) = (v4f){acc[a][0], acc[a][1], acc[a][2], acc[a][3]}; *(v4f*)(dst + (d0 + a) * 128 + e0 + 4) = (v4f){acc[a][4], acc[a][5], acc[a][6], acc[a][7]}; }
    __syncthreads();
}
__device__ __forceinline__ void sample_unit(LAS unsigned char* lds, int su, int l, const bf16* Qb, const bf16* Kb, const bf16* Vb, const bf16* Gb, const float* state_in, float* state_out, bf16* A2, int tid) {
    const int b = su >> 2, h = su & 3, row0 = TP + 4 * b, wave = tid >> 6, lane = tid & 63;
    LAS float* qs = (LAS float*)lds; LAS float* ks = qs + 512; LAS float* vs = ks + 512; LAS float* sc = vs + 512; LAS float* red = sc + 16;
    LAS float* part = (LAS float*)(lds + 8192);
#pragma unroll
    for (int i = 0; i < 3; ++i) { const int idx = tid + 512 * i, which = idx >> 9, t = (idx >> 7) & 3, e = idx & 127;
        const bf16* src = which == 0 ? Qb : which == 1 ? Kb : Vb; qs[idx] = bf2f(src[(size_t)(row0 + t) * RW + h * 128 + e]); }
    __syncthreads();
    const float lg2 = l2gamma(h);
    { const int p = tid >> 5, t = p >> 2, j = p & 3, l32 = tid & 31; float s = 0.f;
#pragma unroll
      for (int dd = 0; dd < 4; ++dd) s += qs[t * 128 + l32 * 4 + dd] * ks[j * 128 + l32 * 4 + dd];
      s += __shfl_xor(s, 16); s += __shfl_xor(s, 8); s += __shfl_xor(s, 4); s += __shfl_xor(s, 2); s += __shfl_xor(s, 1);
      if (l32 == 0) sc[p] = (j <= t) ? s * exp2f((float)(t - j) * lg2) : 0.f; }
    const int dgrp = tid >> 5, d0 = dgrp * 8, e0 = (tid & 31) * 4;
    const size_t sbase = ((size_t)(l * 128 + b) * 4 + h) * 16384;
    const float g4 = exp2f(4.f * lg2), g3 = exp2f(3.f * lg2), g2 = exp2f(2.f * lg2), g1 = exp2f(lg2);
    float cross[4][4], vt[4][4];
#pragma unroll
    for (int t = 0; t < 4; ++t)
#pragma unroll
        for (int c = 0; c < 4; ++c) { cross[t][c] = 0.f; vt[t][c] = vs[t * 128 + e0 + c]; }
#pragma unroll
    for (int dd = 0; dd < 8; ++dd) { const int d = d0 + dd;
        const v4f r = *(const v4f*)(state_in + sbase + (size_t)d * 128 + e0);
        const float q0 = qs[d], q1 = qs[128 + d], q2 = qs[256 + d], q3 = qs[384 + d];
        const float k0 = ks[d] * g3, k1 = ks[128 + d] * g2, k2 = ks[256 + d] * g1, k3 = ks[384 + d];
        v4f rn;
#pragma unroll
        for (int c = 0; c < 4; ++c) { cross[0][c] += q0 * r[c]; cross[1][c] += q1 * r[c]; cross[2][c] += q2 * r[c]; cross[3][c] += q3 * r[c];
            rn[c] = g4 * r[c] + (k0 * vt[0][c] + k1 * vt[1][c] + k2 * vt[2][c] + k3 * vt[3][c]); }
        *(v4f*)(state_out + sbase + (size_t)d * 128 + e0) = rn; }
#pragma unroll
    for (int t = 0; t < 4; ++t) *(LAS v4f*)(part + (dgrp * 4 + t) * 128 + e0) = (v4f){cross[t][0], cross[t][1], cross[t][2], cross[t][3]};
    __syncthreads();
    const int t = tid >> 7, e = tid & 127;
    float oc = 0.f;
#pragma unroll
    for (int g = 0; g < 16; ++g) oc += part[(g * 4 + t) * 128 + e];
    float oi = 0.f;
#pragma unroll
    for (int j = 0; j < 4; ++j) oi += sc[t * 4 + j] * vs[j * 128 + e];
    const float o = oi + exp2f((float)(t + 1) * lg2) * oc;
    const float s1 = wave_sum(o); if (lane == 0) red[wave] = s1;
    __syncthreads();
    const float mean = (red[2 * t] + red[2 * t + 1]) * (1.f / 128.f), dl = o - mean;
    const float s2 = wave_sum(dl * dl); if (lane == 0) red[8 + wave] = s2;
    __syncthreads();
    const float var = (red[8 + 2 * t] + red[8 + 2 * t + 1]) * (1.f / 128.f);
    const int row = row0 + t; const float gate = bf2f(Gb[(size_t)row * RW + h * 128 + e]);
    A2[(size_t)row * D + h * 128 + e] = (bf16)f2bf(dl * rsqrtf(var + LN_EPS) * gate);
    __syncthreads();
}
__device__ __forceinline__ void conv_unit(LAS unsigned char* lds, int cu, int l, const bf16* Ub, const float* cache_in, const float* dwk, const float* dwb, const float* lng, const float* lnb, bf16* A2, int tid) {
    LAS float* red = (LAS float*)lds; const int ch = tid, wave = tid >> 6, lane = tid & 63;
    float w[38]; int row0, nvalid;
    if (cu < 2048) { row0 = cu * 8; nvalid = 8; const int t0 = row0 & 2047;
#pragma unroll
        for (int i = 0; i < 38; ++i) w[i] = (t0 - 30 + i >= 0) ? bf2f(Ub[(size_t)(row0 - 30 + i) * RW + ch]) : 0.f;
    } else { const int sb = cu - 2048; row0 = TP + 4 * sb; nvalid = 4;
#pragma unroll
        for (int i = 0; i < 30; ++i) w[i] = cache_in[((size_t)(l * 128 + sb) * 30 + i) * 512 + ch];
#pragma unroll
        for (int i = 30; i < 34; ++i) w[i] = bf2f(Ub[(size_t)(row0 + i - 30) * RW + ch]);
#pragma unroll
        for (int i = 34; i < 38; ++i) w[i] = 0.f; }
    float y[8]; const float bb = dwb[ch];
#pragma unroll
    for (int k = 0; k < 8; ++k) y[k] = bb;
#pragma unroll
    for (int k = 0; k < 31; ++k) { const float wk = dwk[k * 512 + ch];
#pragma unroll
        for (int tok = 0; tok < 8; ++tok) y[tok] += wk * w[tok + k]; }
    float mean[8];
#pragma unroll
    for (int tok = 0; tok < 8; ++tok) { const float s = wave_sum(y[tok]); if (lane == 0) red[wave * 8 + tok] = s; }
    __syncthreads();
#pragma unroll
    for (int tok = 0; tok < 8; ++tok) { float s = 0.f;
#pragma unroll
        for (int wv = 0; wv < 8; ++wv) s += red[wv * 8 + tok];
        mean[tok] = s * (1.f / 512.f); y[tok] -= mean[tok]; }
#pragma unroll
    for (int tok = 0; tok < 8; ++tok) { const float s = wave_sum(y[tok] * y[tok]); if (lane == 0) red[64 + wave * 8 + tok] = s; }
    __syncthreads();
    const float gg = lng[ch], gb = lnb[ch];
#pragma unroll
    for (int tok = 0; tok < 8; ++tok) { float s = 0.f;
#pragma unroll
        for (int wv = 0; wv < 8; ++wv) s += red[64 + wv * 8 + tok];
        const float v = y[tok] * rsqrtf(s * (1.f / 512.f) + LN_EPS) * gg + gb;
        if (tok < nvalid) A2[(size_t)(row0 + tok) * D + 512 + ch] = (bf16)f2bf(silu_f(v)); }
    __syncthreads();
}
__device__ __forceinline__ void ret_unit(LAS unsigned char* lds, int uidx, int l, const bf16* Qb, const bf16* Kb, const bf16* Vb, const bf16* Gb, const float* KV, float* state_out, bf16* A2, int tid) {
    const int h = uidx & 3, bn = uidx >> 2, n = bn & 15, b = bn >> 4; const size_t row0 = (size_t)bn * 128;
    LAS unsigned char* Qs = lds; LAS unsigned char* Ks = lds + 128 * PST; LAS unsigned char* Vs = lds + 2 * 128 * PST; LAS unsigned char* Ss = lds + 3 * 128 * PST;
    load_tile128(Qs, PST, Qb, row0, h * 128, tid); load_tile128(Ks, PST, Kb, row0, h * 128, tid); load_tile128(Vs, PST, Vb, row0, h * 128, tid);
    __syncthreads();
    const float lg2 = l2gamma(h);
    const int ti = tid >> 4, tj = tid & 15, i0 = ti * 4;
    {   float s[4][8];
#pragma unroll
        for (int a = 0; a < 4; ++a)
#pragma unroll
            for (int c = 0; c < 8; ++c) s[a][c] = 0.f;
#pragma unroll 1
        for (int dc = 0; dc < 16; ++dc) {
            float qf[4][8];
#pragma unroll
            for (int a = 0; a < 4; ++a) unpack8(*(const LAS v4u*)(Qs + (i0 + a) * PST + dc * 16), qf[a]);
#pragma unroll
            for (int c = 0; c < 8; ++c) { float kf[8]; unpack8(*(const LAS v4u*)(Ks + (tj + 16 * c) * PST + dc * 16), kf);
#pragma unroll
                for (int a = 0; a < 4; ++a)
#pragma unroll
                    for (int x = 0; x < 8; ++x) s[a][c] += qf[a][x] * kf[x]; }
        }
#pragma unroll
        for (int a = 0; a < 4; ++a)
#pragma unroll
            for (int c = 0; c < 8; ++c) { const int i = i0 + a, j = tj + 16 * c; const float v = (i >= j) ? s[a][c] * exp2f((float)(i - j) * lg2) : 0.f;
                *(LAS bf16*)(Ss + i * PST + j * 2) = (bf16)f2bf(v); }
    }
    __syncthreads();
    {
        const int d = tid >> 2, e0 = (tid & 3) * 32; const float cd = exp2f(128.f * lg2);
        float r[32];
#pragma unroll
        for (int x = 0; x < 32; ++x) r[x] = 0.f;
        for (int m = 0; m < n; ++m) { const float* src = KV + ((size_t)((b * 16 + m) * 4 + h)) * 16384 + d * 128 + e0;
#pragma unroll
            for (int x = 0; x < 8; ++x) { const v4f k4 = *(const v4f*)(src + 4 * x); r[4 * x] = r[4 * x] * cd + k4.x; r[4 * x + 1] = r[4 * x + 1] * cd + k4.y; r[4 * x + 2] = r[4 * x + 2] * cd + k4.z; r[4 * x + 3] = r[4 * x + 3] * cd + k4.w; } }
#pragma unroll
        for (int x = 0; x < 4; ++x) { const float f8[8] = {r[8 * x], r[8 * x + 1], r[8 * x + 2], r[8 * x + 3], r[8 * x + 4], r[8 * x + 5], r[8 * x + 6], r[8 * x + 7]};
            *(LAS v4u*)(Ks + d * PST + (e0 + 8 * x) * 2) = pack8(f8); }
        if (n == 15) { const float* src = KV + ((size_t)((b * 16 + 15) * 4 + h)) * 16384 + d * 128 + e0; float* dst = state_out + ((size_t)((l * 8 + b) * 4 + h)) * 16384 + d * 128 + e0;
#pragma unroll
            for (int x = 0; x < 8; ++x) { const v4f k4 = *(const v4f*)(src + 4 * x);
                *(v4f*)(dst + 4 * x) = (v4f){r[4 * x] * cd + k4.x, r[4 * x + 1] * cd + k4.y, r[4 * x + 2] * cd + k4.z, r[4 * x + 3] * cd + k4.w}; } }
    }
    __syncthreads();
    {   const int te = tid & 15, e0 = te * 8;
        float o[4][8];
#pragma unroll
        for (int a = 0; a < 4; ++a)
#pragma unroll
            for (int c = 0; c < 8; ++c) o[a][c] = 0.f;
#pragma unroll 1
        for (int jc = 0; jc < 16; ++jc) {
            float sf[4][8];
#pragma unroll
            for (int a = 0; a < 4; ++a) unpack8(*(const LAS v4u*)(Ss + (i0 + a) * PST + jc * 16), sf[a]);
#pragma unroll
            for (int x = 0; x < 8; ++x) { float vf[8]; unpack8(*(const LAS v4u*)(Vs + (jc * 8 + x) * PST + e0 * 2), vf);
#pragma unroll
                for (int a = 0; a < 4; ++a)
#pragma unroll
                    for (int c = 0; c < 8; ++c) o[a][c] += sf[a][x] * vf[c]; }
        }
        float di[4];
#pragma unroll
        for (int a = 0; a < 4; ++a) di[a] = exp2f((float)(i0 + a + 1) * lg2);
#pragma unroll 1
        for (int dc = 0; dc < 16; ++dc) {
            float qf[4][8];
#pragma unroll
            for (int a = 0; a < 4; ++a) { unpack8(*(const LAS v4u*)(Qs + (i0 + a) * PST + dc * 16), qf[a]);
#pragma unroll
                for (int x = 0; x < 8; ++x) qf[a][x] *= di[a]; }
#pragma unroll
            for (int x = 0; x < 8; ++x) { float rf[8]; unpack8(*(const LAS v4u*)(Ks + (dc * 8 + x) * PST + e0 * 2), rf);
#pragma unroll
                for (int a = 0; a < 4; ++a)
#pragma unroll
                    for (int c = 0; c < 8; ++c) o[a][c] += qf[a][x] * rf[c]; }
        }
#pragma unroll
        for (int a = 0; a < 4; ++a) { const int i = i0 + a; float s = 0.f;
#pragma unroll
            for (int c = 0; c < 8; ++c) s += o[a][c];
            s += __shfl_xor(s, 1); s += __shfl_xor(s, 2); s += __shfl_xor(s, 4); s += __shfl_xor(s, 8);
            const float mean = s * (1.f / 128.f); float q = 0.f;
#pragma unroll
            for (int c = 0; c < 8; ++c) { o[a][c] -= mean; q += o[a][c] * o[a][c]; }
            q += __shfl_xor(q, 1); q += __shfl_xor(q, 2); q += __shfl_xor(q, 4); q += __shfl_xor(q, 8);
            const float rstd = rsqrtf(q * (1.f / 128.f) + LN_EPS);
            float gf[8]; unpack8(*(const v4u*)(Gb + (row0 + i) * RW + h * 128 + e0), gf);
            float outv[8];
#pragma unroll
            for (int c = 0; c < 8; ++c) outv[c] = o[a][c] * rstd * gf[c];
            *(v4u*)(A2 + (row0 + i) * D + h * 128 + e0) = pack8(outv); }
    }
    __syncthreads();
}
__host__ __device__ __forceinline__ void ce_desc(float& a, float& b) { const float hi = fmaxf(a, b), lo = fminf(a, b); a = hi; b = lo; }
template <int N> __host__ __device__ __forceinline__ void bitonic_sort_desc(float (&a)[N]) {
#pragma unroll
    for (int k = 2; k <= N; k <<= 1)
#pragma unroll
        for (int j = k >> 1; j > 0; j >>= 1)
#pragma unroll
            for (int i = 0; i < N; ++i) { const int p = i ^ j; if (p > i) { if ((i & k) == 0) ce_desc(a[i], a[p]); else ce_desc(a[p], a[i]); } }
}
template <int N> __host__ __device__ __forceinline__ void bitonic_merge_desc(float (&a)[N]) {
#pragma unroll
    for (int j = N >> 1; j > 0; j >>= 1)
#pragma unroll
        for (int i = 0; i < N; ++i) { const int p = i ^ j; if (p > i) ce_desc(a[i], a[p]); }
}
__host__ __device__ __forceinline__ void merge_top16(float (&a)[16], const float (&b)[16]) {
#pragma unroll
    for (int i = 0; i < 16; ++i) a[i] = fmaxf(a[i], b[15 - i]);
    bitonic_merge_desc<16>(a);
}
__host__ __device__ __forceinline__ void top16_of_64(float (&g0)[16], float (&g1)[16], float (&g2)[16], float (&g3)[16]) {
    bitonic_sort_desc<16>(g0); bitonic_sort_desc<16>(g1); bitonic_sort_desc<16>(g2); bitonic_sort_desc<16>(g3);
    merge_top16(g0, g1); merge_top16(g2, g3); merge_top16(g0, g2);
}
__host__ __device__ __forceinline__ float pack_low(float v, unsigned mask, unsigned code) { unsigned u = __builtin_bit_cast(unsigned, v); u = (u & ~mask) | code; return __builtin_bit_cast(float, u); }
__host__ __device__ constexpr int cand_i(int n) { return n < 16 ? 0 : n < 24 ? 1 : n < 29 ? 2 : n < 33 ? 3 : n < 36 ? 4 : n < 38 ? 5 : n < 40 ? 6 : n < 42 ? 7 : n - 34; }
__host__ __device__ constexpr int cand_j(int n) { return n < 16 ? n : n < 24 ? n - 16 : n < 29 ? n - 24 : n < 33 ? n - 29 : n < 36 ? n - 33 : n < 38 ? n - 36 : n < 40 ? n - 38 : n < 42 ? n - 40 : 0; }
__host__ __device__ __forceinline__ void top16_pair_sums(const float (&v1)[16], const float (&v2)[16], float (&c0)[16]) {
    float c1[16], c2[16], c3[16];
    const float ninf = __builtin_bit_cast(float, 0xff800000u);
#pragma unroll
    for (int n = 0; n < 64; ++n) {
        float v = ninf;
        if (n < 50) v = pack_low(v1[cand_i(n)] + v2[cand_j(n)], 0xffu, (unsigned)((cand_i(n) << 4) | cand_j(n)));
        if (n < 16) c0[n] = v; else if (n < 32) c1[n - 16] = v; else if (n < 48) c2[n - 32] = v; else c3[n - 48] = v;
    }
    top16_of_64(c0, c1, c2, c3);
}

__device__ __forceinline__ void route_unit(LAS unsigned char* lds, int uidx, int l, const bf16* QP, const bf16* KEYS, int* RI, float* RG, int tid) {
    const int head = uidx & 7, tile = uidx >> 3, tok0 = tile * 128;
    const int wave = tid >> 6, lane = tid & 63, side = wave >> 2, sub = wave & 3, r = lane & 31, hl = lane >> 5;
    const bf16* keys = KEYS + (size_t)((l * 2 + side) * 8 + head) * 16384;
    const bf16* qrow = QP + (size_t)(tok0 + sub * 32 + r) * 2048 + head * 256 + side * 128 + hl * 8;
    f32x16 acc[4];
#pragma unroll
    for (int mt = 0; mt < 4; ++mt)
#pragma unroll
        for (int i = 0; i < 16; ++i) acc[mt][i] = 0.f;
#pragma unroll
    for (int ks = 0; ks < 8; ++ks) {
        const bf16x8 bq = *(const bf16x8*)(qrow + ks * 16);
#pragma unroll
        for (int mt = 0; mt < 4; ++mt) { const bf16x8 ak = *(const bf16x8*)(keys + (size_t)(mt * 32 + r) * 128 + ks * 16 + hl * 8);
            acc[mt] = __builtin_amdgcn_mfma_f32_32x32x16_bf16(ak, bq, acc[mt], 0, 0, 0); }
    }
    float g0[16], g1[16], g2[16], g3[16];
#pragma unroll
    for (int i = 0; i < 16; ++i) { const unsigned kr = (unsigned)((i & 3) + 8 * (i >> 2) + 4 * hl);
        g0[i] = pack_low(acc[0][i], 127u, kr); g1[i] = pack_low(acc[1][i], 127u, 32u + kr); g2[i] = pack_low(acc[2][i], 127u, 64u + kr); g3[i] = pack_low(acc[3][i], 127u, 96u + kr); }
    top16_of_64(g0, g1, g2, g3);
#pragma unroll
    for (int i = 0; i < 16; ++i) g1[i] = __shfl_xor(g0[15 - i], 32);
#pragma unroll
    for (int i = 0; i < 16; ++i) g0[i] = fmaxf(g0[i], g1[i]);
    bitonic_merge_desc<16>(g0);
    LAS float* cand = (LAS float*)lds;
    if (hl == 0) { LAS v4f* p = (LAS v4f*)(cand + ((side * 128) + sub * 32 + r) * 16);
#pragma unroll
        for (int x = 0; x < 4; ++x) p[x] = (v4f){g0[4 * x], g0[4 * x + 1], g0[4 * x + 2], g0[4 * x + 3]}; }
    __syncthreads();
    if (tid < 128) {
        float v1[16], v2[16], c0[16];
#pragma unroll
        for (int x = 0; x < 4; ++x) { const v4f a = *(const LAS v4f*)(cand + tid * 16 + 4 * x), b = *(const LAS v4f*)(cand + (128 + tid) * 16 + 4 * x);
            v1[4 * x] = a.x; v1[4 * x + 1] = a.y; v1[4 * x + 2] = a.z; v1[4 * x + 3] = a.w; v2[4 * x] = b.x; v2[4 * x + 1] = b.y; v2[4 * x + 2] = b.z; v2[4 * x + 3] = b.w; }
        top16_pair_sums(v1, v2, c0);
        float e[16], se = 0.f;
#pragma unroll
        for (int k = 0; k < 16; ++k) { e[k] = __expf(c0[k] - c0[0]); se += e[k]; }
        const float inv = 1.f / se;
        const LAS unsigned* cb = (const LAS unsigned*)cand;
        int* ri = RI + (size_t)(tok0 + tid) * NSEL + head * 16; float* rg = RG + (size_t)(tok0 + tid) * NSEL + head * 16;
#pragma unroll
        for (int x = 0; x < 4; ++x) { int ii[4]; float gg[4];
#pragma unroll
            for (int y = 0; y < 4; ++y) { const int k = 4 * x + y; const unsigned code = __builtin_bit_cast(unsigned, c0[k]) & 0xffu;
                const unsigned e1 = cb[tid * 16 + (code >> 4)] & 127u, e2 = cb[(128 + tid) * 16 + (code & 15u)] & 127u;
                ii[y] = (int)(e1 * 128u + e2); gg[y] = e[k] * inv; }
            *(int4*)(ri + 4 * x) = make_int4(ii[0], ii[1], ii[2], ii[3]); *(v4f*)(rg + 4 * x) = (v4f){gg[0], gg[1], gg[2], gg[3]}; }
    }
    __syncthreads();
}
__device__ __forceinline__ void expert_token(int tok, const bf16* X1B, const float* X1F, const int* RI, const float* RG, const bf16* UB, const bf16* VB, const float* g2, const float* b2, float* outf, bf16* outb, int lane) {
    const int i0 = RI[(size_t)tok * NSEL + lane], i1 = RI[(size_t)tok * NSEL + 64 + lane];
    const float w0 = RG[(size_t)tok * NSEL + lane], w1 = RG[(size_t)tok * NSEL + 64 + lane];
    float xf[16];
    { float t8[8]; unpack8(*(const v4u*)(X1B + (size_t)tok * D + lane * 8), t8);
#pragma unroll
      for (int i = 0; i < 8; ++i) xf[i] = t8[i];
      unpack8(*(const v4u*)(X1B + (size_t)tok * D + 512 + lane * 8), t8);
#pragma unroll
      for (int i = 0; i < 8; ++i) xf[8 + i] = t8[i]; }
    float facc[16];
#pragma unroll
    for (int i = 0; i < 16; ++i) facc[i] = 0.f;
    for (int kk = 0; kk < 32; ++kk) {
        v4u ub[4][2], vb[4][2]; float gt[4];
#pragma unroll
        for (int u = 0; u < 4; ++u) { const int k = kk * 4 + u;
            const int e = (k < 64) ? __builtin_amdgcn_readlane(i0, k & 63) : __builtin_amdgcn_readlane(i1, k & 63);
            gt[u] = __builtin_bit_cast(float, (k < 64) ? __builtin_amdgcn_readlane(__builtin_bit_cast(int, w0), k & 63) : __builtin_amdgcn_readlane(__builtin_bit_cast(int, w1), k & 63));
            const bf16* up = UB + (size_t)e * D + lane * 8; const bf16* vp = VB + (size_t)e * D + lane * 8;
            ub[u][0] = *(const v4u*)up; ub[u][1] = *(const v4u*)(up + 512); vb[u][0] = *(const v4u*)vp; vb[u][1] = *(const v4u*)(vp + 512); }
#pragma unroll
        for (int u = 0; u < 4; ++u) {
            float a8[8], b8[8]; unpack8(ub[u][0], a8); unpack8(ub[u][1], b8);
            float p = 0.f;
#pragma unroll
            for (int i = 0; i < 8; ++i) p += a8[i] * xf[i] + b8[i] * xf[8 + i];
            p = wave_sum(p);
            const float wgt = gt[u] * 0.5f * p * (1.f + erff(p * 0.7071067811865476f));
            unpack8(vb[u][0], a8); unpack8(vb[u][1], b8);
#pragma unroll
            for (int i = 0; i < 8; ++i) { facc[i] += wgt * a8[i]; facc[8 + i] += wgt * b8[i]; }
        }
    }
    float z[16];
    { const float* xr = X1F + (size_t)tok * D + lane * 8;
      const v4f a = *(const v4f*)xr, b = *(const v4f*)(xr + 4), c = *(const v4f*)(xr + 512), d = *(const v4f*)(xr + 516);
#pragma unroll
      for (int i = 0; i < 4; ++i) { z[i] = ALPHA * a[i] + facc[i]; z[4 + i] = ALPHA * b[i] + facc[4 + i]; z[8 + i] = ALPHA * c[i] + facc[8 + i]; z[12 + i] = ALPHA * d[i] + facc[12 + i]; } }
    float s = 0.f;
#pragma unroll
    for (int i = 0; i < 16; ++i) s += z[i];
    const float mean = wave_sum(s) * (1.f / D); float q = 0.f;
#pragma unroll
    for (int i = 0; i < 16; ++i) { z[i] -= mean; q += z[i] * z[i]; }
    const float rstd = rsqrtf(wave_sum(q) * (1.f / D) + LN_EPS);
    float o[16];
#pragma unroll
    for (int hh = 0; hh < 2; ++hh) { const int c0 = hh * 512 + lane * 8;
        const v4f ga = *(const v4f*)(g2 + c0), gb = *(const v4f*)(g2 + c0 + 4), ba = *(const v4f*)(b2 + c0), bb = *(const v4f*)(b2 + c0 + 4);
#pragma unroll
        for (int i = 0; i < 4; ++i) { o[hh * 8 + i] = z[hh * 8 + i] * rstd * ga[i] + ba[i]; o[hh * 8 + 4 + i] = z[hh * 8 + 4 + i] * rstd * gb[i] + bb[i]; }
        float* op = outf + (size_t)tok * D + c0;
        *(v4f*)op = (v4f){o[hh * 8], o[hh * 8 + 1], o[hh * 8 + 2], o[hh * 8 + 3]}; *(v4f*)(op + 4) = (v4f){o[hh * 8 + 4], o[hh * 8 + 5], o[hh * 8 + 6], o[hh * 8 + 7]};
        if (outb) { const float o8[8] = {o[hh * 8], o[hh * 8 + 1], o[hh * 8 + 2], o[hh * 8 + 3], o[hh * 8 + 4], o[hh * 8 + 5], o[hh * 8 + 6], o[hh * 8 + 7]}; *(v4u*)(outb + (size_t)tok * D + c0) = pack8(o8); }
    }
}

struct Args { const float* in[20]; float* out; unsigned char* ws; int ph_lo, ph_hi; };
__global__ void __launch_bounds__(NTHR, 2) mk_fwd(Args args) {
    extern __shared__ __attribute__((aligned(16))) unsigned char lds_raw[];
    LAS unsigned char* lds = (LAS unsigned char*)lds_raw;
    volatile LAS unsigned* MISC = (volatile LAS unsigned*)(lds + MISC_OFF);
    const int G = gridDim.x, bx = blockIdx.x, vcu = (G % 8 == 0) ? (bx % 8) * (G / 8) + bx / 8 : bx;
    unsigned char* ws = args.ws; float* out = args.out;
    gu32* ctl = (gu32*)(ws + WS_CTL);
    for (int u = threadIdx.x; u < (LDS_BYTES - LDSCTL_OFF) / 4; u += NTHR) ((LAS unsigned*)(lds + LDSCTL_OFF))[u] = 0u;
    __syncthreads();
    XcdBarrier bar; bar.bar = (unsigned*)(ctl + CW_BAR); bar.x = 0; bar.st = nullptr;
    if (!MK_PER_PHASE) bar = xcd_barrier_post((unsigned*)(ctl + CW_BAR), MISC + 8);
    const int lo = args.ph_lo, hi = args.ph_hi;
#define IN(k) (lo <= (k) && (k) < hi)
#define LAUNDER() int tl = threadIdx.x; asm volatile("" : "+v"(tl)); const int lanel = tl & 63, wavel = __builtin_amdgcn_readfirstlane(tl >> 6); const int gw = vcu * NWAVES + wavel, NGW = G * NWAVES; const size_t gtid = (size_t)vcu * NTHR + tl, NGT = (size_t)G * NTHR; (void)lanel; (void)wavel; (void)gw; (void)NGW; (void)gtid; (void)NGT
#define SEAM(k) do { if (IN(k) && IN((k) + 1)) xcd_barrier(bar); } while (0)
    float* cosT = (float*)(ws + WS_ROPE); float* sinT = cosT + 2052 * 64;
    bf16* WinT = (bf16*)(ws + WS_WIN); bf16* WoutT = (bf16*)(ws + WS_WOUT); bf16* WqT = (bf16*)(ws + WS_WQ); bf16* KEYS = (bf16*)(ws + WS_KEYS);
    bf16* UB = (bf16*)(ws + WS_UB); bf16* VB = (bf16*)(ws + WS_VB);
    bf16* XB = (bf16*)(ws + WS_XB); float* XF = (float*)(ws + WS_XF);
    bf16* Qb = (bf16*)(ws + WS_Q); bf16* Kb = (bf16*)(ws + WS_K); bf16* Vb = (bf16*)(ws + WS_V); bf16* Gb = (bf16*)(ws + WS_G); bf16* Ub = (bf16*)(ws + WS_U);
    float* KV = (float*)(ws + WS_KV); bf16* A2 = (bf16*)(ws + WS_A2); float* Z1 = (float*)(ws + WS_Z1); bf16* X1B = (bf16*)(ws + WS_X1B);
    bf16* QP = (bf16*)(ws + WS_QP); int* RI = (int*)(ws + WS_RI); float* RG = (float*)(ws + WS_RG);

    if (IN(0) && EN(0)) {
        LAUNDER();
        LAS float* scr = (LAS float*)(lds + wavel * 16384);
        for (int it = gw; it < 6144; it += NGW) {
            const int l = it / 3072; int r = it % 3072;
            if (r < 1536) { const int kb = r / 96, nb = r % 96; transpose_item(args.in[4] + (size_t)l * D * INW, D, INW, WinT + (size_t)l * INW * D, kb * 64, nb * 32, inproj_slot(nb * 32), scr, lanel); continue; } r -= 1536;
            if (r < 512) { const int kb = r / 32, nb = r % 32; transpose_item(args.in[10] + (size_t)l * D * D, D, D, WoutT + (size_t)l * D * D, kb * 64, nb * 32, nb * 32, scr, lanel); continue; } r -= 512;
            { const int kb = r / 64, nb = r % 64; transpose_item(args.in[13] + (size_t)l * D * 2048, D, 2048, WqT + (size_t)l * 2048 * D, kb * 64, nb * 32, nb * 32, scr, lanel); }
        }
        for (int l = 0; l < NL; ++l) { cvt_flat(args.in[14] + (size_t)l * 131072, KEYS + (size_t)(l * 2 + 0) * 131072, 131072, gtid, NGT); cvt_flat(args.in[15] + (size_t)l * 131072, KEYS + (size_t)(l * 2 + 1) * 131072, 131072, gtid, NGT); }
        cvt_flat(args.in[16], UB, (size_t)NL * 16384 * D, gtid, NGT);
        cvt_flat(args.in[17], VB, (size_t)NL * 16384 * D, gtid, NGT);
        cvt_flat(args.in[0], XB, (size_t)TP * D, gtid, NGT);
        cvt_flat(args.in[1], XB + (size_t)TP * D, (size_t)TS * D, gtid, NGT);
        for (size_t i = gtid; i < 2052 * 64; i += NGT) { const int p = (int)(i >> 6), j = (int)(i & 63); const double pos = (p < 2048) ? (double)p : (double)(16384 + (p - 2048));
            const double ang = pos * INV_FREQ[j]; const double kq = rint(ang * 0.15915494309189535); const double rr = ang - kq * 6.283185307179586;
            const float rf = (float)rr; cosT[i] = __cosf(rf); sinT[i] = __sinf(rf); }
        for (size_t i = gtid; i < (size_t)NL * 128 * 26 * 128; i += NGT) {
            const size_t c4 = i & 127, rr = (i >> 7) % 26, lb = (i >> 7) / 26;
            *(v4f*)(out + O_CCS + (lb * 30 + rr) * 512 + c4 * 4) = *(const v4f*)(args.in[3] + (lb * 30 + rr + 4) * 512 + c4 * 4); }
    }
    SEAM(0);
#pragma unroll 1
    for (int l = 0; l < NL; ++l) {
        const int pb = 1 + 8 * l;
        if (IN(pb) && EN(1)) {
            LAUNDER();
            pg8::Gemm g{XB, WinT + (size_t)l * INW * D, T, INW, D}; pg8::StaticOrder S; S.init(T, INW, G, bx);
            EpiInProj E{args.in[5] + l * INW, Qb, Kb, Vb, Gb, Ub, cosT, sinT, out + O_CCP + (size_t)l * 8 * 30 * 512, out + O_CCS + (size_t)l * 128 * 30 * 512};
            pg8::gemm_phase<EpiInProj, pg8::StaticOrder, PG8_ALIGN, PG8_SP2>(lds, g, S, E, tl);
        }
        SEAM(pb);
        if (IN(pb + 1) && EN(2)) {
            LAUNDER();
            for (int u = bx; u < 512; u += G) kv_unit(lds, u, Kb, Vb, KV, tl);
            for (int u = bx; u < 512; u += G) sample_unit(lds, u, l, Qb, Kb, Vb, Gb, args.in[2], out + O_SRS, A2, tl);
            for (int u = bx; u < 2176; u += G) conv_unit(lds, u, l, Ub, args.in[3], args.in[6] + (size_t)l * 31 * 512, args.in[7] + l * 512, args.in[8] + l * 512, args.in[9] + l * 512, A2, tl);
        }
        SEAM(pb + 1);
        if (IN(pb + 2) && EN(3)) { LAUNDER(); for (int u = bx; u < 512; u += G) ret_unit(lds, u, l, Qb, Kb, Vb, Gb, KV, out + O_SRP, A2, tl); }
        SEAM(pb + 2);
        if (IN(pb + 3) && EN(4)) {
            LAUNDER();
            const float* res_p = l == 0 ? args.in[0] : XF; const float* res_s = l == 0 ? args.in[1] : XF + (size_t)TP * D;
            pg8::Gemm g{A2, WoutT + (size_t)l * D * D, T, D, D}; pg8::StaticOrder S; S.init(T, D, G, bx);
            EpiOutProj E{res_p, res_s, Z1};
            pg8::gemm_phase<EpiOutProj, pg8::StaticOrder, PG8_ALIGN, PG8_SP2>(lds, g, S, E, tl);
        }
        SEAM(pb + 3);
        if (IN(pb + 4) && EN(5)) {
            LAUNDER();
            const float* gp = args.in[11] + l * D; const float* bp = args.in[12] + l * D;
            for (int row = gw; row < T; row += NGW) {
                float* zr = Z1 + (size_t)row * D + lanel * 4; v4f v[4]; float s = 0.f;
#pragma unroll
                for (int j = 0; j < 4; ++j) { v[j] = *(const v4f*)(zr + 256 * j); s += (v[j].x + v[j].y) + (v[j].z + v[j].w); }
                const float mean = wave_sum(s) * (1.f / D); float q = 0.f;
#pragma unroll
                for (int j = 0; j < 4; ++j) { v[j] = v[j] - mean; q += (v[j].x * v[j].x + v[j].y * v[j].y) + (v[j].z * v[j].z + v[j].w * v[j].w); }
                const float rstd = rsqrtf(wave_sum(q) * (1.f / D) + LN_EPS);
#pragma unroll
                for (int j = 0; j < 4; ++j) { const v4f gg = *(const v4f*)(gp + lanel * 4 + 256 * j), bb = *(const v4f*)(bp + lanel * 4 + 256 * j);
                    const v4f o = v[j] * rstd * gg + bb; *(v4f*)(zr + 256 * j) = o;
                    v2u w; w.x = pk2(o.x, o.y); w.y = pk2(o.z, o.w); *(v2u*)(X1B + (size_t)row * D + lanel * 4 + 256 * j) = w; }
            }
        }
        SEAM(pb + 4);
        if (IN(pb + 5) && EN(6)) {
            LAUNDER();
            pg8::Gemm g{X1B, WqT + (size_t)l * 2048 * D, T, 2048, D}; pg8::StaticOrder S; S.init(T, 2048, G, bx);
            pg8::EpiBf16<0> E{QP, 2048, nullptr, 0, 0, 1.f};
            pg8::gemm_phase<pg8::EpiBf16<0>, pg8::StaticOrder, PG8_ALIGN, PG8_SP2>(lds, g, S, E, tl);
        }
        SEAM(pb + 5);
        if (IN(pb + 6) && EN(7)) { LAUNDER(); for (int u = bx; u < 132 * 8; u += G) route_unit(lds, u, l, QP, KEYS, RI, RG, tl); }
        SEAM(pb + 6);
        if (IN(pb + 7) && EN(8)) {
            LAUNDER();
            const bf16* ub = UB + (size_t)l * 16384 * D; const bf16* vb = VB + (size_t)l * 16384 * D;
            float* of = (l == NL - 1) ? out + O_YP : XF; bf16* ob = (l == NL - 1) ? nullptr : XB;
            for (int tok = gw; tok < T; tok += NGW) expert_token(tok, X1B, Z1, RI, RG, ub, vb, args.in[18] + l * D, args.in[19] + l * D, of, ob, lanel);
        }
        if (l + 1 < NL) SEAM(pb + 7);
    }
#undef IN
#undef SEAM
#undef LAUNDER
}

extern "C" void kernel_launch(void* const* d_in, const int* in_sizes, int n_in, void* d_out, int out_size, void* d_ws, size_t ws_size, hipStream_t stream) {
    static int grid = 0;
    if (grid == 0) {
        if (n_in != 20 || out_size != (int)O_END || ws_size < WS_END) { fprintf(stderr, "kernel_launch: unexpected shapes: n_in %d out %d ws %zu\n", n_in, out_size, ws_size); grid = -1; return; }
        int dev = 0, cus = 0, per_cu = 0;
        if (hipGetDevice(&dev) != hipSuccess || hipDeviceGetAttribute(&cus, hipDeviceAttributeMultiprocessorCount, dev) != hipSuccess) { grid = -1; return; }
        if (hipFuncSetAttribute((const void*)mk_fwd, hipFuncAttributeMaxDynamicSharedMemorySize, LDS_BYTES) != hipSuccess) { fprintf(stderr, "kernel_launch: hipFuncSetAttribute failed\n"); grid = -1; return; }
        if (hipOccupancyMaxActiveBlocksPerMultiprocessor(&per_cu, (const void*)mk_fwd, NTHR, LDS_BYTES) != hipSuccess || per_cu < 1) { fprintf(stderr, "kernel_launch: occupancy query says %d blocks per CU\n", per_cu); (void)hipGetLastError(); grid = -1; return; }
        grid = cus;
    }
    if (grid < 0) return;
    (void)hipMemsetAsync((char*)d_ws + WS_CTL, 0, CTL_ZERO_BYTES, stream);
    Args a{};
    for (int i = 0; i < 20; ++i) a.in[i] = (const float*)d_in[i];
    a.out = (float*)d_out; a.ws = (unsigned char*)d_ws;
#if MK_PER_PHASE
    for (int p = 0; p < N_PHASES; ++p) { a.ph_lo = p; a.ph_hi = p + 1; hipLaunchKernelGGL(mk_fwd, dim3(grid), dim3(NTHR), LDS_BYTES, stream, a); }
#else
    a.ph_lo = 0; a.ph_hi = N_PHASES; hipLaunchKernelGGL(mk_fwd, dim3(grid), dim3(NTHR), LDS_BYTES, stream, a);
#endif
}
```

```cpp
#include <hip/hip_runtime.h>
#include <cstdio>
#include <cstdint>
namespace pg8 {
#define PG8_LAS __attribute__((address_space(3)))
typedef unsigned short bf16_t;
typedef short bf16x8 __attribute__((ext_vector_type(8)));
typedef float f32x4 __attribute__((ext_vector_type(4)));
typedef unsigned u32x4 __attribute__((ext_vector_type(4)));
constexpr int BM = 256, BK = 64, HALF = 128, HTB = HALF * BK * 2  , STAGE_BYTES = 8 * HTB, NXCD = 8, WGM = 8;

__host__ __device__ __forceinline__ int lds_byte(int r, int c) { const int st = (r >> 4) * 2 + (c >> 5), rr = r & 15, cc = c & 31, ob = rr * 64 + cc * 2; return st * 1024 + (ob ^ (((ob >> 9) & 1) << 5)); }
__host__ __device__ __forceinline__ void stage_rc(int b, int& R, int& C) { const int st = b / 1024, sb = b % 1024, swz = sb ^ (((sb >> 9) & 1) << 5); R = (st >> 1) * 16 + swz / 64; C = (st & 1) * 32 + (swz % 64) / 2; }
__host__ __device__ __forceinline__ int perm32(int rho) { const int n = rho >> 4, i = rho & 15; return 8 * (i >> 2) + 4 * n + (i & 3); }

struct Unit { int pm, pn; };
struct Gemm { const bf16_t* A; const bf16_t* Bt; int M, N, K; };

struct StaticOrder {
    int nM, nN, nwg, G, c;
    __host__ __device__ void init(int M, int N, int G_, int c_) { nM = M / BM; nN = N / BM; nwg = nM * nN; G = G_; c = c_; }
    __host__ __device__ bool next(int i, Unit& u) const {
        const long L = (long)i * G + c; if (L >= nwg) return false;
        int wgid = (int)L; { const int q = nwg / NXCD, r = nwg % NXCD, xcd = wgid % NXCD, off = wgid / NXCD; wgid = (xcd < r ? xcd * (q + 1) : r * (q + 1) + (xcd - r) * q) + off; }
        const int nig = WGM * nN, gid = wgid / nig, fm = gid * WGM, gsz = (nM - fm) < WGM ? (nM - fm) : WGM;
        u.pm = fm + ((wgid % nig) % gsz); u.pn = (wgid % nig) / gsz; return true;
    }
    __device__ __forceinline__ void a_ready(const Unit&) const {}
    __device__ __forceinline__ void done(const Unit&) const {}
};

__device__ __forceinline__ unsigned cvt_pk_bf16(float lo, float hi) { unsigned r; asm volatile("v_cvt_pk_bf16_f32 %0, %1, %2" : "=v"(r) : "v"(lo), "v"(hi)); return r; }
typedef float f32x2 __attribute__((ext_vector_type(2)));
__device__ __forceinline__ f32x2 gelu_pk(f32x2 v) {
    const f32x2 av = __builtin_elementwise_abs(v), d = av * 0.2316418882f + 1.0f;
    f32x2 t; t.x = __builtin_amdgcn_rcpf(d.x); t.y = __builtin_amdgcn_rcpf(d.y);
    f32x2 q = t * 0.5307027145f + (-0.7265760135f); q = q * t + 0.7107068705f; q = q * t + (-0.142248368f); q = q * t + 0.127414796f; q = q * t;
    const f32x2 s = (v * v) * (-0.72134752044f);
    f32x2 e; e.x = __builtin_amdgcn_exp2f(s.x); e.y = __builtin_amdgcn_exp2f(s.y);
    const f32x2 m = v * (q * e), r = v - m;
    f32x2 o; o.x = v.x < 0.f ? m.x : r.x; o.y = v.y < 0.f ? m.y : r.y; return o;
}

template <int ACT  > struct EpiBf16 {
    static constexpr bool PERM = true, AFTER_DRAIN = false; static_assert(ACT == 0 || ACT == 1, "EpiBf16: ACT is 0 (none) or 1 (gelu_pk)");
    bf16_t* O; int ldc; const float* bias; int split_cols; size_t split_stride; float scale0;
    __device__ __forceinline__ void operator()(const f32x4 (&acc)[2][2][4][2], const Unit& u, int wr, int wc, int fr, int fq) const {
        const int row0 = u.pm * BM + wr * 64 + fr; int colt = u.pn * BM; bf16_t* base = O;
        float sc = 1.f; if (split_cols) { const int t = colt / split_cols; base += (size_t)t * split_stride; colt -= t * split_cols; if (t == 0) sc = scale0; }
        const int col0 = colt + wc * 32 + 8 * fq, bcol0 = u.pn * BM + wc * 32 + 8 * fq;
        f32x4 bv[2][2];
#pragma unroll
        for (int bj = 0; bj < 2; ++bj)
#pragma unroll
            for (int n = 0; n < 2; ++n) bv[bj][n] = bias ? *(const f32x4*)(bias + bcol0 + bj * HALF + 4 * n) : (f32x4){0.f, 0.f, 0.f, 0.f};
#pragma unroll
        for (int ai = 0; ai < 2; ++ai)
#pragma unroll
            for (int m = 0; m < 4; ++m) { bf16_t* rowp = base + (size_t)(row0 + ai * HALF + m * 16) * ldc + col0;
#pragma unroll
                for (int bj = 0; bj < 2; ++bj) { f32x4 v0 = acc[ai][bj][m][0] + bv[bj][0], v1 = acc[ai][bj][m][1] + bv[bj][1];
                    if (ACT == 1) { f32x2 a = gelu_pk((f32x2){v0[0], v0[1]}), b = gelu_pk((f32x2){v0[2], v0[3]}), c = gelu_pk((f32x2){v1[0], v1[1]}), d = gelu_pk((f32x2){v1[2], v1[3]});
                        v0 = (f32x4){a.x, a.y, b.x, b.y}; v1 = (f32x4){c.x, c.y, d.x, d.y}; }
                    v0 = v0 * sc; v1 = v1 * sc; u32x4 w; w.x = cvt_pk_bf16(v0[0], v0[1]); w.y = cvt_pk_bf16(v0[2], v0[3]); w.z = cvt_pk_bf16(v1[0], v1[1]); w.w = cvt_pk_bf16(v1[2], v1[3]);
                    *(u32x4*)(rowp + bj * HALF) = w; } }
    }
};


template <class Epi, class Sched, bool ALIGN_EPI = false, bool SP2 = false>
__device__ __forceinline__ void gemm_phase(PG8_LAS unsigned char* lds, const Gemm g, const Sched& S, const Epi& E, const int tid) {
    const int wid = __builtin_amdgcn_readfirstlane(tid >> 6), lane = tid & 63, wr = wid >> 2, wc = wid & 3, fr = lane & 15, fq = lane >> 4;
    const int K = g.K, nt = K / BK;
    unsigned voffA[2], voffB[2];
#pragma unroll
    for (int i = 0; i < 2; ++i) { int R, C; stage_rc(tid * 16 + i * 8192, R, C); const int Rb = Epi::PERM ? ((R & ~31) + perm32(R & 31)) : R;
        voffA[i] = (unsigned)(R * K + C) * 2u; voffB[i] = (unsigned)(Rb * K + C) * 2u; }
    const size_t kstep = (size_t)(BK * 2);
    const size_t hstep = (size_t)HALF * K * 2;
    const size_t tstep = 2 * hstep;
    const unsigned ldsw = (unsigned)wid * 1024u;
    const int aoff = lds_byte(wr * 64 + fr, fq * 8), boff = lds_byte(wc * 32 + fr, fq * 8);
#define PG8_SA(b, h) (((b) * 2 + (h)) * HTB)
#define PG8_SB(b, h) ((4 + (b) * 2 + (h)) * HTB)
#define PG8_STAGE(bufoff, gbase, voff) do { _Pragma("unroll") for (int _i = 0; _i < 2; ++_i) \
        __builtin_amdgcn_global_load_lds((const unsigned*)((const char*)(gbase) + (voff)[_i]), (PG8_LAS unsigned*)(lds + (bufoff) + ldsw + _i * 8192), 16, 0, 0); } while (0)
#define PG8_LDA(dst, b, h) do { _Pragma("unroll") for (int m = 0; m < 4; ++m) _Pragma("unroll") for (int k = 0; k < 2; ++k) dst[m][k] = *(const PG8_LAS bf16x8*)(lds + PG8_SA(b, h) + aoff + m * 2048 + k * 1024); } while (0)
#define PG8_LDB(dst, b, h) do { _Pragma("unroll") for (int n = 0; n < 2; ++n) _Pragma("unroll") for (int k = 0; k < 2; ++k) dst[n][k] = *(const PG8_LAS bf16x8*)(lds + PG8_SB(b, h) + boff + n * 2048 + k * 1024); } while (0)
#define PG8_MMA(ai, bj, At, Bt) do { __builtin_amdgcn_s_setprio(1); _Pragma("unroll") for (int m = 0; m < 4; ++m) _Pragma("unroll") for (int n = 0; n < 2; ++n) _Pragma("unroll") for (int k = 0; k < 2; ++k) \
        acc[ai][bj][m][n] = __builtin_amdgcn_mfma_f32_16x16x32_bf16(Bt[n][k], At[m][k], acc[ai][bj][m][n], 0, 0, 0); __builtin_amdgcn_s_setprio(0); } while (0)
#define PG8_WAIT_V(n) asm volatile("s_waitcnt vmcnt(" #n ")" ::: "memory")
#define PG8_WAIT_L(n) asm volatile("s_waitcnt lgkmcnt(" #n ")" ::: "memory")
#define PG8_BAR __builtin_amdgcn_s_barrier()
#define PG8_SCHED __builtin_amdgcn_sched_barrier(0)
    Unit cur, nxt; int ui = 0;
    if (!S.next(0, cur)) return;
    f32x4 acc[2][2][4][2];
#pragma unroll
    for (int a = 0; a < 2; ++a)
#pragma unroll
        for (int b = 0; b < 2; ++b)
#pragma unroll
            for (int m = 0; m < 4; ++m)
#pragma unroll
                for (int n = 0; n < 2; ++n) acc[a][b][m][n] = (f32x4){0.f, 0.f, 0.f, 0.f};
    bf16x8 At[4][2], B0[2][2], B1[2][2];
    const char* cA = (const char*)g.A + (size_t)cur.pm * tstep; const char* cB = (const char*)g.Bt + (size_t)cur.pn * tstep;
    S.a_ready(cur);
    if constexpr (SP2) {
        PG8_STAGE(PG8_SB(0, 0), cB, voffB); PG8_STAGE(PG8_SB(0, 1), cB + hstep, voffB); PG8_STAGE(PG8_SA(0, 0), cA, voffA); PG8_STAGE(PG8_SA(0, 1), cA + hstep, voffA);
        if (wr == 1) PG8_BAR;
        PG8_WAIT_V(2); PG8_BAR;
        PG8_STAGE(PG8_SB(1, 0), cB + kstep, voffB); PG8_STAGE(PG8_SA(1, 0), cA + kstep, voffA); PG8_STAGE(PG8_SB(1, 1), cB + hstep + kstep, voffB);
        PG8_WAIT_V(6); PG8_BAR;
    } else {
        PG8_STAGE(PG8_SB(0, 0), cB, voffB); PG8_STAGE(PG8_SA(0, 0), cA, voffA); PG8_STAGE(PG8_SB(0, 1), cB + hstep, voffB); PG8_STAGE(PG8_SA(0, 1), cA + hstep, voffA);
        if (wr == 1) PG8_BAR;
        PG8_WAIT_V(4); PG8_BAR;
        PG8_STAGE(PG8_SB(1, 0), cB + kstep, voffB); PG8_STAGE(PG8_SA(1, 0), cA + kstep, voffA); PG8_STAGE(PG8_SB(1, 1), cB + hstep + kstep, voffB);
        PG8_WAIT_V(6); PG8_BAR;
    }
    for (;;) {
        const bool has_next = S.next(ui + 1, nxt);
        const char* nA = has_next ? (const char*)g.A + (size_t)nxt.pm * tstep : cA; const char* nB = has_next ? (const char*)g.Bt + (size_t)nxt.pn * tstep : cB;
        for (int t = 0; t < nt; t += 2) {
            const bool last = (t == nt - 2);
            const char* a1 = cA + (size_t)(t + 1) * kstep;
            const char* a2 = last ? nA : cA + (size_t)(t + 2) * kstep; const char* b2 = last ? nB : cB + (size_t)(t + 2) * kstep;
            const char* a3 = a2 + kstep; const char* b3 = b2 + kstep;
            if (last && has_next) S.a_ready(nxt);
            if constexpr (SP2) {
            PG8_LDB(B0, 0, 0); PG8_LDB(B1, 0, 1); PG8_SCHED; PG8_LDA(At, 0, 0); PG8_STAGE(PG8_SA(1, 1), a1 + hstep, voffA);
            PG8_WAIT_V(8); PG8_WAIT_L(0); PG8_BAR; PG8_MMA(0, 0, At, B0); PG8_MMA(0, 1, At, B1); PG8_BAR; PG8_SCHED;
            PG8_LDA(At, 0, 1); PG8_STAGE(PG8_SB(0, 0), b2, voffB); PG8_STAGE(PG8_SB(0, 1), b2 + hstep, voffB); PG8_STAGE(PG8_SA(0, 0), a2, voffA);
            PG8_WAIT_V(8); PG8_WAIT_L(0); PG8_BAR; PG8_MMA(1, 0, At, B0); PG8_MMA(1, 1, At, B1); PG8_BAR; PG8_SCHED;
            PG8_LDB(B0, 1, 0); PG8_LDB(B1, 1, 1); PG8_SCHED; PG8_LDA(At, 1, 0); PG8_STAGE(PG8_SA(0, 1), a2 + hstep, voffA);
            PG8_WAIT_V(8); PG8_WAIT_L(0); PG8_BAR; PG8_MMA(0, 0, At, B0); PG8_MMA(0, 1, At, B1); PG8_BAR; PG8_SCHED;
            PG8_LDA(At, 1, 1); PG8_STAGE(PG8_SB(1, 0), b3, voffB); PG8_STAGE(PG8_SB(1, 1), b3 + hstep, voffB); PG8_STAGE(PG8_SA(1, 0), a3, voffA);
            PG8_WAIT_V(8); PG8_WAIT_L(0); PG8_BAR; PG8_MMA(1, 0, At, B0); PG8_MMA(1, 1, At, B1); PG8_BAR; PG8_SCHED;
            } else {
            PG8_LDB(B0, 0, 0); PG8_SCHED; PG8_LDA(At, 0, 0); PG8_STAGE(PG8_SA(1, 1), a1 + hstep, voffA);
            PG8_WAIT_L(8); PG8_BAR; PG8_WAIT_L(0); PG8_MMA(0, 0, At, B0); PG8_BAR; PG8_SCHED;
            PG8_LDB(B1, 0, 1); PG8_STAGE(PG8_SB(0, 0), b2, voffB);
            PG8_BAR; PG8_WAIT_L(0); PG8_MMA(0, 1, At, B1); PG8_BAR;
            PG8_LDA(At, 0, 1); PG8_STAGE(PG8_SA(0, 0), a2, voffA);
            PG8_BAR; PG8_WAIT_L(0); PG8_MMA(1, 0, At, B0); PG8_BAR; PG8_SCHED;
            PG8_STAGE(PG8_SB(0, 1), b2 + hstep, voffB);
            PG8_WAIT_V(6); PG8_BAR; PG8_MMA(1, 1, At, B1); PG8_BAR;
            PG8_LDB(B0, 1, 0); PG8_SCHED; PG8_LDA(At, 1, 0); PG8_STAGE(PG8_SA(0, 1), a2 + hstep, voffA);
            PG8_WAIT_L(8); PG8_BAR; PG8_WAIT_L(0); PG8_MMA(0, 0, At, B0); PG8_BAR; PG8_SCHED;
            PG8_LDB(B1, 1, 1); PG8_STAGE(PG8_SB(1, 0), b3, voffB);
            PG8_BAR; PG8_WAIT_L(0); PG8_MMA(0, 1, At, B1); PG8_BAR;
            PG8_LDA(At, 1, 1); PG8_STAGE(PG8_SA(1, 0), a3, voffA);
            PG8_BAR; PG8_WAIT_L(0); PG8_MMA(1, 0, At, B0); PG8_BAR; PG8_SCHED;
            PG8_STAGE(PG8_SB(1, 1), b3 + hstep, voffB);
            PG8_WAIT_V(6); PG8_BAR; PG8_MMA(1, 1, At, B1); PG8_BAR;
            }
        }
        if constexpr (ALIGN_EPI) { if (wr == 0) PG8_BAR; }
        if constexpr (!Epi::AFTER_DRAIN) { E(acc, cur, wr, wc, fr, fq); S.done(cur); }
        if (!has_next) break;
#pragma unroll
        for (int a = 0; a < 2; ++a)
#pragma unroll
            for (int b = 0; b < 2; ++b)
#pragma unroll
                for (int m = 0; m < 4; ++m)
#pragma unroll
                    for (int n = 0; n < 2; ++n) acc[a][b][m][n] = (f32x4){0.f, 0.f, 0.f, 0.f};
        cur = nxt; cA = nA; cB = nB; ++ui;
        if constexpr (ALIGN_EPI) { if (wr == 1) PG8_BAR; }
    }
    PG8_WAIT_V(0);
    if constexpr (!ALIGN_EPI) { if (wr == 0) PG8_BAR; }
    PG8_BAR;
    if constexpr (Epi::AFTER_DRAIN) { E.fused(acc, cur, wr, wc, fr, fq, lds, wid, lane); S.done(cur); }
#undef PG8_SA
#undef PG8_SB
#undef PG8_STAGE
#undef PG8_LDA
#undef PG8_LDB
#undef PG8_MMA
#undef PG8_WAIT_V
#undef PG8_WAIT_L
#undef PG8_BAR
#undef PG8_SCHED
}
}
#define GAS __attribute__((address_space(1)))
#define LAS __attribute__((address_space(3)))
typedef unsigned short bf16;
typedef unsigned v4u __attribute__((ext_vector_type(4)));
typedef float f32x4 __attribute__((ext_vector_type(4)));
typedef short bf16x8 __attribute__((ext_vector_type(8)));
typedef GAS unsigned gu32;
typedef GAS unsigned long long gu64;
#define RLX_AGENT __ATOMIC_RELAXED, __HIP_MEMORY_SCOPE_AGENT
#define LDS_WAIT() asm volatile("s_waitcnt lgkmcnt(0)" ::: "memory")
#define VM_WAIT() asm volatile("s_waitcnt vmcnt(0)" ::: "memory")
__device__ __forceinline__ unsigned long long rt() { return __builtin_amdgcn_s_memrealtime(); }
__device__ __forceinline__ unsigned f2bf(float f) { unsigned u = __builtin_bit_cast(unsigned, f); return (u + 0x7fffu + ((u >> 16) & 1u)) >> 16; }
__device__ __forceinline__ unsigned pk2(float lo, float hi) { return f2bf(lo) | (f2bf(hi) << 16); }

#define XB_TMO      128
#define XB_XCNT(j)  (256  + 64 * (j))
#define XB_XSUB(j)  (1280 + 64 * (j))
#define XB_XGEN(j)  (2304 + 64 * (j))
#define XB_TOP      3328
#define XB_TOPGEN   3392
#define XCD_BAR_WORDS 3456
#define XB_SPIN_CAP (1u << 18)

__device__ __forceinline__ unsigned xb_ld(unsigned* p)              { return __hip_atomic_load(p, __ATOMIC_RELAXED, __HIP_MEMORY_SCOPE_AGENT); }
__device__ __forceinline__ unsigned xb_add(unsigned* p, unsigned v) { return __hip_atomic_fetch_add(p, v, __ATOMIC_RELAXED, __HIP_MEMORY_SCOPE_AGENT); }
__device__ __forceinline__ unsigned xb_xcc_id() { return (unsigned)__builtin_amdgcn_s_getreg((3 << 11) | 20) & 0xFu; }
#define XB_SPIN(cond, bar) do { unsigned _sp = 0; while (cond) { __builtin_amdgcn_s_sleep(1); \
    if ((++_sp & 255u) == 0u) { if (xb_ld(&(bar)[XB_TMO])) break; if (_sp > XB_SPIN_CAP) { atomicAdd(&(bar)[XB_TMO], 1u); break; } } } } while (0)

struct XcdBarrier {
    bool lead; unsigned* bar; unsigned x;
    volatile LAS unsigned* st;
};

__device__ __forceinline__ XcdBarrier xcd_barrier_post(unsigned* bar, volatile LAS unsigned* st) {
    XcdBarrier b; b.bar = bar; b.x = xb_xcc_id(); b.st = st;
    if (threadIdx.x == 0) st[2] = xb_add(&bar[XB_XCNT(b.x)], 1u);
    return b;
}
__device__ __forceinline__ void xcd_barrier_complete(unsigned* bar, unsigned x, unsigned& nloc, unsigned& nx) {
    const unsigned G = gridDim.x * gridDim.y * gridDim.z;
    unsigned sum, cnt, mine, sp = 0u;
    for (;;) {
        sum = 0u; cnt = 0u; mine = 0u;
#pragma unroll
        for (unsigned j = 0; j < 16; ++j) { const unsigned c = xb_ld(&bar[XB_XCNT(j)]); sum += c; cnt += (c > 0u) ? 1u : 0u; mine = (j == x) ? c : mine; }
        if (sum == G) break;
        __builtin_amdgcn_s_sleep(1);
        if ((++sp & 255u) == 0u) { if (xb_ld(&bar[XB_TMO])) break; if (sp > XB_SPIN_CAP) { atomicAdd(&bar[XB_TMO], 1u); break; } }
    }
    nloc = mine > 0u ? mine : 1u; nx = cnt > 0u ? cnt : 1u;
}

__device__ __forceinline__ void xcd_barrier(const XcdBarrier& b) {
    asm volatile("s_waitcnt vmcnt(0)" ::: "memory");
    __syncthreads();
    if (b.lead) {
        unsigned* bar = b.bar;
        __builtin_amdgcn_s_waitcnt(0);
        unsigned nloc = b.st[0], nx = b.st[1];
        if (nloc == 0u) { xcd_barrier_complete(bar, b.x, nloc, nx); b.st[0] = nloc; b.st[1] = nx; }
        const unsigned old = xb_add(&bar[XB_XSUB(b.x)], 1u);
        const unsigned gen = old / nloc;
        if (old + 1u == (gen + 1u) * nloc) {
            __builtin_amdgcn_fence(__ATOMIC_RELEASE, "agent");
            asm volatile("s_waitcnt vmcnt(0)" ::: "memory");
            const unsigned og = xb_add(&bar[XB_TOP], 1u);
            const unsigned tg = og / nx;
            if (og + 1u == (tg + 1u) * nx) xb_add(&bar[XB_TOPGEN], 1u);
            else XB_SPIN(xb_ld(&bar[XB_TOPGEN]) == tg, bar);
            __builtin_amdgcn_fence(__ATOMIC_ACQUIRE, "agent");
            xb_add(&bar[XB_XGEN(b.x)], 1u);
            asm volatile("s_waitcnt vmcnt(0)" ::: "memory");
        } else {
            XB_SPIN(xb_ld(&bar[XB_XGEN(b.x)]) == gen, bar);
            __builtin_amdgcn_fence(__ATOMIC_ACQUIRE, "agent");
            asm volatile("s_waitcnt vmcnt(0)" ::: "memory");
        }
    }
    __syncthreads();
}
#ifndef PG8_SP2
#define PG8_SP2 true
#endif
#ifndef PG8_ALIGN
#define PG8_ALIGN true
#endif
#ifndef DIS
#define DIS 0
#endif
#define EN(k) (!((DIS >> (k)) & 1))
#ifndef REPMASK
#define REPMASK 0
#endif
#define REP(k) ((((REPMASK) >> (k)) & 1) ? 2 : 1)
#ifndef SGREP
#define SGREP 1
#endif
#ifndef MK_PER_PHASE
#define MK_PER_PHASE 0
#endif

constexpr int NWAVES = 8, NTHR = 512;
constexpr int D = 1024, TP = 16384, TS = 512, T = TP + TS, NL = 2;
constexpr int INW = 3072, RW = 512, QS = 2048;
constexpr int PHD = 8, NSEL = 128;
constexpr float ALPHA = 1.4142135623730951f, LN_EPS = 1e-5f;
constexpr int PPL = 11, N_PHASES = 1 + PPL * 2;
constexpr size_t O_YP = 0, O_YS = 16777216, O_SRP = 17301504, O_CCP = 18350080, O_SRS = 18595840, O_CCS = 35373056, O_END = 39305216;
constexpr size_t MiB = 1u << 20;
constexpr size_t WS_CTL = 0, CTL_ZERO_BYTES = 1 * MiB;
constexpr size_t WS_ROPE = 1 * MiB;
constexpr size_t WS_WIN = 4 * MiB, WS_WOUT = 16 * MiB, WS_WQ = 20 * MiB, WS_KEYS = 28 * MiB;
constexpr size_t WS_UB = 32 * MiB, WS_VB = 64 * MiB;
constexpr size_t WS_SU = 3 * MiB, WS_SV = 3 * MiB + 131072;
constexpr size_t WS_GT = 96 * MiB, WS_XQ = 328 * MiB  , WS_SX = 3 * MiB + 524288, WS_CC = 363 * MiB;
static_assert(WS_CC + (size_t)16896 * 128 * 4 <= 377 * MiB, "CC inside the dead KV region");
constexpr size_t WS_CQ = 372 * MiB, WS_CS = 3 * MiB + 786432;
constexpr size_t WS_PD = 260 * MiB, WS_FF = 377 * MiB;
constexpr size_t WS_XB = 160 * MiB, WS_XF = 194 * MiB;
constexpr size_t WS_Q = 260 * MiB, WS_K = WS_Q + 1024, WS_V = WS_Q + 2048, WS_G = WS_Q + 3072, WS_U = 328 * MiB;
constexpr size_t WS_KV = 345 * MiB, WS_A2 = 377 * MiB, WS_Z1 = 411 * MiB, WS_X1B = 160 * MiB  , WS_END = 511 * MiB;
constexpr size_t WS_QP = WS_Q;
constexpr size_t WS_RI = 411 * MiB, WS_RG = 416 * MiB;
constexpr int CW_BAR = 4096;
constexpr int CW_XL = 49152;
constexpr int RING_BYTES = 131072, LDSCTL_OFF = 139264, MISC_OFF = LDSCTL_OFF + 320, LDS_BYTES = 147456;
constexpr int R1_LO = 2;
constexpr int PST = 272;

typedef float v4f __attribute__((ext_vector_type(4)));
typedef unsigned v2u __attribute__((ext_vector_type(2)));
typedef unsigned u32x4v __attribute__((ext_vector_type(4)));
typedef float f32x16 __attribute__((ext_vector_type(16)));

__device__ __forceinline__ float bflo(unsigned w) { return __uint_as_float(w << 16); }
__device__ __forceinline__ float bfhi(unsigned w) { return __uint_as_float(w & 0xffff0000u); }
__device__ __forceinline__ float bf2f(bf16 b) { return __uint_as_float((unsigned)b << 16); }
#define WAVE_REDUCE(OP) \
    v = OP(v, __builtin_bit_cast(float, __builtin_amdgcn_update_dpp(0, __builtin_bit_cast(int, v), 0xB1, 0xf, 0xf, false))); \
    v = OP(v, __builtin_bit_cast(float, __builtin_amdgcn_update_dpp(0, __builtin_bit_cast(int, v), 0x4E, 0xf, 0xf, false))); \
    v = OP(v, __builtin_bit_cast(float, __builtin_amdgcn_update_dpp(0, __builtin_bit_cast(int, v), 0x141, 0xf, 0xf, false))); \
    v = OP(v, __builtin_bit_cast(float, __builtin_amdgcn_update_dpp(0, __builtin_bit_cast(int, v), 0x128, 0xf, 0xf, false))); \
    { const unsigned a = __builtin_bit_cast(unsigned, v); const auto r = __builtin_amdgcn_permlane16_swap(a, a, false, false); unsigned r0 = r[0], r1 = r[1]; asm volatile("" : "+v"(r0), "+v"(r1)); v = OP(__builtin_bit_cast(float, r0), __builtin_bit_cast(float, r1)); } \
    { const unsigned a = __builtin_bit_cast(unsigned, v); const auto r = __builtin_amdgcn_permlane32_swap(a, a, false, false); unsigned r0 = r[0], r1 = r[1]; asm volatile("" : "+v"(r0), "+v"(r1)); v = OP(__builtin_bit_cast(float, r0), __builtin_bit_cast(float, r1)); }
__device__ __forceinline__ float wr_add(float a, float b) { return a + b; }
__device__ __forceinline__ float wave_sum(float v) { WAVE_REDUCE(wr_add) return v; }
__device__ __forceinline__ float wave_max(float v) { WAVE_REDUCE(fmaxf) return v; }
#undef WAVE_REDUCE
__device__ __forceinline__ float silu_f(float x) { return x / (1.f + __expf(-x)); }
__device__ __forceinline__ float l2gamma(int h) { return h == 0 ? -0.04580368961312479f : h == 1 ? -0.02272007650008353f : h == 2 ? -0.011315313227834146f : -0.005646563141142063f; }
__device__ __forceinline__ void unpack8(const v4u w, float (&f)[8]) {
    f[0] = bflo(w.x); f[1] = bfhi(w.x); f[2] = bflo(w.y); f[3] = bfhi(w.y); f[4] = bflo(w.z); f[5] = bfhi(w.z); f[6] = bflo(w.w); f[7] = bfhi(w.w);
}
typedef float f32x2_t __attribute__((ext_vector_type(2))); typedef __bf16 bf16x2_t __attribute__((ext_vector_type(2)));
__device__ __forceinline__ unsigned cvtpk(float lo, float hi) { f32x2_t v = {lo, hi}; bf16x2_t b = __builtin_convertvector(v, bf16x2_t); return __builtin_bit_cast(unsigned, b); }
__device__ __forceinline__ v4u pack8(const float (&f)[8]) { v4u w; w.x = pk2(f[0], f[1]); w.y = pk2(f[2], f[3]); w.z = pk2(f[4], f[5]); w.w = pk2(f[6], f[7]); return w; }

__device__ const double INV_FREQ[64] = {
1.0, 0.8659643233600653, 0.7498942093324559, 0.6493816315762113, 0.5623413251903491, 0.4869675251658631, 0.4216965034285822, 0.3651741272548377, 0.31622776601683794, 0.27384196342643613, 0.23713737056616552, 0.2053525026457146, 0.1778279410038923, 0.1539926526059492, 0.1333521432163324, 0.11547819846894582, 0.1, 0.08659643233600653, 0.07498942093324558, 0.06493816315762113, 0.05623413251903491, 0.04869675251658631, 0.042169650342858224, 0.03651741272548377, 0.03162277660168379, 0.027384196342643614, 0.023713737056616554, 0.02053525026457146, 0.01778279410038923, 0.01539926526059492, 0.01333521432163324, 0.011547819846894581, 0.01, 0.008659643233600654, 0.007498942093324558, 0.006493816315762113, 0.005623413251903491, 0.004869675251658631, 0.004216965034285823, 0.003651741272548377, 0.0031622776601683794, 0.0027384196342643613, 0.0023713737056616554, 0.002053525026457146, 0.0017782794100389228, 0.001539926526059492, 0.001333521432163324, 0.0011547819846894581, 0.001, 0.0008659643233600654, 0.0007498942093324559, 0.0006493816315762113, 0.0005623413251903491, 0.0004869675251658631, 0.00042169650342858224, 0.0003651741272548377, 0.00031622776601683794, 0.0002738419634264361, 0.00023713737056616554, 0.0002053525026457146, 0.00017782794100389227, 0.0001539926526059492, 0.0001333521432163324, 0.00011547819846894582};

__device__ __forceinline__ int inproj_slot(int c) {
    if (c < 1024) { const int reg = c >> 9, cc = c & 511, head = cc >> 7, half = (cc >> 6) & 1, dd = cc & 63; return reg * 512 + (head >> 1) * 256 + half * 128 + (head & 1) * 64 + dd; }
    if (c < 2048) return c;
    const int cg = (c >= 2560) ? 1 : 0, ch = (c - 2048) & 511;
    return 2048 + (ch >> 7) * 256 + cg * 128 + (ch & 127);
}
__device__ __forceinline__ void transpose_item(const float* W, int K, int N, bf16* WT, int k0, int n0s, int n0d, LAS float* scr, int lane) {
    float wv[32];
#pragma unroll
    for (int i = 0; i < 32; ++i) wv[i] = __builtin_nontemporal_load(W + (size_t)(k0 + 2 * i + (lane >> 5)) * N + n0s + (lane & 31));
#pragma unroll
    for (int i = 0; i < 32; ++i) scr[(2 * i + (lane >> 5)) * 33 + (lane & 31)] = wv[i];
    LDS_WAIT(); asm volatile("" ::: "memory");
    const int c = lane & 7;
#pragma unroll
    for (int j = 0; j < 4; ++j) { const int n = (lane >> 3) + 8 * j; const LAS float* s = scr + (8 * c) * 33 + n;
        v4u o; o.x = pk2(s[0 * 33], s[1 * 33]); o.y = pk2(s[2 * 33], s[3 * 33]); o.z = pk2(s[4 * 33], s[5 * 33]); o.w = pk2(s[6 * 33], s[7 * 33]);
        *(GAS v4u*)(WT + (size_t)(n0d + n) * K + k0 + 8 * c) = o; }
    LDS_WAIT(); asm volatile("" ::: "memory");
}
__device__ __forceinline__ void cvt_flat(const float* src, bf16* dst, size_t n, size_t gtid, size_t nthr) {
    for (size_t i = gtid * 8; i < n; i += nthr * 8) {
        const v4f a = __builtin_nontemporal_load((const v4f*)(src + i)), b = __builtin_nontemporal_load((const v4f*)(src + i + 4));
        v4u o; o.x = pk2(a.x, a.y); o.y = pk2(a.z, a.w); o.z = pk2(b.x, b.y); o.w = pk2(b.z, b.w);
        *(v4u*)(dst + i) = o;
    }
}

struct EpiInProj {
    static constexpr bool PERM = true, AFTER_DRAIN = false;
    const float* bias; bf16 *Q, *K, *V, *G, *U; const float *cosT, *sinT; float *ccp, *ccs;
    __device__ __forceinline__ void operator()(const pg8::f32x4 (&acc)[2][2][4][2], const pg8::Unit& u, int wr, int wc, int fr, int fq) const {
        const int s0 = wc * 32 + 8 * fq, pn = u.pn;
        const int rowb = u.pm * 256 + wr * 64 + fr;
        if (pn < 4) {
            const int reg = pn >> 1, head = 2 * (pn & 1) + (s0 >> 6), dd0 = s0 & 63;
            const int c0 = reg * 512 + head * 128 + dd0;
            float b0[8], b1[8];
            { const v4f x0 = *(const v4f*)(bias + c0), x1 = *(const v4f*)(bias + c0 + 4), y0 = *(const v4f*)(bias + c0 + 64), y1 = *(const v4f*)(bias + c0 + 68);
#pragma unroll
              for (int i = 0; i < 4; ++i) { b0[i] = x0[i]; b0[4 + i] = x1[i]; b1[i] = y0[i]; b1[4 + i] = y1[i]; } }
            bf16* dst = reg ? K : Q; const float sc = reg ? 0.08838834764831845f : 1.f;
#pragma unroll
            for (int ai = 0; ai < 2; ++ai)
#pragma unroll
                for (int m = 0; m < 4; ++m) {
                    const int row = rowb + ai * 128 + m * 16;
                    const int pidx = row < TP ? (row & 2047) : 2048 + ((row - TP) & 3);
                    const v4f c0v = *(const v4f*)(cosT + pidx * 64 + dd0), c1v = *(const v4f*)(cosT + pidx * 64 + dd0 + 4);
                    const v4f s0v = *(const v4f*)(sinT + pidx * 64 + dd0), s1v = *(const v4f*)(sinT + pidx * 64 + dd0 + 4);
                    float o1[8], o2[8];
#pragma unroll
                    for (int i = 0; i < 8; ++i) {
                        const float t1 = acc[ai][0][m][i >> 2][i & 3] + b0[i], t2 = acc[ai][1][m][i >> 2][i & 3] + b1[i];
                        const float cc = (i < 4) ? c0v[i & 3] : c1v[i & 3], ss = (i < 4) ? s0v[i & 3] : s1v[i & 3];
                        o1[i] = (t1 * cc - t2 * ss) * sc; o2[i] = (t1 * ss + t2 * cc) * sc;
                    }
                    bf16* p = dst + (size_t)row * QS + head * 128 + dd0;
                    *(v4u*)p = pack8(o1); *(v4u*)(p + 64) = pack8(o2);
                }
        } else if (pn < 8) {
            const bool isg = pn >= 6; bf16* dst = isg ? G : V;
#pragma unroll
            for (int bj = 0; bj < 2; ++bj) {
                const int c0 = 256 * pn + 128 * bj + s0, dcol = c0 - (isg ? 1536 : 1024);
                const v4f x0 = *(const v4f*)(bias + c0), x1 = *(const v4f*)(bias + c0 + 4);
#pragma unroll
                for (int ai = 0; ai < 2; ++ai)
#pragma unroll
                    for (int m = 0; m < 4; ++m) {
                        const int row = rowb + ai * 128 + m * 16;
                        float o[8];
#pragma unroll
                        for (int i = 0; i < 8; ++i) { float v = acc[ai][bj][m][i >> 2][i & 3] + ((i < 4) ? x0[i & 3] : x1[i & 3]); o[i] = isg ? silu_f(v) : v; }
                        *(v4u*)(dst + (size_t)row * QS + dcol) = pack8(o);
                    }
            }
        } else {
            const int ch0 = 128 * (pn - 8) + s0;
            const v4f a0 = *(const v4f*)(bias + 2048 + ch0), a1 = *(const v4f*)(bias + 2048 + ch0 + 4), g0 = *(const v4f*)(bias + 2560 + ch0), g1 = *(const v4f*)(bias + 2560 + ch0 + 4);
#pragma unroll
            for (int ai = 0; ai < 2; ++ai)
#pragma unroll
                for (int m = 0; m < 4; ++m) {
                    const int row = rowb + ai * 128 + m * 16;
                    float o[8];
#pragma unroll
                    for (int i = 0; i < 8; ++i) {
                        const float a = acc[ai][0][m][i >> 2][i & 3] + ((i < 4) ? a0[i & 3] : a1[i & 3]), g = acc[ai][1][m][i >> 2][i & 3] + ((i < 4) ? g0[i & 3] : g1[i & 3]);
                        o[i] = a / (1.f + __expf(-g));
                    }
                    *(v4u*)(U + (size_t)row * RW + ch0) = pack8(o);
                    float* cp = nullptr;
                    if (row < TP) { const int t = row & 2047; if (t >= 2018) cp = ccp + ((size_t)(row >> 11) * 30 + (t - 2018)) * 512 + ch0; }
                    else { const int rs = row - TP; cp = ccs + ((size_t)(rs >> 2) * 30 + 26 + (rs & 3)) * 512 + ch0; }
                    if (cp) { *(v4f*)cp = (v4f){o[0], o[1], o[2], o[3]}; *(v4f*)(cp + 4) = (v4f){o[4], o[5], o[6], o[7]}; }
                }
        }
    }
};
struct EpiOutProj {
    static constexpr bool PERM = true, AFTER_DRAIN = false;
    const float* res_f; const bf16* res_b; bf16* Z;
    __device__ __forceinline__ void operator()(const pg8::f32x4 (&acc)[2][2][4][2], const pg8::Unit& u, int wr, int wc, int fr, int fq) const {
        const int col0 = u.pn * 256 + wc * 32 + 8 * fq;
#pragma unroll
        for (int ai = 0; ai < 2; ++ai)
#pragma unroll
            for (int m = 0; m < 4; ++m) {
                const size_t ro = (size_t)(u.pm * 256 + ai * 128 + wr * 64 + m * 16 + fr) * D;
#pragma unroll
                for (int bj = 0; bj < 2; ++bj) { const size_t o = ro + col0 + bj * 128; float r8[8];
                    if (res_f) { const v4f a = *(const v4f*)(res_f + o), b = *(const v4f*)(res_f + o + 4); r8[0] = a.x; r8[1] = a.y; r8[2] = a.z; r8[3] = a.w; r8[4] = b.x; r8[5] = b.y; r8[6] = b.z; r8[7] = b.w; }
                    else unpack8(*(const v4u*)(res_b + o), r8);
                    v4u w; w.x = cvtpk(ALPHA * r8[0] + acc[ai][bj][m][0][0], ALPHA * r8[1] + acc[ai][bj][m][0][1]); w.y = cvtpk(ALPHA * r8[2] + acc[ai][bj][m][0][2], ALPHA * r8[3] + acc[ai][bj][m][0][3]);
                    w.z = cvtpk(ALPHA * r8[4] + acc[ai][bj][m][1][0], ALPHA * r8[5] + acc[ai][bj][m][1][1]); w.w = cvtpk(ALPHA * r8[6] + acc[ai][bj][m][1][2], ALPHA * r8[7] + acc[ai][bj][m][1][3]);
                    *(v4u*)(Z + o) = w; }
            }
    }
};
__device__ __forceinline__ unsigned sg_off(int row, int ch) { return (unsigned)(row * 128 + ((ch ^ ((row >> 1) & 7)) << 4)); }
template <class EpiS> __device__ __forceinline__ void sgemm_unit(LAS unsigned char* lds, const bf16* A, const bf16* Bt, int pn, int row0, const EpiS& E, int tid) {
    const int lane = tid & 63, wave = __builtin_amdgcn_readfirstlane(tid >> 6), r = lane & 31, hl = lane >> 5, mt = wave >> 2, nq = wave & 3;
    const int srow = tid >> 3, sch = tid & 7;
    const unsigned char* ag = (const unsigned char*)(A + (size_t)(row0 + srow) * D) + sch * 16;
    const unsigned char* bg = (const unsigned char*)(Bt + (size_t)(pn * 256 + srow) * D) + sch * 16;
    v4u ra0, ra1, ra2, ra3, rb0[4], rb1[4], rb2[4], rb3[4];
#define SG_LOAD(RA, RB, kc) do { RA = *(const v4u*)(ag + (kc) * 128); _Pragma("unroll") for (int q = 0; q < 4; ++q) RB[q] = *(const v4u*)(bg + (size_t)q * 64 * D * 2 + (kc) * 128); } while (0)
    SG_LOAD(ra0, rb0, 0); SG_LOAD(ra1, rb1, 1); SG_LOAD(ra2, rb2, 2); SG_LOAD(ra3, rb3, 3);
    f32x16 acc0, acc1;
#pragma unroll
    for (int i = 0; i < 16; ++i) { acc0[i] = 0.f; acc1[i] = 0.f; }
#define SG_STAGE(RA, RB, kc) do { LAS unsigned char* buf = lds + ((kc) & 1) * 40960; \
        *(LAS v4u*)(buf + sg_off(srow, sch)) = RA; _Pragma("unroll") for (int q = 0; q < 4; ++q) *(LAS v4u*)(buf + 8192 + sg_off(64 * q + srow, sch)) = RB[q]; \
        if ((kc) + 4 < 16) SG_LOAD(RA, RB, (kc) + 4); \
        __syncthreads(); \
        _Pragma("unroll") for (int ks = 0; ks < 4; ++ks) { const bf16x8 a = *(const LAS bf16x8*)(buf + sg_off(32 * mt + r, 2 * ks + hl)); \
            const bf16x8 x0 = *(const LAS bf16x8*)(buf + 8192 + sg_off(32 * nq + r, 2 * ks + hl)), x1 = *(const LAS bf16x8*)(buf + 8192 + sg_off(128 + 32 * nq + r, 2 * ks + hl)); \
            acc0 = __builtin_amdgcn_mfma_f32_32x32x16_bf16(a, x0, acc0, 0, 0, 0); acc1 = __builtin_amdgcn_mfma_f32_32x32x16_bf16(a, x1, acc1, 0, 0, 0); } } while (0)
#pragma unroll 1
    for (int kc = 0; kc < 16; kc += 4) { SG_STAGE(ra0, rb0, kc); SG_STAGE(ra1, rb1, kc + 1); SG_STAGE(ra2, rb2, kc + 2); SG_STAGE(ra3, rb3, kc + 3); }
#undef SG_STAGE
#undef SG_LOAD
#pragma unroll
    for (int i = 0; i < 16; ++i) E(row0 + 32 * mt + (i & 3) + 8 * (i >> 2) + 4 * hl, pn, 32 * nq + r, acc0[i], acc1[i]);
    __syncthreads();
}
struct SEpiInProj {
    const float* bias; bf16 *Q, *K, *V, *G, *U; const float *cosT, *sinT; float* ccs;
    __device__ __forceinline__ void operator()(int row, int pn, int s, float v0, float v1) const {
        if (pn < 4) { const int reg = pn >> 1, head = 2 * (pn & 1) + (s >> 6), dd = s & 63, c0 = reg * 512 + head * 128 + dd, pidx = 2048 + ((row - TP) & 3);
            const float t1 = v0 + bias[c0], t2 = v1 + bias[c0 + 64], cc = cosT[pidx * 64 + dd], ss = sinT[pidx * 64 + dd], sc = reg ? 0.08838834764831845f : 1.f;
            bf16* p = (reg ? K : Q) + (size_t)row * QS + head * 128 + dd; p[0] = (bf16)(cvtpk((t1 * cc - t2 * ss) * sc, 0.f) & 0xffffu); p[64] = (bf16)(cvtpk((t1 * ss + t2 * cc) * sc, 0.f) & 0xffffu);
        } else if (pn < 8) { const bool isg = pn >= 6; bf16* dst = (isg ? G : V) + (size_t)row * QS + (256 * pn - (isg ? 1536 : 1024)) + s;
            const float a = v0 + bias[256 * pn + s], b = v1 + bias[256 * pn + 128 + s];
            dst[0] = (bf16)(cvtpk(isg ? silu_f(a) : a, 0.f) & 0xffffu); dst[128] = (bf16)(cvtpk(isg ? silu_f(b) : b, 0.f) & 0xffffu);
        } else { const int ch = 128 * (pn - 8) + s; const float a = v0 + bias[2048 + ch], g = v1 + bias[2560 + ch], u = a / (1.f + __expf(-g));
            U[(size_t)row * RW + ch] = (bf16)(cvtpk(u, 0.f) & 0xffffu); const int rs = row - TP; ccs[((size_t)(rs >> 2) * 30 + 26 + (rs & 3)) * 512 + ch] = u; }
    }
};
struct SEpiOutProj { const float* res_f; const bf16* res_b; bf16* Z;
    __device__ __forceinline__ void operator()(int row, int pn, int s, float v0, float v1) const { const size_t o = (size_t)row * D + pn * 256 + s;
        const float r0 = res_f ? res_f[o] : bf2f(res_b[o]), r1 = res_f ? res_f[o + 128] : bf2f(res_b[o + 128]);
        Z[o] = (bf16)(cvtpk(ALPHA * r0 + v0, 0.f) & 0xffffu); Z[o + 128] = (bf16)(cvtpk(ALPHA * r1 + v1, 0.f) & 0xffffu); } };
struct SEpiQ { bf16* QP;
    __device__ __forceinline__ void operator()(int row, int pn, int s, float v0, float v1) const { bf16* p = QP + (size_t)row * 2048 + pn * 256 + s; p[0] = (bf16)(cvtpk(v0, 0.f) & 0xffffu); p[128] = (bf16)(cvtpk(v1, 0.f) & 0xffffu); } };

struct OrderM {
    int nM, nN, nwg, G, c, mult;
    __device__ void init(int M, int N, int G_, int c_, int mult_) { nM = M / pg8::BM; nN = N / pg8::BM; nwg = nM * nN; G = G_; c = c_; mult = mult_; }
    __device__ bool next(int i, pg8::Unit& u) const {
        const long L = (long)i * G + c; if (L >= (long)nwg * mult) return false;
        int wgid = (int)(L % nwg); { const int q = nwg / pg8::NXCD, r = nwg % pg8::NXCD, xcd = wgid % pg8::NXCD, off = wgid / pg8::NXCD; wgid = (xcd < r ? xcd * (q + 1) : r * (q + 1) + (xcd - r) * q) + off; }
        const int nig = pg8::WGM * nN, gid = wgid / nig, fm = gid * pg8::WGM, gsz = (nM - fm) < pg8::WGM ? (nM - fm) : pg8::WGM;
        u.pm = fm + ((wgid % nig) % gsz); u.pn = (wgid % nig) / gsz; return true;
    }
    __device__ __forceinline__ void a_ready(const pg8::Unit&) const {}
    __device__ __forceinline__ void done(const pg8::Unit&) const {}
};
__device__ __forceinline__ void load_tile128(LAS unsigned char* dst, int stride, const bf16* src, size_t row0, int coff, int tid) {
#pragma unroll
    for (int i = 0; i < 4; ++i) { const int idx = tid + 512 * i, j = idx >> 4, c16 = idx & 15;
        *(LAS v4u*)(dst + j * stride + c16 * 16) = *(const v4u*)(src + (row0 + j) * RW + coff + c16 * 8); }
}
typedef short s16x4 __attribute__((ext_vector_type(4)));
typedef short v4i16_t __attribute__((ext_vector_type(4)));
__device__ __forceinline__ unsigned offb(unsigned row, unsigned ch) { return 256u * row + 16u * (ch ^ (((row & 3u) << 2) | ((row >> 2) & 3u))); }
__device__ __forceinline__ s16x4 trrd(LAS unsigned char* p) { return __builtin_bit_cast(s16x4, __builtin_amdgcn_ds_read_tr16_b64_v4i16((LAS v4i16_t*)p)); }
__device__ __forceinline__ bf16x8 tr_frag(LAS unsigned char* img, int rowlo, int rowhi, int c, int lane) {
    const unsigned blk = (lane >> 4) & 1, q = (lane & 15) >> 2, p = lane & 3, ch = 4 * c + 2 * blk + (p >> 1), o8 = 8 * (p & 1);
    const s16x4 lo = trrd(img + offb(rowlo + q, ch) + o8), hi = trrd(img + offb(rowhi + q, ch) + o8);
    return __builtin_shufflevector(lo, hi, 0, 1, 2, 3, 4, 5, 6, 7);
}
__device__ __forceinline__ bf16x8 row_frag(LAS unsigned char* img, int row0, int ks, int lane) { return *(const LAS bf16x8*)(img + offb(row0 + (lane & 31), 2 * ks + (lane >> 5))); }
__device__ __forceinline__ int crow16(int i, int hl) { return (i & 3) + 8 * (i >> 2) + 4 * hl; }
__device__ __forceinline__ void stage_tile(LAS unsigned char* img, const bf16* src, size_t row0, int coff, float rsc0, float rsc1, bool scaled, int tid, int stride = RW) {
#pragma unroll
    for (int i = 0; i < 4; ++i) { const int idx = tid + 512 * i, j = idx >> 4, ch = idx & 15;
        v4u w = *(const v4u*)(src + (row0 + j) * stride + coff + ch * 8);
        if (scaled) { const float sc = exp2f(rsc0 + (float)j * rsc1); float f[8]; unpack8(w, f);
            w.x = cvtpk(f[0] * sc, f[1] * sc); w.y = cvtpk(f[2] * sc, f[3] * sc); w.z = cvtpk(f[4] * sc, f[5] * sc); w.w = cvtpk(f[6] * sc, f[7] * sc); }
        *(LAS v4u*)(img + offb(j, ch)) = w; }
}
__device__ __forceinline__ void tile_load(v4u (&w)[4], const bf16* src, size_t row0, int coff, int tid, int stride = RW) {
#pragma unroll
    for (int i = 0; i < 4; ++i) { const int idx = tid + 512 * i, j = idx >> 4, ch = idx & 15; w[i] = *(const v4u*)(src + (row0 + j) * stride + coff + ch * 8); }
}
__device__ __forceinline__ void tile_store(LAS unsigned char* img, const v4u (&win)[4], float rsc0, float rsc1, bool scaled, int tid) {
#pragma unroll
    for (int i = 0; i < 4; ++i) { const int idx = tid + 512 * i, j = idx >> 4, ch = idx & 15; v4u w = win[i];
        if (scaled) { const float sc = exp2f(rsc0 + (float)j * rsc1); float f[8]; unpack8(w, f);
            w.x = cvtpk(f[0] * sc, f[1] * sc); w.y = cvtpk(f[2] * sc, f[3] * sc); w.z = cvtpk(f[4] * sc, f[5] * sc); w.w = cvtpk(f[6] * sc, f[7] * sc); }
        *(LAS v4u*)(img + offb(j, ch)) = w; }
}
__device__ __forceinline__ void st_state_bf16(bf16* dst, const f32x16 (&run)[2], int mt, int ntb, int r, int hl) {
    const bool odd = (r & 1) != 0;
#pragma unroll
    for (int t = 0; t < 2; ++t)
#pragma unroll
        for (int i = 0; i < 16; i += 2) {
            const float a0 = run[t][i], a1 = run[t][i + 1];
            const float b0 = __builtin_bit_cast(float, __builtin_amdgcn_update_dpp(0, __builtin_bit_cast(int, a0), 0xB1, 0xf, 0xf, false));
            const float b1 = __builtin_bit_cast(float, __builtin_amdgcn_update_dpp(0, __builtin_bit_cast(int, a1), 0xB1, 0xf, 0xf, false));
            const unsigned w = odd ? cvtpk(b1, a1) : cvtpk(a0, b0);
            const int row = 32 * mt + (odd ? crow16(i + 1, hl) : crow16(i, hl));
            *(unsigned*)(dst + row * 128 + 32 * (ntb + t) + (r & 30)) = w; }
}
__device__ __forceinline__ void kvgroup_unit(LAS unsigned char* lds, int gu, const bf16* Kb, const bf16* Vb, bf16* LP, bf16* GT, int tid) {
    const int h = gu & 3, g = (gu >> 2) & 3, b = gu >> 4, lane = tid & 63, wave = __builtin_amdgcn_readfirstlane(tid >> 6), r = lane & 31, hl = lane >> 5;
    const int mt = wave >> 1, ntb = (wave & 1) * 2; const float lg2 = l2gamma(h), cd = exp2f(128.f * lg2);
    LAS unsigned char* Ks = lds; LAS unsigned char* Vs = lds + 32768;
    f32x16 run[2];
#pragma unroll
    for (int t = 0; t < 2; ++t)
#pragma unroll
        for (int i = 0; i < 16; ++i) run[t][i] = 0.f;
    v4u kw[4], vw[4];
    tile_load(kw, Kb, (size_t)(b * 16 + 4 * g) * 128, h * 128, tid, QS); tile_load(vw, Vb, (size_t)(b * 16 + 4 * g) * 128, h * 128, tid, QS);
#pragma unroll 1
    for (int rr = 0; rr < 4; ++rr) {
        const int n = 4 * g + rr;
        tile_store(Ks, kw, 127.f * lg2, -lg2, true, tid); tile_store(Vs, vw, 0.f, 0.f, false, tid);
        if (rr < 3) { tile_load(kw, Kb, (size_t)(b * 16 + n + 1) * 128, h * 128, tid, QS); tile_load(vw, Vb, (size_t)(b * 16 + n + 1) * 128, h * 128, tid, QS); }
        __syncthreads();
        if (rr > 0) st_state_bf16(LP + (size_t)((b * 16 + n) * 4 + h) * 16384, run, mt, ntb, r, hl);
        f32x16 acc[2];
#pragma unroll
        for (int t = 0; t < 2; ++t)
#pragma unroll
            for (int i = 0; i < 16; ++i) acc[t][i] = 0.f;
#pragma unroll
        for (int ks = 0; ks < 8; ++ks) { const bf16x8 a = tr_frag(Ks, 16 * ks + 8 * hl, 16 * ks + 8 * hl + 4, mt, lane);
#pragma unroll
            for (int t = 0; t < 2; ++t) { const bf16x8 bb = tr_frag(Vs, 16 * ks + 8 * hl, 16 * ks + 8 * hl + 4, ntb + t, lane); acc[t] = __builtin_amdgcn_mfma_f32_32x32x16_bf16(a, bb, acc[t], 0, 0, 0); } }
#pragma unroll
        for (int t = 0; t < 2; ++t)
#pragma unroll
            for (int i = 0; i < 16; ++i) run[t][i] = run[t][i] * cd + acc[t][i];
        __syncthreads();
    }
    st_state_bf16(GT + (size_t)gu * 16384, run, mt, ntb, r, hl);
}
__device__ __forceinline__ void sample_pair_unit(LAS unsigned char* lds, int pu, int l, const bf16* Qb, const bf16* Kb, const bf16* Vb, const bf16* Gb, const float* state_in, float* state_out, bf16* A2, int tid) {
    const int half = tid >> 8, ht = tid & 255, lane = tid & 63, dq = (tid >> 6) & 3;
    const int su = 2 * pu + half, b = su >> 2, h = su & 3, row0 = TP + 4 * b;
    LAS float* base = (LAS float*)(lds + half * 16384);
    LAS float* qT = base;
    LAS float* kT = base + 512;
    LAS float* vs = base + 1024;
    LAS float* sc = base + 1536;
    LAS float* part = base + 1600;
    if (ht < 192) { const int which = ht >> 6, t = (ht >> 4) & 3, ch = ht & 15;
        const bf16* src = which == 0 ? Qb : which == 1 ? Kb : Vb; float f[8]; unpack8(*(const v4u*)(src + (size_t)(row0 + t) * QS + h * 128 + ch * 8), f);
        if (which == 2) {
#pragma unroll
            for (int x = 0; x < 8; ++x) vs[t * 128 + ch * 8 + x] = f[x];
        } else { LAS float* dst = which == 0 ? qT : kT;
#pragma unroll
            for (int x = 0; x < 8; ++x) dst[(ch * 8 + x) * 4 + t] = f[x]; } }
    __syncthreads();
    const float lg2 = l2gamma(h);
    {
        const v4f qa = *(const LAS v4f*)(qT + (2 * lane) * 4), qb = *(const LAS v4f*)(qT + (2 * lane + 1) * 4), ka = *(const LAS v4f*)(kT + (2 * lane) * 4), kb = *(const LAS v4f*)(kT + (2 * lane + 1) * 4);
        const float qx = dq == 0 ? qa.x : dq == 1 ? qa.y : dq == 2 ? qa.z : qa.w, qy = dq == 0 ? qb.x : dq == 1 ? qb.y : dq == 2 ? qb.z : qb.w;
#pragma unroll
        for (int jj = 0; jj < 4; ++jj) { float sp = qx * ka[jj] + qy * kb[jj]; sp = wave_sum(sp); if (lane == 0) sc[dq * 4 + jj] = (jj <= dq) ? sp * exp2f((float)(dq - jj) * lg2) : 0.f; }
    }
    const size_t sbase = ((size_t)(l * 128 + b) * 4 + h) * 16384;
    const float g4 = exp2f(4.f * lg2), g3 = exp2f(3.f * lg2), g2 = exp2f(2.f * lg2), g1 = exp2f(lg2);
    float vt[4][2], cross[4][2];
#pragma unroll
    for (int t = 0; t < 4; ++t) { vt[t][0] = vs[t * 128 + 2 * lane]; vt[t][1] = vs[t * 128 + 2 * lane + 1]; cross[t][0] = 0.f; cross[t][1] = 0.f; }
    typedef float v2f __attribute__((ext_vector_type(2)));
#pragma unroll 1
    for (int db = 0; db < 32; db += 16) {
    v2f rin[16];
#pragma unroll
    for (int dd = 0; dd < 16; ++dd) rin[dd] = __builtin_nontemporal_load((const v2f*)(state_in + sbase + (size_t)(32 * dq + db + dd) * 128 + 2 * lane));
#pragma unroll
    for (int dd = 0; dd < 16; ++dd) { const int d = 32 * dq + db + dd;
        const v2f r = rin[dd];
        const v4f q4 = *(const LAS v4f*)(qT + d * 4), k4 = *(const LAS v4f*)(kT + d * 4);
        const float k0 = k4.x * g3, k1 = k4.y * g2, k2 = k4.z * g1, k3 = k4.w;
        v2f rn;
#pragma unroll
        for (int c = 0; c < 2; ++c) { cross[0][c] += q4.x * r[c]; cross[1][c] += q4.y * r[c]; cross[2][c] += q4.z * r[c]; cross[3][c] += q4.w * r[c];
            rn[c] = g4 * r[c] + (k0 * vt[0][c] + k1 * vt[1][c] + k2 * vt[2][c] + k3 * vt[3][c]); }
        __builtin_nontemporal_store(rn, (v2f*)(state_out + sbase + (size_t)d * 128 + 2 * lane)); }
    }
#pragma unroll
    for (int t = 0; t < 4; ++t) *(LAS v2f*)(part + (dq * 4 + t) * 128 + 2 * lane) = (v2f){cross[t][0], cross[t][1]};
    __syncthreads();
    {   const int t = dq; float o[2];
#pragma unroll
        for (int c = 0; c < 2; ++c) { const int e = 2 * lane + c; float oc = 0.f;
#pragma unroll
            for (int q = 0; q < 4; ++q) oc += part[(q * 4 + t) * 128 + e];
            float oi = 0.f;
#pragma unroll
            for (int jj = 0; jj < 4; ++jj) oi += sc[t * 4 + jj] * vs[jj * 128 + e];
            o[c] = oi + exp2f((float)(t + 1) * lg2) * oc; }
        const float mean = wave_sum(o[0] + o[1]) * (1.f / 128.f), d0 = o[0] - mean, d1 = o[1] - mean;
        const float rstd = rsqrtf(wave_sum(d0 * d0 + d1 * d1) * (1.f / 128.f) + LN_EPS);
        const int row = row0 + t; const unsigned gw2 = *(const unsigned*)(Gb + (size_t)row * QS + h * 128 + 2 * lane);
        *(unsigned*)(A2 + (size_t)row * D + h * 128 + 2 * lane) = cvtpk(d0 * rstd * bflo(gw2), d1 * rstd * bfhi(gw2)); }
    __syncthreads();
}
template <int NT> __device__ __forceinline__ void conv_unit(LAS unsigned char* lds, int cu, int l, const bf16* Ub, const float* cache_in, const float* dwk, const float* dwb, const float* lng, const float* lnb, bf16* A2, int tid) {
    constexpr int NR = NT + 30;
    LAS unsigned char* us = lds; LAS float* ys = (LAS float*)(lds + 65536);
    const int lane = tid & 63, wave = __builtin_amdgcn_readfirstlane(tid >> 6);
    int row0;
    if (NT == 32) { row0 = cu * 32; const int t0 = row0 & 2047;
        v4u w[(NR * 64 + NTHR - 1) / NTHR];
#pragma unroll
        for (int it = 0; it < (NR * 64 + NTHR - 1) / NTHR; ++it) { const int idx = tid + it * NTHR, i = idx >> 6, ch = idx & 63; w[it] = (v4u){0u, 0u, 0u, 0u};
            if (idx < NR * 64 && t0 - 30 + i >= 0) w[it] = *(const v4u*)(Ub + (size_t)(row0 - 30 + i) * RW + ch * 8); }
#pragma unroll
        for (int it = 0; it < (NR * 64 + NTHR - 1) / NTHR; ++it) { const int idx = tid + it * NTHR, i = idx >> 6, ch = idx & 63; if (idx < NR * 64) *(LAS v4u*)(us + i * 1024 + ch * 16) = w[it]; }
    } else { row0 = TP + 4 * cu;
        for (int idx = tid; idx < NR * 64; idx += NTHR) { const int i = idx >> 6, ch = idx & 63; v4u w;
            if (i < 30) { const float* cp = cache_in + ((size_t)(l * 128 + cu) * 30 + i) * 512 + ch * 8; const v4f a = *(const v4f*)cp, b = *(const v4f*)(cp + 4);
                w.x = cvtpk(a.x, a.y); w.y = cvtpk(a.z, a.w); w.z = cvtpk(b.x, b.y); w.w = cvtpk(b.z, b.w); }
            else w = *(const v4u*)(Ub + (size_t)(row0 + i - 30) * RW + ch * 8);
            *(LAS v4u*)(us + i * 1024 + ch * 16) = w; }
    }
    float wk[31];
#pragma unroll
    for (int k = 0; k < 31; ++k) wk[k] = dwk[k * 512 + tid];
    const float bb = dwb[tid];
    __syncthreads();
    constexpr int CT = (NT < 8) ? NT : 8;
#pragma unroll 1
    for (int c0 = 0; c0 < NT; c0 += CT) {
        float y[CT];
#pragma unroll
        for (int t = 0; t < CT; ++t) y[t] = bb;
#pragma unroll
        for (int i = 0; i < CT + 30; ++i) { const float val = bf2f(*(const LAS bf16*)(us + (c0 + i) * 1024 + tid * 2));
#pragma unroll
            for (int t = 0; t < CT; ++t) { if (i - t >= 0 && i - t < 31) y[t] += wk[i - t] * val; } }
#pragma unroll
        for (int t = 0; t < CT; ++t) ys[(c0 + t) * 512 + tid] = y[t];
    }
    __syncthreads();
    constexpr int TPW = (NT + 7) / 8;
    const v4f ga = *(const v4f*)(lng + 4 * lane), gb = *(const v4f*)(lng + 256 + 4 * lane), ba = *(const v4f*)(lnb + 4 * lane), bbv = *(const v4f*)(lnb + 256 + 4 * lane);
#pragma unroll
    for (int tt = 0; tt < TPW; ++tt) { const int t = wave * TPW + tt;
        if (t < NT) {
            v4f a = *(const LAS v4f*)(ys + t * 512 + 4 * lane), b = *(const LAS v4f*)(ys + t * 512 + 256 + 4 * lane);
            const float mean = wave_sum((a.x + a.y) + (a.z + a.w) + (b.x + b.y) + (b.z + b.w)) * (1.f / 512.f);
            a = a - mean; b = b - mean;
            const float rstd = rsqrtf(wave_sum((a.x * a.x + a.y * a.y) + (a.z * a.z + a.w * a.w) + (b.x * b.x + b.y * b.y) + (b.z * b.z + b.w * b.w)) * (1.f / 512.f) + LN_EPS);
            a = a * rstd * ga + ba; b = b * rstd * gb + bbv;
            v2u wa, wb; wa.x = cvtpk(silu_f(a.x), silu_f(a.y)); wa.y = cvtpk(silu_f(a.z), silu_f(a.w)); wb.x = cvtpk(silu_f(b.x), silu_f(b.y)); wb.y = cvtpk(silu_f(b.z), silu_f(b.w));
            bf16* op = A2 + (size_t)(row0 + t) * D + 512 + 4 * lane; *(v2u*)op = wa; *(v2u*)(op + 256) = wb; }
    }
    __syncthreads();
}
__device__ __forceinline__ float sum32_f(float v) {
    v += __builtin_bit_cast(float, __builtin_amdgcn_update_dpp(0, __builtin_bit_cast(int, v), 0xB1, 0xf, 0xf, false));
    v += __builtin_bit_cast(float, __builtin_amdgcn_update_dpp(0, __builtin_bit_cast(int, v), 0x4E, 0xf, 0xf, false));
    v += __builtin_bit_cast(float, __builtin_amdgcn_update_dpp(0, __builtin_bit_cast(int, v), 0x141, 0xf, 0xf, false));
    v += __builtin_bit_cast(float, __builtin_amdgcn_update_dpp(0, __builtin_bit_cast(int, v), 0x128, 0xf, 0xf, false));
    { const unsigned a = __builtin_bit_cast(unsigned, v); const auto r = __builtin_amdgcn_permlane16_swap(a, a, false, false); unsigned r0 = r[0], r1 = r[1]; asm volatile("" : "+v"(r0), "+v"(r1)); v = __builtin_bit_cast(float, r0) + __builtin_bit_cast(float, r1); }
    return v;
}
__device__ __forceinline__ void ret_unit(LAS unsigned char* lds, int uidx, int l, const bf16* Qb, const bf16* Kb, const bf16* Vb, const bf16* Gb, const bf16* LP, const bf16* GT, float* state_out, bf16* A2, int tid) {
    const int h = uidx & 3, bn = uidx >> 2, n = bn & 15, b = bn >> 4, g = n >> 2, rr = n & 3; const size_t row0 = (size_t)bn * 128;
    const int lane = tid & 63, wave = __builtin_amdgcn_readfirstlane(tid >> 6), r = lane & 31, hl = lane >> 5, s = wave & 3, eh = wave >> 2;
    LAS unsigned char* Qs = lds; LAS unsigned char* Ks = lds + 32768; LAS unsigned char* Vs = lds + 65536; LAS float* stat = (LAS float*)(lds + 98304);
    const float lg2 = l2gamma(h);
    LAS unsigned char* Rs = lds + 100352;
    v4u qw[4], kw[4], vw[4];
    tile_load(qw, Qb, row0, h * 128, tid, QS); tile_load(kw, Kb, row0, h * 128, tid, QS); tile_load(vw, Vb, row0, h * 128, tid, QS);
    {
        const int d = tid >> 2, e0 = (tid & 3) * 32; const float cd4 = exp2f(512.f * lg2), gam = exp2f(lg2), cr = exp2f((float)(128 * rr) * lg2);
        const float w2 = (g > 2) ? 1.f : 0.f, w1 = (g > 1) ? ((g > 2) ? cd4 : 1.f) : 0.f, w0 = (g > 0) ? ((g > 2) ? cd4 * cd4 : (g > 1) ? cd4 : 1.f) : 0.f;
#pragma unroll
        for (int hf = 0; hf < 2; ++hf) {
            v4f gb[3][4], lpb[4];
#pragma unroll
            for (int gp = 0; gp < 3; ++gp) { const bf16* src = GT + (size_t)((b * 4 + gp) * 4 + h) * 16384 + d * 128 + e0 + 16 * hf;
#pragma unroll
                for (int x = 0; x < 4; ++x) gb[gp][x] = (v4f){0.f, 0.f, 0.f, 0.f};
                if (gp < g) { const v4u w0_ = *(const v4u*)src, w1_ = *(const v4u*)(src + 8);
                    gb[gp][0] = (v4f){bflo(w0_.x), bfhi(w0_.x), bflo(w0_.y), bfhi(w0_.y)}; gb[gp][1] = (v4f){bflo(w0_.z), bfhi(w0_.z), bflo(w0_.w), bfhi(w0_.w)};
                    gb[gp][2] = (v4f){bflo(w1_.x), bfhi(w1_.x), bflo(w1_.y), bfhi(w1_.y)}; gb[gp][3] = (v4f){bflo(w1_.z), bfhi(w1_.z), bflo(w1_.w), bfhi(w1_.w)}; } }
#pragma unroll
            for (int x = 0; x < 4; ++x) lpb[x] = (v4f){0.f, 0.f, 0.f, 0.f};
            if (rr > 0) { const bf16* src = LP + (size_t)((b * 16 + n) * 4 + h) * 16384 + d * 128 + e0 + 16 * hf; const v4u w0_ = *(const v4u*)src, w1_ = *(const v4u*)(src + 8);
                lpb[0] = (v4f){bflo(w0_.x), bfhi(w0_.x), bflo(w0_.y), bfhi(w0_.y)}; lpb[1] = (v4f){bflo(w0_.z), bfhi(w0_.z), bflo(w0_.w), bfhi(w0_.w)};
                lpb[2] = (v4f){bflo(w1_.x), bfhi(w1_.x), bflo(w1_.y), bfhi(w1_.y)}; lpb[3] = (v4f){bflo(w1_.z), bfhi(w1_.z), bflo(w1_.w), bfhi(w1_.w)}; }
            v4f rv[4];
#pragma unroll
            for (int x = 0; x < 4; ++x) rv[x] = gb[0][x] * w0 + gb[1][x] * w1 + gb[2][x] * w2;
            if (n == 15) { const bf16* src = GT + (size_t)((b * 4 + 3) * 4 + h) * 16384 + d * 128 + e0 + 16 * hf; float* dst = state_out + ((size_t)((l * 8 + b) * 4 + h)) * 16384 + d * 128 + e0 + 16 * hf;
                const v4u w0_ = *(const v4u*)src, w1_ = *(const v4u*)(src + 8);
                *(v4f*)(dst + 0) = rv[0] * cd4 + (v4f){bflo(w0_.x), bfhi(w0_.x), bflo(w0_.y), bfhi(w0_.y)}; *(v4f*)(dst + 4) = rv[1] * cd4 + (v4f){bflo(w0_.z), bfhi(w0_.z), bflo(w0_.w), bfhi(w0_.w)};
                *(v4f*)(dst + 8) = rv[2] * cd4 + (v4f){bflo(w1_.x), bfhi(w1_.x), bflo(w1_.y), bfhi(w1_.y)}; *(v4f*)(dst + 12) = rv[3] * cd4 + (v4f){bflo(w1_.z), bfhi(w1_.z), bflo(w1_.w), bfhi(w1_.w)}; }
#pragma unroll
            for (int x = 0; x < 2; ++x) { const v4f o0 = (rv[2 * x] * cr + lpb[2 * x]) * gam, o1 = (rv[2 * x + 1] * cr + lpb[2 * x + 1]) * gam;
                *(LAS v4u*)(Rs + offb(d, (e0 >> 3) + 2 * hf + x)) = (v4u){cvtpk(o0.x, o0.y), cvtpk(o0.z, o0.w), cvtpk(o1.x, o1.y), cvtpk(o1.z, o1.w)}; }
            asm volatile("" ::: "memory");
        }
    }
    asm volatile("" ::: "memory");
    tile_store(Qs, qw, 0.f, lg2, true, tid); tile_store(Ks, kw, 0.f, -lg2, true, tid); tile_store(Vs, vw, 0.f, 0.f, false, tid);
    __syncthreads();
    f32x16 st[4];
#pragma unroll
    for (int mt = 0; mt < 4; ++mt) {
#pragma unroll
        for (int i = 0; i < 16; ++i) st[mt][i] = 0.f;
        if (mt <= s) {
#pragma unroll
            for (int ks = 0; ks < 8; ++ks) st[mt] = __builtin_amdgcn_mfma_f32_32x32x16_bf16(row_frag(Ks, 32 * mt, ks, lane), row_frag(Qs, 32 * s, ks, lane), st[mt], 0, 0, 0);
            if (mt == s) {
#pragma unroll
                for (int i = 0; i < 16; ++i) st[mt][i] = (crow16(i, hl) > r) ? 0.f : st[mt][i];
            }
        }
    }
    f32x16 oa[2];
#pragma unroll
    for (int t = 0; t < 2; ++t)
#pragma unroll
        for (int i = 0; i < 16; ++i) oa[t][i] = 0.f;
#pragma unroll
    for (int mt = 0; mt < 4; ++mt) if (mt <= s) {
#pragma unroll
        for (int s2 = 0; s2 < 2; ++s2) {
            u32x4v pa; pa.x = cvtpk(st[mt][8 * s2], st[mt][8 * s2 + 1]); pa.y = cvtpk(st[mt][8 * s2 + 2], st[mt][8 * s2 + 3]); pa.z = cvtpk(st[mt][8 * s2 + 4], st[mt][8 * s2 + 5]); pa.w = cvtpk(st[mt][8 * s2 + 6], st[mt][8 * s2 + 7]);
            const bf16x8 a = __builtin_bit_cast(bf16x8, pa);
#pragma unroll
            for (int t = 0; t < 2; ++t) oa[t] = __builtin_amdgcn_mfma_f32_32x32x16_bf16(a, tr_frag(Vs, 32 * mt + 16 * s2 + 4 * hl, 32 * mt + 16 * s2 + 8 + 4 * hl, 2 * eh + t, lane), oa[t], 0, 0, 0);
        }
    }
#pragma unroll
    for (int ks = 0; ks < 8; ++ks) { const bf16x8 a = row_frag(Qs, 32 * s, ks, lane);
#pragma unroll
        for (int t = 0; t < 2; ++t) oa[t] = __builtin_amdgcn_mfma_f32_32x32x16_bf16(a, tr_frag(Rs, 16 * ks + 8 * hl, 16 * ks + 8 * hl + 4, 2 * eh + t, lane), oa[t], 0, 0, 0); }
#pragma unroll
    for (int i = 0; i < 16; ++i) { float ps = oa[0][i] + oa[1][i], pq = oa[0][i] * oa[0][i] + oa[1][i] * oa[1][i];
        ps = sum32_f(ps); pq = sum32_f(pq);
        if (r == 0) { stat[(wave * 32 + crow16(i, hl)) * 2] = ps; stat[(wave * 32 + crow16(i, hl)) * 2 + 1] = pq; } }
    v4u gw[4]; tile_load(gw, Gb, row0, h * 128, tid, QS);
    __syncthreads();
#pragma unroll
    for (int i = 0; i < 16; ++i) { const int rl = crow16(i, hl);
        const float sm = stat[(s * 32 + rl) * 2] + stat[((s + 4) * 32 + rl) * 2], sq = stat[(s * 32 + rl) * 2 + 1] + stat[((s + 4) * 32 + rl) * 2 + 1];
        const float mean = sm * (1.f / 128.f), var = fmaxf(sq * (1.f / 128.f) - mean * mean, 0.f), rstd = rsqrtf(var + LN_EPS);
#pragma unroll
        for (int t = 0; t < 2; ++t) { const int e = 64 * eh + 32 * t + r;
            *(LAS bf16*)(Qs + offb(32 * s + rl, e >> 3) + (e & 7) * 2) = (bf16)(cvtpk((oa[t][i] - mean) * rstd, 0.f) & 0xffffu); } }
    __syncthreads();
#pragma unroll
    for (int i = 0; i < 4; ++i) { const int idx = tid + 512 * i, j = idx >> 4, ch = idx & 15;
        float o8[8], g8[8]; unpack8(*(const LAS v4u*)(Qs + offb(j, ch)), o8); unpack8(gw[i], g8);
        v4u w; w.x = cvtpk(o8[0] * g8[0], o8[1] * g8[1]); w.y = cvtpk(o8[2] * g8[2], o8[3] * g8[3]); w.z = cvtpk(o8[4] * g8[4], o8[5] * g8[5]); w.w = cvtpk(o8[6] * g8[6], o8[7] * g8[7]);
        *(v4u*)(A2 + (row0 + j) * D + h * 128 + ch * 8) = w; }
    __syncthreads();
}
__host__ __device__ __forceinline__ void ce_desc(float& a, float& b) { const float hi = fmaxf(a, b), lo = fminf(a, b); a = hi; b = lo; }
template <int N> __host__ __device__ __forceinline__ void bitonic_sort_desc(float (&a)[N]) {
#pragma unroll
    for (int k = 2; k <= N; k <<= 1)
#pragma unroll
        for (int j = k >> 1; j > 0; j >>= 1)
#pragma unroll
            for (int i = 0; i < N; ++i) { const int p = i ^ j; if (p > i) { if ((i & k) == 0) ce_desc(a[i], a[p]); else ce_desc(a[p], a[i]); } }
}
template <int N> __host__ __device__ __forceinline__ void bitonic_merge_desc(float (&a)[N]) {
#pragma unroll
    for (int j = N >> 1; j > 0; j >>= 1)
#pragma unroll
        for (int i = 0; i < N; ++i) { const int p = i ^ j; if (p > i) ce_desc(a[i], a[p]); }
}
__host__ __device__ __forceinline__ void merge_top16(float (&a)[16], const float (&b)[16]) {
#pragma unroll
    for (int i = 0; i < 16; ++i) a[i] = fmaxf(a[i], b[15 - i]);
    bitonic_merge_desc<16>(a);
}
__host__ __device__ __forceinline__ void top16_of_64(float (&g0)[16], float (&g1)[16], float (&g2)[16], float (&g3)[16]) {
    bitonic_sort_desc<16>(g0); bitonic_sort_desc<16>(g1); bitonic_sort_desc<16>(g2); bitonic_sort_desc<16>(g3);
    merge_top16(g0, g1); merge_top16(g2, g3); merge_top16(g0, g2);
}
__host__ __device__ __forceinline__ float pack_low(float v, unsigned mask, unsigned code) { unsigned u = __builtin_bit_cast(unsigned, v); u = (u & ~mask) | code; return __builtin_bit_cast(float, u); }
__host__ __device__ constexpr int cand_i(int n) { return n < 16 ? 0 : n < 24 ? 1 : n < 29 ? 2 : n < 33 ? 3 : n < 36 ? 4 : n < 38 ? 5 : n < 40 ? 6 : n < 42 ? 7 : n - 34; }
__host__ __device__ constexpr int cand_j(int n) { return n < 16 ? n : n < 24 ? n - 16 : n < 29 ? n - 24 : n < 33 ? n - 29 : n < 36 ? n - 33 : n < 38 ? n - 36 : n < 40 ? n - 38 : n < 42 ? n - 40 : 0; }
__host__ __device__ __forceinline__ void top16_pair_sums(const float (&v1)[16], const float (&v2)[16], float (&c0)[16]) {
    float c1[16], c2[16], c3[16];
    const float ninf = __builtin_bit_cast(float, 0xff800000u);
#define PS_C(n) pack_low(v1[cand_i(n)] + v2[cand_j(n)], 0xffu, (unsigned)((cand_i(n) << 4) | cand_j(n)))
#pragma unroll
    for (int n = 0; n < 16; ++n) { c0[n] = PS_C(n); c1[n] = PS_C(16 + n); c2[n] = PS_C(32 + n); }
    c3[0] = PS_C(48); c3[1] = PS_C(49);
#pragma unroll
    for (int n = 2; n < 16; ++n) c3[n] = ninf;
#undef PS_C
    top16_of_64(c0, c1, c2, c3);
}

__device__ __forceinline__ void route_stage_keys(LAS unsigned char* lds, int head, int l, const bf16* KEYS, int tid) {
    stage_tile(lds, KEYS + (size_t)((l * 2 + 0) * 8 + head) * 16384, 0, 0, 0.f, 0.f, false, tid, 128);
    stage_tile(lds + 32768, KEYS + (size_t)((l * 2 + 1) * 8 + head) * 16384, 0, 0, 0.f, 0.f, false, tid, 128);
}
__device__ __forceinline__ void route_unit(LAS unsigned char* lds, int head, int tok0, int ntok, const bf16* QP, unsigned short* RI, float* RG, int tid) {
    const int wave = __builtin_amdgcn_readfirstlane(tid >> 6), lane = tid & 63, side = wave >> 2, sub = wave & 3, r = lane & 31, hl = lane >> 5;
    LAS unsigned char* Ks = lds + side * 32768; LAS unsigned char* Qs = lds + 65536 + side * 32768;
    stage_tile(lds + 65536, QP, tok0, head * 256, 0.f, 0.f, false, tid, 2048); stage_tile(lds + 98304, QP, tok0, head * 256 + 128, 0.f, 0.f, false, tid, 2048);
    __syncthreads();
    f32x16 acc[4];
#pragma unroll
    for (int mt = 0; mt < 4; ++mt)
#pragma unroll
        for (int i = 0; i < 16; ++i) acc[mt][i] = 0.f;
#pragma unroll
    for (int ks = 0; ks < 8; ++ks) { const bf16x8 bq = row_frag(Qs, 32 * sub, ks, lane);
#pragma unroll
        for (int mt = 0; mt < 4; ++mt) acc[mt] = __builtin_amdgcn_mfma_f32_32x32x16_bf16(row_frag(Ks, 32 * mt, ks, lane), bq, acc[mt], 0, 0, 0); }
    float g0[16], g1[16], g2[16], g3[16];
#pragma unroll
    for (int i = 0; i < 16; ++i) { const unsigned kr = (unsigned)((i & 3) + 8 * (i >> 2) + 4 * hl);
        g0[i] = pack_low(acc[0][i], 127u, kr); g1[i] = pack_low(acc[1][i], 127u, 32u + kr); g2[i] = pack_low(acc[2][i], 127u, 64u + kr); g3[i] = pack_low(acc[3][i], 127u, 96u + kr); }
    top16_of_64(g0, g1, g2, g3);
#pragma unroll
    for (int i = 0; i < 16; ++i) { const unsigned a = __builtin_bit_cast(unsigned, g0[15 - i]); const auto rr = __builtin_amdgcn_permlane32_swap(a, a, false, false); unsigned r0 = rr[0], r1 = rr[1]; asm volatile("" : "+v"(r0), "+v"(r1));
        g1[i] = __builtin_bit_cast(float, hl ? r0 : r1); }
#pragma unroll
    for (int i = 0; i < 16; ++i) g0[i] = fmaxf(g0[i], g1[i]);
    bitonic_merge_desc<16>(g0);
    __syncthreads();
    LAS float* cand = (LAS float*)(lds + 65536);
    if (hl == 0) { LAS v4f* p = (LAS v4f*)(cand + ((side * 128) + sub * 32 + r) * 16);
#pragma unroll
        for (int x = 0; x < 4; ++x) p[x] = (v4f){g0[4 * x], g0[4 * x + 1], g0[4 * x + 2], g0[4 * x + 3]}; }
    __syncthreads();
    if (tid < ntok) {
        float v1[16], v2[16], c0[16];
#pragma unroll
        for (int x = 0; x < 4; ++x) { const v4f a = *(const LAS v4f*)(cand + tid * 16 + 4 * x), b = *(const LAS v4f*)(cand + (128 + tid) * 16 + 4 * x);
            v1[4 * x] = a.x; v1[4 * x + 1] = a.y; v1[4 * x + 2] = a.z; v1[4 * x + 3] = a.w; v2[4 * x] = b.x; v2[4 * x + 1] = b.y; v2[4 * x + 2] = b.z; v2[4 * x + 3] = b.w; }
        top16_pair_sums(v1, v2, c0);
        float e[16], se = 0.f;
#pragma unroll
        for (int k = 0; k < 16; ++k) { e[k] = __expf(c0[k] - c0[0]); se += e[k]; }
        const float inv = 1.f / se;
        const LAS unsigned* cb = (const LAS unsigned*)cand;
        unsigned short* ri = RI + (size_t)(tok0 + tid) * NSEL + head * 16; float* rg = RG + (size_t)(tok0 + tid) * NSEL + head * 16;
#pragma unroll
        for (int x = 0; x < 4; ++x) { int ii[4]; float gg[4];
#pragma unroll
            for (int y = 0; y < 4; ++y) { const int k = 4 * x + y; const unsigned code = __builtin_bit_cast(unsigned, c0[k]) & 0xffu;
                const unsigned e1 = cb[tid * 16 + (code >> 4)] & 127u, e2 = cb[(128 + tid) * 16 + (code & 15u)] & 127u;
                ii[y] = (int)(e1 * 128u + e2); gg[y] = e[k] * inv; }
            *(v2u*)(ri + 4 * x) = (v2u){(unsigned)ii[0] | ((unsigned)ii[1] << 16), (unsigned)ii[2] | ((unsigned)ii[3] << 16)}; *(v4f*)(rg + 4 * x) = (v4f){gg[0], gg[1], gg[2], gg[3]}; }
    }
    __syncthreads();
}
template <int NR> __device__ __forceinline__ void quant_rows(const float* src, unsigned char* dstl, int row, float* scale_out, int offset_binary, int lane) {
    v4f v[NR][4]; float m[NR];
#pragma unroll
    for (int r = 0; r < NR; ++r)
#pragma unroll
        for (int j = 0; j < 4; ++j) v[r][j] = __builtin_nontemporal_load((const v4f*)(src + (size_t)r * D + 256 * j + 4 * lane));
#pragma unroll
    for (int r = 0; r < NR; ++r) { float mm = 0.f;
#pragma unroll
        for (int j = 0; j < 4; ++j) mm = fmaxf(mm, fmaxf(fmaxf(fabsf(v[r][j].x), fabsf(v[r][j].y)), fmaxf(fabsf(v[r][j].z), fabsf(v[r][j].w))));
        m[r] = mm; }
#pragma unroll
    for (int r = 0; r < NR; ++r) m[r] = wave_max(m[r]);
    const int off = offset_binary ? 128 : 0;
#pragma unroll
    for (int r = 0; r < NR; ++r) { const float sc = m[r] > 0.f ? 127.f / m[r] : 0.f; v4u o;
#pragma unroll
        for (int j = 0; j < 4; ++j) { unsigned w = 0;
#pragma unroll
            for (int e = 0; e < 4; ++e) { const int q = (int)rintf(v[r][j][e] * sc) + off; w |= ((unsigned)q & 0xffu) << (8 * e); }
            o[j] = w; }
        __builtin_nontemporal_store(o, (v4u*)(dstl + (size_t)(lane >> 3) * (16384 * 128) + (size_t)(row + r) * 128 + 16 * (lane & 7)));
        if (lane == 0) scale_out[r] = m[r] * (1.f / 127.f); }
}
__device__ __forceinline__ float ub0(unsigned w) { return (float)(w & 0xffu); }
__device__ __forceinline__ float ub1(unsigned w) { return (float)((w >> 8) & 0xffu); }
__device__ __forceinline__ float ub2(unsigned w) { return (float)((w >> 16) & 0xffu); }
__device__ __forceinline__ float ub3(unsigned w) { return (float)(w >> 24); }
struct SliceMap { int vx, rank, cnt; };
__device__ __forceinline__ SliceMap slice_map(unsigned* bar, volatile LAS unsigned* MISC, int G, int bx, int tid) {
    if (tid == 0) { const unsigned x = xb_xcc_id(); unsigned bad = (x >= 8u) ? 1u : 0u, mine = 0u;
#pragma unroll 1
        for (unsigned j = 0; j < 16; ++j) { const unsigned c = xb_ld(&bar[XB_XCNT(j)]); bad |= (j < 8u) ? (c == 0u ? 1u : 0u) : (c != 0u ? 1u : 0u); mine = (j == x) ? c : mine; }
        if (!bad) { MISC[12] = x; MISC[13] = MISC[10]; MISC[14] = mine; }
        else { MISC[12] = (unsigned)(bx & 7); MISC[13] = (unsigned)(bx >> 3); MISC[14] = (unsigned)((G - (bx & 7) + 7) >> 3); } }
    __syncthreads();
    SliceMap m; m.vx = (int)MISC[12]; m.rank = (int)MISC[13]; m.cnt = (int)MISC[14];
    __syncthreads();
    return m;
}
#define DPP_XOR1 0xB1
#define DPP_XOR2 0x4E
#define DPP_HMIR 0x141
#define DPP_ROR8 0x128
__device__ __forceinline__ int sum8_i(int t) { t += __builtin_amdgcn_update_dpp(0, t, DPP_XOR1, 0xf, 0xf, false); t += __builtin_amdgcn_update_dpp(0, t, DPP_XOR2, 0xf, 0xf, false); t += __builtin_amdgcn_update_dpp(0, t, DPP_HMIR, 0xf, 0xf, false); return t; }
__device__ __forceinline__ void expert_u_sweep(int tok0, int step, int vx, const unsigned char* XQ, const unsigned short* RI, const unsigned char* UB, int* PD, int lane) {
    const int g = lane >> 3, c = lane & 7;
    const unsigned char* us = UB + (size_t)vx * (16384 * 128) + 16 * c;
    const bool b0 = c & 1, b1 = c & 2, b2 = c & 4;
    v4u en[2]; v4u xn;
    if (tok0 < T) {
#pragma unroll
        for (int x = 0; x < 2; ++x) en[x] = *(const v4u*)(RI + (size_t)tok0 * NSEL + 16 * g + 8 * x);
        xn = *(const v4u*)(XQ + (size_t)tok0 * D + 128 * vx + 16 * c); }
#pragma unroll 1
    for (int tok = tok0; tok < T; tok += step) {
        int ev[16];
#pragma unroll
        for (int x = 0; x < 2; ++x)
#pragma unroll
            for (int y = 0; y < 4; ++y) { ev[8 * x + 2 * y] = (int)(en[x][y] & 0xffffu); ev[8 * x + 2 * y + 1] = (int)(en[x][y] >> 16); }
        const v4u xw = xn;
        v4u ub[16];
#pragma unroll
        for (int kk = 0; kk < 16; ++kk) ub[kk] = *(const v4u*)(us + (size_t)ev[kk] * 128);
        const int tn = tok + step;
        if (tn < T) {
#pragma unroll
            for (int x = 0; x < 2; ++x) en[x] = *(const v4u*)(RI + (size_t)tn * NSEL + 16 * g + 8 * x);
            xn = *(const v4u*)(XQ + (size_t)tn * D + 128 * vx + 16 * c); }
        int t[16];
#pragma unroll
        for (int kk = 0; kk < 16; ++kk) { int a = __builtin_amdgcn_sdot4((int)ub[kk].x, (int)xw.x, 0, false); a = __builtin_amdgcn_sdot4((int)ub[kk].y, (int)xw.y, a, false);
            a = __builtin_amdgcn_sdot4((int)ub[kk].z, (int)xw.z, a, false); a = __builtin_amdgcn_sdot4((int)ub[kk].w, (int)xw.w, a, false); t[kk] = sum8_i(a); }
        int lo, hi;
        { const int a0 = b0 ? t[2] : t[0], a1 = b0 ? t[6] : t[4], a2 = b0 ? t[10] : t[8], a3 = b0 ? t[14] : t[12]; const int c0 = b1 ? a1 : a0, c1 = b1 ? a3 : a2; lo = b2 ? c1 : c0; }
        { const int a0 = b0 ? t[3] : t[1], a1 = b0 ? t[7] : t[5], a2 = b0 ? t[11] : t[9], a3 = b0 ? t[15] : t[13]; const int c0 = b1 ? a1 : a0, c1 = b1 ? a3 : a2; hi = b2 ? c1 : c0; }
        typedef int v2i __attribute__((ext_vector_type(2)));
        *(v2i*)(PD + ((size_t)vx * T + tok) * NSEL + 2 * lane) = (v2i){lo, hi};
    }
}
template <int NT> __device__ __forceinline__ void expert_coefs(int tok, int dt, const int* PD, const float* SX, const unsigned short* RI, const float* RG, const float* SU, const float* SV, unsigned char* CQ, float* CS, int lane) {
    int pd[NT][2][8], ev[NT][2]; float gv[NT][2], sxv[NT];
#pragma unroll
    for (int t = 0; t < NT; ++t) { const int tk = (tok + t * dt < T) ? tok + t * dt : tok;
        sxv[t] = SX[tk];
#pragma unroll
        for (int kh = 0; kh < 2; ++kh) { const int k = 64 * kh + lane; ev[t][kh] = (int)RI[(size_t)tk * NSEL + k]; gv[t][kh] = RG[(size_t)tk * NSEL + k];
#pragma unroll
            for (int x = 0; x < 8; ++x) pd[t][kh][x] = __builtin_nontemporal_load(PD + ((size_t)x * T + tk) * NSEL + k); } }
    float suv[NT][2], svv[NT][2];
#pragma unroll
    for (int t = 0; t < NT; ++t)
#pragma unroll
        for (int kh = 0; kh < 2; ++kh) { suv[t][kh] = SU[ev[t][kh]]; svv[t][kh] = SV[ev[t][kh]]; }
#pragma unroll
    for (int t = 0; t < NT; ++t) { const int tk = tok + t * dt; float cv[2];
#pragma unroll
        for (int kh = 0; kh < 2; ++kh) { int sum = 0;
#pragma unroll
            for (int x = 0; x < 8; ++x) sum += pd[t][kh][x];
            const float dot = (float)sum * (suv[t][kh] * sxv[t]);
            cv[kh] = gv[t][kh] * 0.5f * dot * (1.f + erff(dot * 0.7071067811865476f)) * svv[t][kh]; }
        const float mx = wave_max(fmaxf(fabsf(cv[0]), fabsf(cv[1]))), qs = mx > 0.f ? 127.f / mx : 0.f;
        if (tk < T) { CQ[(size_t)tk * NSEL + lane] = (unsigned char)((int)rintf(cv[0] * qs) & 0xff); CQ[(size_t)tk * NSEL + 64 + lane] = (unsigned char)((int)rintf(cv[1] * qs) & 0xff);
            if (lane == 0) CS[tk] = mx * (1.f / 127.f); } }
}
__device__ __forceinline__ void expert_v_sweep(int tok0, int step, int vx, const unsigned short* RI, const unsigned char* CQ, const float* CS, const unsigned char* VB, bf16* FF, int lane) {
    const int g = lane >> 3, c = lane & 7;
    const unsigned char* vs = VB + (size_t)vx * (16384 * 128) + 16 * c;
    const bool b3 = (lane & 8) != 0; const int jj = 2 * ((lane >> 5) & 1) + ((lane >> 4) & 1), e0 = 2 * ((lane >> 3) & 1);
    v4u en[2]; v4u cqn; float csn = 0.f;
    if (tok0 < T) {
#pragma unroll
        for (int x = 0; x < 2; ++x) en[x] = *(const v4u*)(RI + (size_t)tok0 * NSEL + 16 * g + 8 * x);
        cqn = *(const v4u*)(CQ + (size_t)tok0 * NSEL + 16 * g); csn = CS[tok0]; }
#pragma unroll 1
    for (int tok = tok0; tok < T; tok += step) {
        int ev[16];
#pragma unroll
        for (int x = 0; x < 2; ++x)
#pragma unroll
            for (int y = 0; y < 4; ++y) { ev[8 * x + 2 * y] = (int)(en[x][y] & 0xffffu); ev[8 * x + 2 * y + 1] = (int)(en[x][y] >> 16); }
        const v4u cq = cqn; const float cs = csn;
        v4u vb[16];
#pragma unroll
        for (int kk = 0; kk < 16; ++kk) vb[kk] = *(const v4u*)(vs + (size_t)ev[kk] * 128);
        const int tn = tok + step;
        if (tn < T) {
#pragma unroll
            for (int x = 0; x < 2; ++x) en[x] = *(const v4u*)(RI + (size_t)tn * NSEL + 16 * g + 8 * x);
            cqn = *(const v4u*)(CQ + (size_t)tn * NSEL + 16 * g); csn = CS[tn]; }
        int acc[16];
#pragma unroll
        for (int i = 0; i < 16; ++i) acc[i] = 0;
#pragma unroll
        for (int blk = 0; blk < 4; ++blk) { const int cw = (int)cq[blk];
#pragma unroll
            for (int j = 0; j < 4; ++j) { const unsigned a = vb[4 * blk][j], b = vb[4 * blk + 1][j], cc = vb[4 * blk + 2][j], d = vb[4 * blk + 3][j];
                const unsigned ablo = __builtin_amdgcn_perm(a, b, 0x01050004u), abhi = __builtin_amdgcn_perm(a, b, 0x03070206u), cdlo = __builtin_amdgcn_perm(cc, d, 0x01050004u), cdhi = __builtin_amdgcn_perm(cc, d, 0x03070206u);
                const unsigned t0 = __builtin_amdgcn_perm(cdlo, ablo, 0x05040100u), t1 = __builtin_amdgcn_perm(cdlo, ablo, 0x07060302u), t2 = __builtin_amdgcn_perm(cdhi, abhi, 0x05040100u), t3 = __builtin_amdgcn_perm(cdhi, abhi, 0x07060302u);
                acc[4 * j] = __builtin_amdgcn_sdot4((int)t0, cw, acc[4 * j], false); acc[4 * j + 1] = __builtin_amdgcn_sdot4((int)t1, cw, acc[4 * j + 1], false);
                acc[4 * j + 2] = __builtin_amdgcn_sdot4((int)t2, cw, acc[4 * j + 2], false); acc[4 * j + 3] = __builtin_amdgcn_sdot4((int)t3, cw, acc[4 * j + 3], false); } }
        int r8[8], r4[4];
#pragma unroll
        for (int i = 0; i < 8; ++i) { const auto r = __builtin_amdgcn_permlane32_swap((unsigned)acc[i], (unsigned)acc[i + 8], false, false); unsigned r0 = r[0], r1 = r[1]; asm volatile("" : "+v"(r0), "+v"(r1)); r8[i] = (int)(r0 + r1); }
#pragma unroll
        for (int i = 0; i < 4; ++i) { const auto r = __builtin_amdgcn_permlane16_swap((unsigned)r8[i], (unsigned)r8[i + 4], false, false); unsigned r0 = r[0], r1 = r[1]; asm volatile("" : "+v"(r0), "+v"(r1)); r4[i] = (int)(r0 + r1); }
        int r2[2];
#pragma unroll
        for (int i = 0; i < 2; ++i) { const int keep = b3 ? r4[i + 2] : r4[i], send = b3 ? r4[i] : r4[i + 2]; r2[i] = keep + __builtin_amdgcn_update_dpp(0, send, DPP_ROR8, 0xf, 0xf, false); }
        *(unsigned*)(FF + (size_t)tok * D + 256 * jj + 4 * (8 * vx + c) + e0) = cvtpk((float)r2[0] * cs, (float)r2[1] * cs);
    }
}
__device__ __forceinline__ int xcd_row(int x, int j) { return j < 2048 ? 2048 * x + j : TP + 64 * x + (j - 2048); }
template <int NT> __device__ __forceinline__ void ln2_tokens(int xq_, int tok, int dt, const bf16* X1, const bf16* FF, const float* g2, const float* b2, float* outf, bf16* outb, int lane) {
    v2u xw[NT][4], fw[NT][4];
#pragma unroll
    for (int t = 0; t < NT; ++t) { const int jx = tok + t * dt, tk = xcd_row(xq_, jx);
#pragma unroll
        for (int j = 0; j < 4; ++j) { xw[t][j] = (v2u){0u, 0u}; fw[t][j] = (v2u){0u, 0u};
            if (jx < 2112) { xw[t][j] = __builtin_nontemporal_load((const v2u*)(X1 + (size_t)tk * D + 256 * j + 4 * lane)); fw[t][j] = __builtin_nontemporal_load((const v2u*)(FF + (size_t)tk * D + 256 * j + 4 * lane)); } } }
    v4f ga[4], ba[4];
#pragma unroll
    for (int j = 0; j < 4; ++j) { ga[j] = *(const v4f*)(g2 + 256 * j + 4 * lane); ba[j] = *(const v4f*)(b2 + 256 * j + 4 * lane); }
#pragma unroll
    for (int t = 0; t < NT; ++t) { const int jx = tok + t * dt, tk = xcd_row(xq_, jx);
        float z[16]; float s = 0.f;
#pragma unroll
        for (int j = 0; j < 4; ++j) { z[4 * j] = ALPHA * bflo(xw[t][j].x) + bflo(fw[t][j].x); z[4 * j + 1] = ALPHA * bfhi(xw[t][j].x) + bfhi(fw[t][j].x); z[4 * j + 2] = ALPHA * bflo(xw[t][j].y) + bflo(fw[t][j].y); z[4 * j + 3] = ALPHA * bfhi(xw[t][j].y) + bfhi(fw[t][j].y);
            s += (z[4 * j] + z[4 * j + 1]) + (z[4 * j + 2] + z[4 * j + 3]); }
        const float mean = wave_sum(s) * (1.f / D); float q = 0.f;
#pragma unroll
        for (int i = 0; i < 16; ++i) { z[i] -= mean; q += z[i] * z[i]; }
        const float rstd = rsqrtf(wave_sum(q) * (1.f / D) + LN_EPS);
        if (jx < 2112) {
#pragma unroll
            for (int j = 0; j < 4; ++j) { const int c0c = 256 * j + 4 * lane; v4f o;
#pragma unroll
                for (int e = 0; e < 4; ++e) o[e] = z[4 * j + e] * rstd * ga[j][e] + ba[j][e];
                if (outf) __builtin_nontemporal_store(o, (v4f*)(outf + (size_t)tk * D + c0c));
                if (outb) { v2u w; w.x = cvtpk(o.x, o.y); w.y = cvtpk(o.z, o.w); *(v2u*)(outb + (size_t)tk * D + c0c) = w; } } }
    }
}

#define QUANT_ITEMS(ly, lo, hi, widx, nw) do { for (int qi = (lo) + (widx); qi < (hi); qi += (nw)) { const int tb = qi >> 12, rr = (ly) * 16384 + 4 * (qi & 4095); \
        quant_rows<4>((tb ? ka->in[17] : ka->in[16]) + (size_t)rr * D, (tb ? VB : UB), rr & 16383, (tb ? SV : SU) + rr, 0, lanel); } } while (0)
__device__ __forceinline__ void xl_barrier(unsigned* xw, unsigned x, unsigned nloc, unsigned round, bool lead) {
    asm volatile("s_waitcnt vmcnt(0)" ::: "memory");
    __syncthreads();
    if (lead) {
        unsigned* sub = xw + 64 * x; unsigned* gen = xw + 1024 + 64 * x;
        const unsigned old = xb_add(sub, 1u), g = round;
        if (old + 1u == (g + 1u) * nloc) xb_add(gen, 1u);
        else { unsigned sp = 0; while (xb_ld(gen) <= g) { __builtin_amdgcn_s_sleep(1); if (++sp > (1u << 22)) break; } }
        __builtin_amdgcn_fence(__ATOMIC_ACQUIRE, "agent");
        asm volatile("s_waitcnt vmcnt(0)" ::: "memory");
    }
    __syncthreads();
}
struct Args { const float* in[20]; float* out; unsigned char* ws; int ph_lo, ph_hi; };
__global__ void __launch_bounds__(NTHR, 2) mk_fwd(Args args) {
    extern __shared__ __attribute__((aligned(16))) unsigned char lds_raw[];
    LAS unsigned char* lds = (LAS unsigned char*)lds_raw;
    volatile LAS unsigned* MISC = (volatile LAS unsigned*)(lds + MISC_OFF);
    const int G = gridDim.x, bx = blockIdx.x, vcu = (G % 8 == 0) ? (bx % 8) * (G / 8) + bx / 8 : bx;
    gu32* ctl = (gu32*)(args.ws + WS_CTL);
    { int t0 = threadIdx.x; asm volatile("" : "+v"(t0)); for (int u = t0; u < (LDS_BYTES - LDSCTL_OFF) / 4; u += NTHR) ((LAS unsigned*)(lds + LDSCTL_OFF))[u] = 0u; }
    __syncthreads();
    const int wid_s = __builtin_amdgcn_readfirstlane(threadIdx.x >> 6);
    XcdBarrier bar; bar.lead = false; bar.bar = (unsigned*)(ctl + CW_BAR); bar.x = 0; bar.st = nullptr;
    if (!MK_PER_PHASE) bar = xcd_barrier_post((unsigned*)(ctl + CW_BAR), MISC + 8);
    const int lo = args.ph_lo, hi = args.ph_hi;
    int cb_ = blockIdx.x;
#define IN(k) (lo <= (k) && (k) < hi)
#define KAS __attribute__((address_space(4)))
#define KTID(var) unsigned mm_##var = ~0u; asm volatile("" : "+s"(mm_##var)); int var = (wid_s << 6) | (int)__builtin_amdgcn_mbcnt_hi(mm_##var, __builtin_amdgcn_mbcnt_lo(mm_##var, 0u))
#define LAUNDER() KTID(tl); asm volatile("" : "+v"(tl)); const KAS Args* ka = (const KAS Args*)__builtin_amdgcn_kernarg_segment_ptr(); asm volatile("" : "+s"(ka)); int bxl = blockIdx.x; asm volatile("" : "+s"(bxl)); (void)bxl; int cbl = cb_; asm volatile("" : "+s"(cbl)); const int xv = cbl & 7, rv = cbl >> 3; (void)xv; (void)rv; \
    const int lanel = tl & 63, wavel = __builtin_amdgcn_readfirstlane(tl >> 6); const int gw = vcu * NWAVES + wavel, NGW = G * NWAVES; const size_t gtid = (size_t)vcu * NTHR + tl, NGT = (size_t)G * NTHR; (void)lanel; (void)wavel; (void)gw; (void)NGW; (void)gtid; (void)NGT; \
    unsigned char* ws = ka->ws; float* out = ka->out; (void)out; \
    float* cosT = (float*)(ws + WS_ROPE); float* sinT = cosT + 2052 * 64; (void)sinT; \
    bf16* WinT = (bf16*)(ws + WS_WIN); bf16* WoutT = (bf16*)(ws + WS_WOUT); bf16* WqT = (bf16*)(ws + WS_WQ); bf16* KEYS = (bf16*)(ws + WS_KEYS); \
    unsigned char* UB = ws + WS_UB; unsigned char* VB = ws + WS_VB; float* SU = (float*)(ws + WS_SU); float* SV = (float*)(ws + WS_SV); (void)SU; (void)SV; bf16* XB = (bf16*)(ws + WS_XB); float* XF = (float*)(ws + WS_XF); \
    bf16* Qb = (bf16*)(ws + WS_Q); bf16* Kb = (bf16*)(ws + WS_K); bf16* Vb = (bf16*)(ws + WS_V); bf16* Gb = (bf16*)(ws + WS_G); bf16* Ub = (bf16*)(ws + WS_U); \
    bf16* KV = (bf16*)(ws + WS_KV); bf16* GT = (bf16*)(ws + WS_GT); (void)GT; unsigned char* XQ = ws + WS_XQ; float* SX = (float*)(ws + WS_SX); float* CC = (float*)(ws + WS_CC); (void)XQ; (void)SX; (void)CC; int* PD = (int*)(ws + WS_PD); bf16* FF = (bf16*)(ws + WS_FF); (void)PD; (void)FF; unsigned char* CQ = ws + WS_CQ; float* CS = (float*)(ws + WS_CS); (void)CQ; (void)CS; bf16* A2 = (bf16*)(ws + WS_A2); float* Z1 = (float*)(ws + WS_Z1); bf16* X1B = (bf16*)(ws + WS_X1B); \
    bf16* QP = (bf16*)(ws + WS_QP); unsigned short* RI = (unsigned short*)(ws + WS_RI); float* RG = (float*)(ws + WS_RG); \
    (void)WinT; (void)WoutT; (void)WqT; (void)KEYS; (void)UB; (void)VB; (void)XB; (void)XF; (void)Qb; (void)Kb; (void)Vb; (void)Gb; (void)Ub; (void)KV; (void)A2; (void)Z1; (void)X1B; (void)QP; (void)RI; (void)RG
#ifndef BARX
#define BARX 1
#endif
#define SEAM(k) do { if (IN(k) && IN((k) + 1)) { KTID(bt_); XcdBarrier bl_ = bar; bl_.lead = (bt_ == 0); asm volatile("" : "+s"(bl_.bar)); for (int bq = 0; bq < BARX; ++bq) xcd_barrier(bl_); } } while (0)
#define SEAM_X(k) do { if (IN(k) && IN((k) + 1)) { if (!xl) { KTID(bt_); XcdBarrier bl_ = bar; bl_.lead = (bt_ == 0); asm volatile("" : "+s"(bl_.bar)); xcd_barrier(bl_); } \
    else { KTID(bt_); unsigned* xw_ = (unsigned*)(ctl + CW_XL); asm volatile("" : "+s"(xw_)); int cq_ = cb_; asm volatile("" : "+s"(cq_)); xl_barrier(xw_, (unsigned)(cq_ & 7), (unsigned)NXW, (unsigned)xl_round, bt_ == 0); ++xl_round; } } } while (0)
    if (IN(0) && EN(0)) {
        LAUNDER(); for (int rep = 0; rep < REP(0); ++rep) {
        LAS float* scr = (LAS float*)(lds + wavel * 16384);
        for (int it = gw; it < 6144; it += NGW) {
            const int l = it / 3072; int r = it % 3072;
            if (r < 1536) { const int kb = r / 96, nb = r % 96; transpose_item(ka->in[4] + (size_t)l * D * INW, D, INW, WinT + (size_t)l * INW * D, kb * 64, nb * 32, inproj_slot(nb * 32), scr, lanel); continue; } r -= 1536;
            if (r < 512) { const int kb = r / 32, nb = r % 32; transpose_item(ka->in[10] + (size_t)l * D * D, D, D, WoutT + (size_t)l * D * D, kb * 64, nb * 32, nb * 32, scr, lanel); continue; } r -= 512;
            { const int kb = r / 64, nb = r % 64; transpose_item(ka->in[13] + (size_t)l * D * 2048, D, 2048, WqT + (size_t)l * 2048 * D, kb * 64, nb * 32, nb * 32, scr, lanel); }
        }
        for (int l = 0; l < NL; ++l) { cvt_flat(ka->in[14] + (size_t)l * 131072, KEYS + (size_t)(l * 2 + 0) * 131072, 131072, gtid, NGT); cvt_flat(ka->in[15] + (size_t)l * 131072, KEYS + (size_t)(l * 2 + 1) * 131072, 131072, gtid, NGT); }
        cvt_flat(ka->in[0], XB, (size_t)TP * D, gtid, NGT);
        cvt_flat(ka->in[1], XB + (size_t)TP * D, (size_t)TS * D, gtid, NGT);
        for (size_t i = gtid; i < 2052 * 64; i += NGT) { const int p = (int)(i >> 6), j = (int)(i & 63); const double pos = (p < 2048) ? (double)p : (double)(16384 + (p - 2048));
            const double ang = pos * INV_FREQ[j]; const double kq = rint(ang * 0.15915494309189535); const double rr = ang - kq * 6.283185307179586;
            const float rf = (float)rr; cosT[i] = __cosf(rf); sinT[i] = __sinf(rf); }
    } }
    SEAM(0);
    const int NXW = G >> 3;
    int xl, xl_round = 0;
    {   KTID(t0_);
        if (t0_ == 0) { unsigned bad = MK_PER_PHASE ? 1u : 0u; const unsigned x = xb_xcc_id(); bad |= (x >= 8u) ? 1u : 0u; unsigned* bw = (unsigned*)(ctl + CW_BAR);
#pragma unroll 1
            for (unsigned j = 0; j < 16; ++j) { const unsigned c = xb_ld(&bw[XB_XCNT(j)]); bad |= (j < 8u) ? (c != (unsigned)NXW ? 1u : 0u) : (c != 0u ? 1u : 0u); }
            const unsigned rk = MISC[10]; bad |= (rk >= (unsigned)NXW) ? 1u : 0u;
#ifdef XL_OFF
            bad = 1u;
#endif
            MISC[16] = bad ? 0u : 1u; MISC[17] = bad ? (unsigned)bx : (x + 8u * rk); }
        __syncthreads();
        xl = __builtin_amdgcn_readfirstlane((int)MISC[16]); cb_ = __builtin_amdgcn_readfirstlane((int)MISC[17]);
        __syncthreads(); }
#pragma unroll 1
    for (int l = 0; l < NL; ++l) {
        const int pb = 1 + PPL * l;
        if (IN(pb) && EN(1)) {
            LAUNDER(); {
            pg8::Gemm g{XB, WinT + (size_t)l * INW * D, TP, INW, D}; OrderM S; S.init(TP, INW, G, cbl, REP(1));
            EpiInProj E{ka->in[5] + l * INW, Qb, Kb, Vb, Gb, Ub, cosT, sinT, out + O_CCP + (size_t)l * 8 * 30 * 512, out + O_CCS + (size_t)l * 128 * 30 * 512};
            pg8::gemm_phase<EpiInProj, OrderM, PG8_ALIGN, PG8_SP2>(lds, g, S, E, tl);
            { const SEpiInProj SE{ka->in[5] + l * INW, Qb, Kb, Vb, Gb, Ub, cosT, sinT, out + O_CCS + (size_t)l * 128 * 30 * 512};
              for (int sr = 0; sr < SGREP; ++sr) for (int u = rv; u < 12; u += NXW) sgemm_unit(lds, XB, WinT + (size_t)l * INW * D, u, TP + 64 * xv, SE, tl);
              if (NXW > 12) { if (rv >= 12) QUANT_ITEMS(l, 0, 2272, ((rv - 12) * 8 + xv) * NWAVES + wavel, (NXW - 12) * 8 * NWAVES); }
              else QUANT_ITEMS(l, 0, 2272, gw, NGW); }
        } }
        SEAM_X(pb);
        if (IN(pb + 1) && EN(2)) {
            LAUNDER(); for (int rep = 0; rep < REP(2); ++rep) {
            for (int u = rv; u < 16; u += NXW) kvgroup_unit(lds, 16 * xv + u, Kb, Vb, KV, GT, tl);
            for (int u = rv; u < 32; u += NXW) sample_pair_unit(lds, 32 * xv + u, l, Qb, Kb, Vb, Gb, ka->in[2], out + O_SRS, A2, tl);
            const bool split = (NXW == 32);
            const int u0 = split ? (rv < 16 ? rv : 32 + (rv - 16)) : rv, ust = split ? 16 : NXW, uend = split ? (rv < 16 ? 32 : 80) : 80;
            for (int u = u0; u < uend; u += ust) {
                if (u < 64) conv_unit<32>(lds, 64 * xv + u, l, Ub, ka->in[3], ka->in[6] + (size_t)l * 31 * 512, ka->in[7] + l * 512, ka->in[8] + l * 512, ka->in[9] + l * 512, A2, tl);
                else conv_unit<4>(lds, 16 * xv + (u - 64), l, Ub, ka->in[3], ka->in[6] + (size_t)l * 31 * 512, ka->in[7] + l * 512, ka->in[8] + l * 512, ka->in[9] + l * 512, A2, tl); }
        } }
        SEAM_X(pb + 1);
        if (IN(pb + 2) && EN(3)) { LAUNDER(); for (int rep = 0; rep < REP(3); ++rep) { for (int u = rv; u < 64; u += NXW) ret_unit(lds, 64 * xv + u, l, Qb, Kb, Vb, Gb, KV, GT, out + O_SRP, A2, tl); } }
        SEAM_X(pb + 2);
        if (IN(pb + 3) && EN(4)) {
            LAUNDER(); {
            pg8::Gemm g{A2, WoutT + (size_t)l * D * D, TP, D, D}; OrderM S; S.init(TP, D, G, cbl, REP(4));
            EpiOutProj E{nullptr, XB, X1B};
            pg8::gemm_phase<EpiOutProj, OrderM, PG8_ALIGN, PG8_SP2>(lds, g, S, E, tl);
            { const SEpiOutProj SE{nullptr, XB, X1B};
              for (int sr = 0; sr < SGREP; ++sr) for (int u = rv; u < 4; u += NXW) sgemm_unit(lds, A2, WoutT + (size_t)l * D * D, u, TP + 64 * xv, SE, tl);
              if (NXW > 4) { if (rv >= 4) QUANT_ITEMS(l, 2272, 5456, ((rv - 4) * 8 + xv) * NWAVES + wavel, (NXW - 4) * 8 * NWAVES); }
              else QUANT_ITEMS(l, 2272, 5456, gw, NGW); }
        } }
        SEAM_X(pb + 3);
        if (IN(pb + 4) && EN(5)) {
            LAUNDER();
            const float* gp = ka->in[11] + l * D; const float* bp = ka->in[12] + l * D;
            constexpr int LR = 3;
            v4f gg[4], bb[4];
#pragma unroll
            for (int j = 0; j < 4; ++j) { gg[j] = *(const v4f*)(gp + lanel * 4 + 256 * j); bb[j] = *(const v4f*)(bp + lanel * 4 + 256 * j); }
            const int xwv = NXW * NWAVES;
            for (int j0 = rv * NWAVES + wavel; j0 < 2112; j0 += LR * xwv) {
                v2u zw[LR][4];
#pragma unroll
                for (int t = 0; t < LR; ++t) { const int row = xcd_row(xv, (j0 + t * xwv < 2112) ? j0 + t * xwv : j0);
#pragma unroll
                    for (int j = 0; j < 4; ++j) zw[t][j] = *(const v2u*)(X1B + (size_t)row * D + lanel * 4 + 256 * j); }
#pragma unroll
                for (int t = 0; t < LR; ++t) { if (j0 + t * xwv < 2112) { const int row = xcd_row(xv, j0 + t * xwv);
                    bf16* zr = X1B + (size_t)row * D + lanel * 4; v4f v[4]; float s = 0.f;
#pragma unroll
                    for (int j = 0; j < 4; ++j) { const v2u w = zw[t][j]; v[j] = (v4f){bflo(w.x), bfhi(w.x), bflo(w.y), bfhi(w.y)}; s += (v[j].x + v[j].y) + (v[j].z + v[j].w); }
                    const float mean = wave_sum(s) * (1.f / D); float q = 0.f;
#pragma unroll
                    for (int j = 0; j < 4; ++j) { v[j] = v[j] - mean; q += (v[j].x * v[j].x + v[j].y * v[j].y) + (v[j].z * v[j].z + v[j].w * v[j].w); }
                    const float rstd = rsqrtf(wave_sum(q) * (1.f / D) + LN_EPS);
#pragma unroll
                    for (int j = 0; j < 4; ++j) { const v4f o = v[j] * rstd * gg[j] + bb[j];
                        v2u w; w.x = cvtpk(o.x, o.y); w.y = cvtpk(o.z, o.w); *(v2u*)(zr + 256 * j) = w; v[j] = o; }
                    float mx = 0.f;
#pragma unroll
                    for (int j = 0; j < 4; ++j) mx = fmaxf(mx, fmaxf(fmaxf(fabsf(v[j].x), fabsf(v[j].y)), fmaxf(fabsf(v[j].z), fabsf(v[j].w))));
                    mx = wave_max(mx); const float xs = mx > 0.f ? 127.f / mx : 0.f;
                    v4u xq;
#pragma unroll
                    for (int j = 0; j < 4; ++j) { unsigned w = 0;
#pragma unroll
                        for (int e = 0; e < 4; ++e) w |= ((unsigned)((int)rintf(v[j][e] * xs)) & 0xffu) << (8 * e);
                        xq[j] = w; }
                    *(v4u*)(XQ + (size_t)row * D + 16 * lanel) = xq; if (lanel == 0) SX[row] = mx * (1.f / 127.f);
                } }
            }
        }
        SEAM_X(pb + 4);
        if (IN(pb + 5) && EN(6)) {
            LAUNDER(); {
            pg8::Gemm g{X1B, WqT + (size_t)l * 2048 * D, TP, 2048, D}; OrderM S; S.init(TP, 2048, G, cbl, REP(6));
            pg8::EpiBf16<0> E{QP, 2048, nullptr, 0, 0, 1.f};
            pg8::gemm_phase<pg8::EpiBf16<0>, OrderM, PG8_ALIGN, PG8_SP2>(lds, g, S, E, tl);
            { const SEpiQ SE{QP};
              for (int sr = 0; sr < SGREP; ++sr) for (int u = rv; u < 8; u += NXW) sgemm_unit(lds, X1B, WqT + (size_t)l * 2048 * D, u, TP + 64 * xv, SE, tl);
              const bool idle = (NXW > 8);
              if (idle) { if (rv >= 8) QUANT_ITEMS(l, 5456, 8192, ((rv - 8) * 8 + xv) * NWAVES + wavel, (NXW - 8) * 8 * NWAVES); }
              else QUANT_ITEMS(l, 5456, 8192, gw, NGW);
              if (l == 0) { const size_t i0 = idle ? (rv >= 8 ? (size_t)((rv - 8) * 8 + xv) * NTHR + tl : (size_t)-1) : gtid, istep = idle ? (size_t)(NXW - 8) * 8 * NTHR : NGT;
                  if (i0 != (size_t)-1) for (size_t i = i0; i < (size_t)NL * 128 * 26 * 128; i += istep) {
                      const size_t c4 = i & 127, rr = (i >> 7) % 26, lb = (i >> 7) / 26;
                      __builtin_nontemporal_store(__builtin_nontemporal_load((const v4f*)(ka->in[3] + (lb * 30 + rr + 4) * 512 + c4 * 4)), (v4f*)(out + O_CCS + (lb * 30 + rr) * 512 + c4 * 4)); } } }
        } }
        if (IN(pb + 5) && IN(pb + 6) && EN(7)) { LAUNDER(); route_stage_keys(lds, rv & 7, l, KEYS, tl); }
        SEAM_X(pb + 5);
        if (IN(pb + 6) && EN(7)) { LAUNDER(); for (int rep = 0; rep < REP(7); ++rep) { { const int head = rv & 7, slot = rv >> 3, nslot = NXW >> 3; if (!IN(pb + 5)) route_stage_keys(lds, head, l, KEYS, tl);
            for (int t = slot; t < 16; t += nslot) route_unit(lds, head, (16 * xv + t) * 128, 128, QP, RI, RG, tl);
            if (slot == 0) route_unit(lds, head, TP + 64 * xv, 64, QP, RI, RG, tl); } } }
        SEAM(pb + 6);
        if (IN(pb + 7) && EN(8)) {
            LAUNDER(); for (int rep = 0; rep < REP(8); ++rep) {
            const SliceMap sm = slice_map((unsigned*)((gu32*)(ws + WS_CTL) + CW_BAR), MISC, G, bxl, tl);
            const unsigned char* ub = UB;
            expert_u_sweep(sm.rank * NWAVES + wavel, sm.cnt * NWAVES, sm.vx, XQ, RI, ub, PD, lanel);
        } }
        SEAM(pb + 7);
        if (IN(pb + 8) && EN(9)) {
            LAUNDER(); for (int rep = 0; rep < REP(9); ++rep) {
            for (int tok = gw; tok < T; tok += 3 * NGW) expert_coefs<3>(tok, NGW, PD, SX, RI, RG, SU + l * 16384, SV + l * 16384, CQ, CS, lanel);
        } }
        SEAM(pb + 8);
        if (IN(pb + 9) && EN(10)) {
            LAUNDER(); for (int rep = 0; rep < REP(10); ++rep) {
            const SliceMap sm = slice_map((unsigned*)((gu32*)(ws + WS_CTL) + CW_BAR), MISC, G, bxl, tl);
            const unsigned char* vb = VB;
            expert_v_sweep(sm.rank * NWAVES + wavel, sm.cnt * NWAVES, sm.vx, RI, CQ, CS, vb, FF, lanel);
        } }
        SEAM(pb + 9);
        if (IN(pb + 10) && EN(11)) {
            LAUNDER(); for (int rep = 0; rep < REP(11); ++rep) {
            float* of = (l == NL - 1) ? out + O_YP : nullptr; bf16* ob = (l == NL - 1) ? nullptr : XB;
            const int xwv = NXW * NWAVES;
            for (int j0 = rv * NWAVES + wavel; j0 < 2112; j0 += 3 * xwv) ln2_tokens<3>(xv, j0, xwv, X1B, FF, ka->in[18] + l * D, ka->in[19] + l * D, of, ob, lanel);
        } }
        if (l + 1 < NL) SEAM_X(pb + 10);
    }
#undef IN
#undef SEAM
#undef SEAM_X
#undef LAUNDER
}

extern "C" void kernel_launch(void* const* d_in, const int* in_sizes, int n_in, void* d_out, int out_size, void* d_ws, size_t ws_size, hipStream_t stream) {
    static int grid = 0;
    if (grid == 0) {
        if (n_in != 20 || out_size != (int)O_END || ws_size < WS_END) { fprintf(stderr, "kernel_launch: unexpected shapes: n_in %d out %d ws %zu\n", n_in, out_size, ws_size); grid = -1; return; }
        int dev = 0, cus = 0, per_cu = 0;
        if (hipGetDevice(&dev) != hipSuccess || hipDeviceGetAttribute(&cus, hipDeviceAttributeMultiprocessorCount, dev) != hipSuccess) { grid = -1; return; }
        if (hipFuncSetAttribute((const void*)mk_fwd, hipFuncAttributeMaxDynamicSharedMemorySize, LDS_BYTES) != hipSuccess) { fprintf(stderr, "kernel_launch: hipFuncSetAttribute failed\n"); grid = -1; return; }
        if (hipOccupancyMaxActiveBlocksPerMultiprocessor(&per_cu, (const void*)mk_fwd, NTHR, LDS_BYTES) != hipSuccess || per_cu < 1) { fprintf(stderr, "kernel_launch: occupancy query says %d blocks per CU\n", per_cu); (void)hipGetLastError(); grid = -1; return; }
        grid = cus - (cus % 64);
        if (grid < 64) { fprintf(stderr, "kernel_launch: needs at least 64 CUs, found %d\n", cus); grid = -1; return; }
    }
    if (grid < 0) return;
    (void)hipMemsetAsync((char*)d_ws + WS_CTL, 0, CTL_ZERO_BYTES, stream);
    Args a{};
    for (int i = 0; i < 20; ++i) a.in[i] = (const float*)d_in[i];
    a.out = (float*)d_out; a.ws = (unsigned char*)d_ws;
#if MK_PER_PHASE
    for (int p = 0; p < N_PHASES; ++p) { a.ph_lo = p; a.ph_hi = p + 1; hipLaunchKernelGGL(mk_fwd, dim3(grid), dim3(NTHR), LDS_BYTES, stream, a); }
#else
    a.ph_lo = 0; a.ph_hi = N_PHASES; hipLaunchKernelGGL(mk_fwd, dim3(grid), dim3(NTHR), LDS_BYTES, stream, a);
#endif
}
```

```cpp
#include <hip/hip_runtime.h>
#include <cstdio>
#include <cstdint>
namespace pg8 {
#define PG8_LAS __attribute__((address_space(3)))
typedef unsigned short bf16_t;
typedef short bf16x8 __attribute__((ext_vector_type(8)));
typedef float f32x4 __attribute__((ext_vector_type(4)));
typedef unsigned u32x4 __attribute__((ext_vector_type(4)));
constexpr int BM = 256, BK = 64, HALF = 128, HTB = HALF * BK * 2  , STAGE_BYTES = 8 * HTB, NXCD = 8, WGM = 8;

__host__ __device__ __forceinline__ int lds_byte(int r, int c) { const int st = (r >> 4) * 2 + (c >> 5), rr = r & 15, cc = c & 31, ob = rr * 64 + cc * 2; return st * 1024 + (ob ^ (((ob >> 9) & 1) << 5)); }
__host__ __device__ __forceinline__ void stage_rc(int b, int& R, int& C) { const int st = b / 1024, sb = b % 1024, swz = sb ^ (((sb >> 9) & 1) << 5); R = (st >> 1) * 16 + swz / 64; C = (st & 1) * 32 + (swz % 64) / 2; }
__host__ __device__ __forceinline__ int perm32(int rho) { const int n = rho >> 4, i = rho & 15; return 8 * (i >> 2) + 4 * n + (i & 3); }

struct Unit { int pm, pn; };
struct Gemm { const bf16_t* A; const bf16_t* Bt; int M, N, K; };

struct StaticOrder {
    int nM, nN, nwg, G, c;
    __host__ __device__ void init(int M, int N, int G_, int c_) { nM = M / BM; nN = N / BM; nwg = nM * nN; G = G_; c = c_; }
    __host__ __device__ bool next(int i, Unit& u) const {
        const long L = (long)i * G + c; if (L >= nwg) return false;
        int wgid = (int)L; { const int q = nwg / NXCD, r = nwg % NXCD, xcd = wgid % NXCD, off = wgid / NXCD; wgid = (xcd < r ? xcd * (q + 1) : r * (q + 1) + (xcd - r) * q) + off; }
        const int nig = WGM * nN, gid = wgid / nig, fm = gid * WGM, gsz = (nM - fm) < WGM ? (nM - fm) : WGM;
        u.pm = fm + ((wgid % nig) % gsz); u.pn = (wgid % nig) / gsz; return true;
    }
    __device__ __forceinline__ void a_ready(const Unit&) const {}
    __device__ __forceinline__ void done(const Unit&) const {}
};

__device__ __forceinline__ unsigned cvt_pk_bf16(float lo, float hi) { unsigned r; asm volatile("v_cvt_pk_bf16_f32 %0, %1, %2" : "=v"(r) : "v"(lo), "v"(hi)); return r; }
typedef float f32x2 __attribute__((ext_vector_type(2)));
__device__ __forceinline__ f32x2 gelu_pk(f32x2 v) {
    const f32x2 av = __builtin_elementwise_abs(v), d = av * 0.2316418882f + 1.0f;
    f32x2 t; t.x = __builtin_amdgcn_rcpf(d.x); t.y = __builtin_amdgcn_rcpf(d.y);
    f32x2 q = t * 0.5307027145f + (-0.7265760135f); q = q * t + 0.7107068705f; q = q * t + (-0.142248368f); q = q * t + 0.127414796f; q = q * t;
    const f32x2 s = (v * v) * (-0.72134752044f);
    f32x2 e; e.x = __builtin_amdgcn_exp2f(s.x); e.y = __builtin_amdgcn_exp2f(s.y);
    const f32x2 m = v * (q * e), r = v - m;
    f32x2 o; o.x = v.x < 0.f ? m.x : r.x; o.y = v.y < 0.f ? m.y : r.y; return o;
}

template <int ACT  > struct EpiBf16 {
    static constexpr bool PERM = true, AFTER_DRAIN = false; static_assert(ACT == 0 || ACT == 1, "EpiBf16: ACT is 0 (none) or 1 (gelu_pk)");
    bf16_t* O; int ldc; const float* bias; int split_cols; size_t split_stride; float scale0;
    __device__ __forceinline__ void operator()(const f32x4 (&acc)[2][2][4][2], const Unit& u, int wr, int wc, int fr, int fq) const {
        const int row0 = u.pm * BM + wr * 64 + fr; int colt = u.pn * BM; bf16_t* base = O;
        float sc = 1.f; if (split_cols) { const int t = colt / split_cols; base += (size_t)t * split_stride; colt -= t * split_cols; if (t == 0) sc = scale0; }
        const int col0 = colt + wc * 32 + 8 * fq, bcol0 = u.pn * BM + wc * 32 + 8 * fq;
        f32x4 bv[2][2];
#pragma unroll
        for (int bj = 0; bj < 2; ++bj)
#pragma unroll
            for (int n = 0; n < 2; ++n) bv[bj][n] = bias ? *(const f32x4*)(bias + bcol0 + bj * HALF + 4 * n) : (f32x4){0.f, 0.f, 0.f, 0.f};
#pragma unroll
        for (int ai = 0; ai < 2; ++ai)
#pragma unroll
            for (int m = 0; m < 4; ++m) { bf16_t* rowp = base + (size_t)(row0 + ai * HALF + m * 16) * ldc + col0;
#pragma unroll
                for (int bj = 0; bj < 2; ++bj) { f32x4 v0 = acc[ai][bj][m][0] + bv[bj][0], v1 = acc[ai][bj][m][1] + bv[bj][1];
                    if (ACT == 1) { f32x2 a = gelu_pk((f32x2){v0[0], v0[1]}), b = gelu_pk((f32x2){v0[2], v0[3]}), c = gelu_pk((f32x2){v1[0], v1[1]}), d = gelu_pk((f32x2){v1[2], v1[3]});
                        v0 = (f32x4){a.x, a.y, b.x, b.y}; v1 = (f32x4){c.x, c.y, d.x, d.y}; }
                    v0 = v0 * sc; v1 = v1 * sc; u32x4 w; w.x = cvt_pk_bf16(v0[0], v0[1]); w.y = cvt_pk_bf16(v0[2], v0[3]); w.z = cvt_pk_bf16(v1[0], v1[1]); w.w = cvt_pk_bf16(v1[2], v1[3]);
                    *(u32x4*)(rowp + bj * HALF) = w; } }
    }
};


template <class Epi, class Sched, bool ALIGN_EPI = false, bool SP2 = false>
__device__ __forceinline__ void gemm_phase(PG8_LAS unsigned char* lds, const Gemm g, const Sched& S, const Epi& E, const int tid) {
    const int wid = __builtin_amdgcn_readfirstlane(tid >> 6), lane = tid & 63, wr = wid >> 2, wc = wid & 3, fr = lane & 15, fq = lane >> 4;
    const int K = g.K, nt = K / BK;
    unsigned voffA[2], voffB[2];
#pragma unroll
    for (int i = 0; i < 2; ++i) { int R, C; stage_rc(tid * 16 + i * 8192, R, C); const int Rb = Epi::PERM ? ((R & ~31) + perm32(R & 31)) : R;
        voffA[i] = (unsigned)(R * K + C) * 2u; voffB[i] = (unsigned)(Rb * K + C) * 2u; }
    const size_t kstep = (size_t)(BK * 2);
    const size_t hstep = (size_t)HALF * K * 2;
    const size_t tstep = 2 * hstep;
    const unsigned ldsw = (unsigned)wid * 1024u;
    const int aoff = lds_byte(wr * 64 + fr, fq * 8), boff = lds_byte(wc * 32 + fr, fq * 8);
#define PG8_SA(b, h) (((b) * 2 + (h)) * HTB)
#define PG8_SB(b, h) ((4 + (b) * 2 + (h)) * HTB)
#define PG8_STAGE(bufoff, gbase, voff) do { _Pragma("unroll") for (int _i = 0; _i < 2; ++_i) \
        __builtin_amdgcn_global_load_lds((const unsigned*)((const char*)(gbase) + (voff)[_i]), (PG8_LAS unsigned*)(lds + (bufoff) + ldsw + _i * 8192), 16, 0, 0); } while (0)
#define PG8_LDA(dst, b, h) do { _Pragma("unroll") for (int m = 0; m < 4; ++m) _Pragma("unroll") for (int k = 0; k < 2; ++k) dst[m][k] = *(const PG8_LAS bf16x8*)(lds + PG8_SA(b, h) + aoff + m * 2048 + k * 1024); } while (0)
#define PG8_LDB(dst, b, h) do { _Pragma("unroll") for (int n = 0; n < 2; ++n) _Pragma("unroll") for (int k = 0; k < 2; ++k) dst[n][k] = *(const PG8_LAS bf16x8*)(lds + PG8_SB(b, h) + boff + n * 2048 + k * 1024); } while (0)
#define PG8_MMA(ai, bj, At, Bt) do { __builtin_amdgcn_s_setprio(1); _Pragma("unroll") for (int m = 0; m < 4; ++m) _Pragma("unroll") for (int n = 0; n < 2; ++n) _Pragma("unroll") for (int k = 0; k < 2; ++k) \
        acc[ai][bj][m][n] = __builtin_amdgcn_mfma_f32_16x16x32_bf16(Bt[n][k], At[m][k], acc[ai][bj][m][n], 0, 0, 0); __builtin_amdgcn_s_setprio(0); } while (0)
#define PG8_WAIT_V(n) asm volatile("s_waitcnt vmcnt(" #n ")" ::: "memory")
#define PG8_WAIT_L(n) asm volatile("s_waitcnt lgkmcnt(" #n ")" ::: "memory")
#define PG8_BAR __builtin_amdgcn_s_barrier()
#define PG8_SCHED __builtin_amdgcn_sched_barrier(0)
    Unit cur, nxt; int ui = 0;
    if (!S.next(0, cur)) return;
    f32x4 acc[2][2][4][2];
#pragma unroll
    for (int a = 0; a < 2; ++a)
#pragma unroll
        for (int b = 0; b < 2; ++b)
#pragma unroll
            for (int m = 0; m < 4; ++m)
#pragma unroll
                for (int n = 0; n < 2; ++n) acc[a][b][m][n] = (f32x4){0.f, 0.f, 0.f, 0.f};
    bf16x8 At[4][2], B0[2][2], B1[2][2];
    const char* cA = (const char*)g.A + (size_t)cur.pm * tstep; const char* cB = (const char*)g.Bt + (size_t)cur.pn * tstep;
    S.a_ready(cur);
    if constexpr (SP2) {
        PG8_STAGE(PG8_SB(0, 0), cB, voffB); PG8_STAGE(PG8_SB(0, 1), cB + hstep, voffB); PG8_STAGE(PG8_SA(0, 0), cA, voffA); PG8_STAGE(PG8_SA(0, 1), cA + hstep, voffA);
        if (wr == 1) PG8_BAR;
        PG8_WAIT_V(2); PG8_BAR;
        PG8_STAGE(PG8_SB(1, 0), cB + kstep, voffB); PG8_STAGE(PG8_SA(1, 0), cA + kstep, voffA); PG8_STAGE(PG8_SB(1, 1), cB + hstep + kstep, voffB);
        PG8_WAIT_V(6); PG8_BAR;
    } else {
        PG8_STAGE(PG8_SB(0, 0), cB, voffB); PG8_STAGE(PG8_SA(0, 0), cA, voffA); PG8_STAGE(PG8_SB(0, 1), cB + hstep, voffB); PG8_STAGE(PG8_SA(0, 1), cA + hstep, voffA);
        if (wr == 1) PG8_BAR;
        PG8_WAIT_V(4); PG8_BAR;
        PG8_STAGE(PG8_SB(1, 0), cB + kstep, voffB); PG8_STAGE(PG8_SA(1, 0), cA + kstep, voffA); PG8_STAGE(PG8_SB(1, 1), cB + hstep + kstep, voffB);
        PG8_WAIT_V(6); PG8_BAR;
    }
    for (;;) {
        const bool has_next = S.next(ui + 1, nxt);
        const char* nA = has_next ? (const char*)g.A + (size_t)nxt.pm * tstep : cA; const char* nB = has_next ? (const char*)g.Bt + (size_t)nxt.pn * tstep : cB;
        for (int t = 0; t < nt; t += 2) {
            const bool last = (t == nt - 2);
            const char* a1 = cA + (size_t)(t + 1) * kstep;
            const char* a2 = last ? nA : cA + (size_t)(t + 2) * kstep; const char* b2 = last ? nB : cB + (size_t)(t + 2) * kstep;
            const char* a3 = a2 + kstep; const char* b3 = b2 + kstep;
            if (last && has_next) S.a_ready(nxt);
            if constexpr (SP2) {
            PG8_LDB(B0, 0, 0); PG8_LDB(B1, 0, 1); PG8_SCHED; PG8_LDA(At, 0, 0); PG8_STAGE(PG8_SA(1, 1), a1 + hstep, voffA);
            PG8_WAIT_V(8); PG8_WAIT_L(0); PG8_BAR; PG8_MMA(0, 0, At, B0); PG8_MMA(0, 1, At, B1); PG8_BAR; PG8_SCHED;
            PG8_LDA(At, 0, 1); PG8_STAGE(PG8_SB(0, 0), b2, voffB); PG8_STAGE(PG8_SB(0, 1), b2 + hstep, voffB); PG8_STAGE(PG8_SA(0, 0), a2, voffA);
            PG8_WAIT_V(8); PG8_WAIT_L(0); PG8_BAR; PG8_MMA(1, 0, At, B0); PG8_MMA(1, 1, At, B1); PG8_BAR; PG8_SCHED;
            PG8_LDB(B0, 1, 0); PG8_LDB(B1, 1, 1); PG8_SCHED; PG8_LDA(At, 1, 0); PG8_STAGE(PG8_SA(0, 1), a2 + hstep, voffA);
            PG8_WAIT_V(8); PG8_WAIT_L(0); PG8_BAR; PG8_MMA(0, 0, At, B0); PG8_MMA(0, 1, At, B1); PG8_BAR; PG8_SCHED;
            PG8_LDA(At, 1, 1); PG8_STAGE(PG8_SB(1, 0), b3, voffB); PG8_STAGE(PG8_SB(1, 1), b3 + hstep, voffB); PG8_STAGE(PG8_SA(1, 0), a3, voffA);
            PG8_WAIT_V(8); PG8_WAIT_L(0); PG8_BAR; PG8_MMA(1, 0, At, B0); PG8_MMA(1, 1, At, B1); PG8_BAR; PG8_SCHED;
            } else {
            PG8_LDB(B0, 0, 0); PG8_SCHED; PG8_LDA(At, 0, 0); PG8_STAGE(PG8_SA(1, 1), a1 + hstep, voffA);
            PG8_WAIT_L(8); PG8_BAR; PG8_WAIT_L(0); PG8_MMA(0, 0, At, B0); PG8_BAR; PG8_SCHED;
            PG8_LDB(B1, 0, 1); PG8_STAGE(PG8_SB(0, 0), b2, voffB);
            PG8_BAR; PG8_WAIT_L(0); PG8_MMA(0, 1, At, B1); PG8_BAR;
            PG8_LDA(At, 0, 1); PG8_STAGE(PG8_SA(0, 0), a2, voffA);
            PG8_BAR; PG8_WAIT_L(0); PG8_MMA(1, 0, At, B0); PG8_BAR; PG8_SCHED;
            PG8_STAGE(PG8_SB(0, 1), b2 + hstep, voffB);
            PG8_WAIT_V(6); PG8_BAR; PG8_MMA(1, 1, At, B1); PG8_BAR;
            PG8_LDB(B0, 1, 0); PG8_SCHED; PG8_LDA(At, 1, 0); PG8_STAGE(PG8_SA(0, 1), a2 + hstep, voffA);
            PG8_WAIT_L(8); PG8_BAR; PG8_WAIT_L(0); PG8_MMA(0, 0, At, B0); PG8_BAR; PG8_SCHED;
            PG8_LDB(B1, 1, 1); PG8_STAGE(PG8_SB(1, 0), b3, voffB);
            PG8_BAR; PG8_WAIT_L(0); PG8_MMA(0, 1, At, B1); PG8_BAR;
            PG8_LDA(At, 1, 1); PG8_STAGE(PG8_SA(1, 0), a3, voffA);
            PG8_BAR; PG8_WAIT_L(0); PG8_MMA(1, 0, At, B0); PG8_BAR; PG8_SCHED;
            PG8_STAGE(PG8_SB(1, 1), b3 + hstep, voffB);
            PG8_WAIT_V(6); PG8_BAR; PG8_MMA(1, 1, At, B1); PG8_BAR;
            }
        }
        if constexpr (ALIGN_EPI) { if (wr == 0) PG8_BAR; }
        if constexpr (!Epi::AFTER_DRAIN) { E(acc, cur, wr, wc, fr, fq); S.done(cur); }
        if (!has_next) break;
#pragma unroll
        for (int a = 0; a < 2; ++a)
#pragma unroll
            for (int b = 0; b < 2; ++b)
#pragma unroll
                for (int m = 0; m < 4; ++m)
#pragma unroll
                    for (int n = 0; n < 2; ++n) acc[a][b][m][n] = (f32x4){0.f, 0.f, 0.f, 0.f};
        cur = nxt; cA = nA; cB = nB; ++ui;
        if constexpr (ALIGN_EPI) { if (wr == 1) PG8_BAR; }
    }
    PG8_WAIT_V(0);
    if constexpr (!ALIGN_EPI) { if (wr == 0) PG8_BAR; }
    PG8_BAR;
    if constexpr (Epi::AFTER_DRAIN) { E.fused(acc, cur, wr, wc, fr, fq, lds, wid, lane); S.done(cur); }
#undef PG8_SA
#undef PG8_SB
#undef PG8_STAGE
#undef PG8_LDA
#undef PG8_LDB
#undef PG8_MMA
#undef PG8_WAIT_V
#undef PG8_WAIT_L
#undef PG8_BAR
#undef PG8_SCHED
}
}
#define GAS __attribute__((address_space(1)))
#define LAS __attribute__((address_space(3)))
typedef unsigned short bf16;
typedef unsigned v4u __attribute__((ext_vector_type(4)));
typedef float f32x4 __attribute__((ext_vector_type(4)));
typedef short bf16x8 __attribute__((ext_vector_type(8)));
typedef GAS unsigned gu32;
typedef GAS unsigned long long gu64;
#define RLX_AGENT __ATOMIC_RELAXED, __HIP_MEMORY_SCOPE_AGENT
#define LDS_WAIT() asm volatile("s_waitcnt lgkmcnt(0)" ::: "memory")
#define VM_WAIT() asm volatile("s_waitcnt vmcnt(0)" ::: "memory")
__device__ __forceinline__ unsigned long long rt() { return __builtin_amdgcn_s_memrealtime(); }
__device__ __forceinline__ unsigned f2bf(float f) { unsigned u = __builtin_bit_cast(unsigned, f); return (u + 0x7fffu + ((u >> 16) & 1u)) >> 16; }
__device__ __forceinline__ unsigned pk2(float lo, float hi) { return f2bf(lo) | (f2bf(hi) << 16); }

#define XB_TMO      128
#define XB_XCNT(j)  (256  + 64 * (j))
#define XB_XSUB(j)  (1280 + 64 * (j))
#define XB_XGEN(j)  (2304 + 64 * (j))
#define XB_TOP      3328
#define XB_TOPGEN   3392
#define XCD_BAR_WORDS 3456
#define XB_SPIN_CAP (1u << 18)

__device__ __forceinline__ unsigned xb_ld(unsigned* p)              { return __hip_atomic_load(p, __ATOMIC_RELAXED, __HIP_MEMORY_SCOPE_AGENT); }
__device__ __forceinline__ unsigned xb_add(unsigned* p, unsigned v) { return __hip_atomic_fetch_add(p, v, __ATOMIC_RELAXED, __HIP_MEMORY_SCOPE_AGENT); }
__device__ __forceinline__ unsigned xb_xcc_id() { return (unsigned)__builtin_amdgcn_s_getreg((3 << 11) | 20) & 0xFu; }
#define XB_SPIN(cond, bar) do { unsigned _sp = 0; while (cond) { __builtin_amdgcn_s_sleep(1); \
    if ((++_sp & 255u) == 0u) { if (xb_ld(&(bar)[XB_TMO])) break; if (_sp > XB_SPIN_CAP) { atomicAdd(&(bar)[XB_TMO], 1u); break; } } } } while (0)

struct XcdBarrier {
    bool lead; unsigned* bar; unsigned x;
    volatile LAS unsigned* st;
};

__device__ __forceinline__ XcdBarrier xcd_barrier_post(unsigned* bar, volatile LAS unsigned* st) {
    XcdBarrier b; b.bar = bar; b.x = xb_xcc_id(); b.st = st;
    if (threadIdx.x == 0) st[2] = xb_add(&bar[XB_XCNT(b.x)], 1u);
    return b;
}
__device__ __forceinline__ void xcd_barrier_complete(unsigned* bar, unsigned x, unsigned& nloc, unsigned& nx) {
    const unsigned G = gridDim.x * gridDim.y * gridDim.z;
    unsigned sum, cnt, mine, sp = 0u;
    for (;;) {
        sum = 0u; cnt = 0u; mine = 0u;
#pragma unroll
        for (unsigned j = 0; j < 16; ++j) { const unsigned c = xb_ld(&bar[XB_XCNT(j)]); sum += c; cnt += (c > 0u) ? 1u : 0u; mine = (j == x) ? c : mine; }
        if (sum == G) break;
        __builtin_amdgcn_s_sleep(1);
        if ((++sp & 255u) == 0u) { if (xb_ld(&bar[XB_TMO])) break; if (sp > XB_SPIN_CAP) { atomicAdd(&bar[XB_TMO], 1u); break; } }
    }
    nloc = mine > 0u ? mine : 1u; nx = cnt > 0u ? cnt : 1u;
}

__device__ __forceinline__ void xcd_barrier(const XcdBarrier& b) {
    asm volatile("s_waitcnt vmcnt(0)" ::: "memory");
    __syncthreads();
    if (b.lead) {
        unsigned* bar = b.bar;
        __builtin_amdgcn_s_waitcnt(0);
        unsigned nloc = b.st[0], nx = b.st[1];
        if (nloc == 0u) { xcd_barrier_complete(bar, b.x, nloc, nx); b.st[0] = nloc; b.st[1] = nx; }
        const unsigned old = xb_add(&bar[XB_XSUB(b.x)], 1u);
        const unsigned gen = old / nloc;
        if (old + 1u == (gen + 1u) * nloc) {
            __builtin_amdgcn_fence(__ATOMIC_RELEASE, "agent");
            asm volatile("s_waitcnt vmcnt(0)" ::: "memory");
            const unsigned og = xb_add(&bar[XB_TOP], 1u);
            const unsigned tg = og / nx;
            if (og + 1u == (tg + 1u) * nx) xb_add(&bar[XB_TOPGEN], 1u);
            else XB_SPIN(xb_ld(&bar[XB_TOPGEN]) == tg, bar);
            __builtin_amdgcn_fence(__ATOMIC_ACQUIRE, "agent");
            xb_add(&bar[XB_XGEN(b.x)], 1u);
            asm volatile("s_waitcnt vmcnt(0)" ::: "memory");
        } else {
            XB_SPIN(xb_ld(&bar[XB_XGEN(b.x)]) == gen, bar);
            __builtin_amdgcn_fence(__ATOMIC_ACQUIRE, "agent");
            asm volatile("s_waitcnt vmcnt(0)" ::: "memory");
        }
    }
    __syncthreads();
}
#ifndef PG8_SP2
#define PG8_SP2 true
#endif
#ifndef PG8_ALIGN
#define PG8_ALIGN true
#endif
#ifndef DIS
#define DIS 0
#endif
#define EN(k) (!((DIS >> (k)) & 1))
#ifndef REPMASK
#define REPMASK 0
#endif
#define REP(k) ((((REPMASK) >> (k)) & 1) ? 2 : 1)
#ifndef SGREP
#define SGREP 1
#endif
#ifndef MK_PER_PHASE
#define MK_PER_PHASE 0
#endif

constexpr int NWAVES = 8, NTHR = 512;
constexpr int D = 1024, TP = 16384, TS = 512, T = TP + TS, NL = 2;
constexpr int INW = 3072, RW = 512, QS = 2048;
constexpr int PHD = 8, NSEL = 128;
constexpr float ALPHA = 1.4142135623730951f, LN_EPS = 1e-5f;
constexpr int PPL = 11, N_PHASES = 1 + PPL * 2;
constexpr size_t O_YP = 0, O_YS = 16777216, O_SRP = 17301504, O_CCP = 18350080, O_SRS = 18595840, O_CCS = 35373056, O_END = 39305216;
constexpr size_t MiB = 1u << 20;
constexpr size_t WS_CTL = 0, CTL_ZERO_BYTES = 1 * MiB;
constexpr size_t WS_ROPE = 1 * MiB;
constexpr size_t WS_WIN = 4 * MiB, WS_WOUT = 16 * MiB, WS_WQ = 20 * MiB, WS_KEYS = 28 * MiB;
constexpr size_t WS_UB = 32 * MiB, WS_VB = 64 * MiB;
constexpr size_t WS_SU = 3 * MiB, WS_SV = 3 * MiB + 131072;
constexpr size_t WS_GT = 96 * MiB, WS_XQ = 328 * MiB  , WS_SX = 3 * MiB + 524288, WS_CC = 363 * MiB;
static_assert(WS_CC + (size_t)16896 * 128 * 4 <= 377 * MiB, "CC inside the dead KV region");
constexpr size_t WS_CQ = 372 * MiB, WS_CS = 3 * MiB + 786432;
constexpr size_t WS_PD = 260 * MiB, WS_FF = 377 * MiB;
constexpr size_t WS_XB = 160 * MiB, WS_XF = 194 * MiB;
constexpr size_t WS_Q = 260 * MiB, WS_K = WS_Q + 1024, WS_V = WS_Q + 2048, WS_G = WS_Q + 3072, WS_U = 328 * MiB;
constexpr size_t WS_KV = 345 * MiB, WS_A2 = 377 * MiB, WS_Z1 = 411 * MiB, WS_X1B = 160 * MiB  , WS_END = 511 * MiB;
constexpr size_t WS_QP = WS_Q;
constexpr size_t WS_RI = 411 * MiB, WS_RG = 416 * MiB;
constexpr int CW_BAR = 4096;
constexpr int CW_XL = 49152;
constexpr int RING_BYTES = 131072, LDSCTL_OFF = 139264, MISC_OFF = LDSCTL_OFF + 320, LDS_BYTES = 147456;
constexpr int R1_LO = 2;
constexpr int PST = 272;

typedef float v4f __attribute__((ext_vector_type(4)));
typedef unsigned v2u __attribute__((ext_vector_type(2)));
typedef unsigned u32x4v __attribute__((ext_vector_type(4)));
typedef float f32x16 __attribute__((ext_vector_type(16)));

__device__ __forceinline__ float bflo(unsigned w) { return __uint_as_float(w << 16); }
__device__ __forceinline__ float bfhi(unsigned w) { return __uint_as_float(w & 0xffff0000u); }
__device__ __forceinline__ float bf2f(bf16 b) { return __uint_as_float((unsigned)b << 16); }
#define WAVE_REDUCE(OP) \
    v = OP(v, __builtin_bit_cast(float, __builtin_amdgcn_update_dpp(0, __builtin_bit_cast(int, v), 0xB1, 0xf, 0xf, false))); \
    v = OP(v, __builtin_bit_cast(float, __builtin_amdgcn_update_dpp(0, __builtin_bit_cast(int, v), 0x4E, 0xf, 0xf, false))); \
    v = OP(v, __builtin_bit_cast(float, __builtin_amdgcn_update_dpp(0, __builtin_bit_cast(int, v), 0x141, 0xf, 0xf, false))); \
    v = OP(v, __builtin_bit_cast(float, __builtin_amdgcn_update_dpp(0, __builtin_bit_cast(int, v), 0x128, 0xf, 0xf, false))); \
    { const unsigned a = __builtin_bit_cast(unsigned, v); const auto r = __builtin_amdgcn_permlane16_swap(a, a, false, false); unsigned r0 = r[0], r1 = r[1]; asm volatile("" : "+v"(r0), "+v"(r1)); v = OP(__builtin_bit_cast(float, r0), __builtin_bit_cast(float, r1)); } \
    { const unsigned a = __builtin_bit_cast(unsigned, v); const auto r = __builtin_amdgcn_permlane32_swap(a, a, false, false); unsigned r0 = r[0], r1 = r[1]; asm volatile("" : "+v"(r0), "+v"(r1)); v = OP(__builtin_bit_cast(float, r0), __builtin_bit_cast(float, r1)); }
__device__ __forceinline__ float wr_add(float a, float b) { return a + b; }
__device__ __forceinline__ float wave_sum(float v) { WAVE_REDUCE(wr_add) return v; }
__device__ __forceinline__ float wave_max(float v) { WAVE_REDUCE(fmaxf) return v; }
#undef WAVE_REDUCE
__device__ __forceinline__ float silu_f(float x) { return x / (1.f + __expf(-x)); }
__device__ __forceinline__ float l2gamma(int h) { return h == 0 ? -0.04580368961312479f : h == 1 ? -0.02272007650008353f : h == 2 ? -0.011315313227834146f : -0.005646563141142063f; }
__device__ __forceinline__ void unpack8(const v4u w, float (&f)[8]) {
    f[0] = bflo(w.x); f[1] = bfhi(w.x); f[2] = bflo(w.y); f[3] = bfhi(w.y); f[4] = bflo(w.z); f[5] = bfhi(w.z); f[6] = bflo(w.w); f[7] = bfhi(w.w);
}
typedef float f32x2_t __attribute__((ext_vector_type(2))); typedef __bf16 bf16x2_t __attribute__((ext_vector_type(2)));
__device__ __forceinline__ unsigned cvtpk(float lo, float hi) { f32x2_t v = {lo, hi}; bf16x2_t b = __builtin_convertvector(v, bf16x2_t); return __builtin_bit_cast(unsigned, b); }
__device__ __forceinline__ v4u pack8(const float (&f)[8]) { v4u w; w.x = pk2(f[0], f[1]); w.y = pk2(f[2], f[3]); w.z = pk2(f[4], f[5]); w.w = pk2(f[6], f[7]); return w; }

__device__ const double INV_FREQ[64] = {
1.0, 0.8659643233600653, 0.7498942093324559, 0.6493816315762113, 0.5623413251903491, 0.4869675251658631, 0.4216965034285822, 0.3651741272548377, 0.31622776601683794, 0.27384196342643613, 0.23713737056616552, 0.2053525026457146, 0.1778279410038923, 0.1539926526059492, 0.1333521432163324, 0.11547819846894582, 0.1, 0.08659643233600653, 0.07498942093324558, 0.06493816315762113, 0.05623413251903491, 0.04869675251658631, 0.042169650342858224, 0.03651741272548377, 0.03162277660168379, 0.027384196342643614, 0.023713737056616554, 0.02053525026457146, 0.01778279410038923, 0.01539926526059492, 0.01333521432163324, 0.011547819846894581, 0.01, 0.008659643233600654, 0.007498942093324558, 0.006493816315762113, 0.005623413251903491, 0.004869675251658631, 0.004216965034285823, 0.003651741272548377, 0.0031622776601683794, 0.0027384196342643613, 0.0023713737056616554, 0.002053525026457146, 0.0017782794100389228, 0.001539926526059492, 0.001333521432163324, 0.0011547819846894581, 0.001, 0.0008659643233600654, 0.0007498942093324559, 0.0006493816315762113, 0.0005623413251903491, 0.0004869675251658631, 0.00042169650342858224, 0.0003651741272548377, 0.00031622776601683794, 0.0002738419634264361, 0.00023713737056616554, 0.0002053525026457146, 0.00017782794100389227, 0.0001539926526059492, 0.0001333521432163324, 0.00011547819846894582};

__device__ __forceinline__ int inproj_slot(int c) {
    if (c < 1024) { const int reg = c >> 9, cc = c & 511, head = cc >> 7, half = (cc >> 6) & 1, dd = cc & 63; return reg * 512 + (head >> 1) * 256 + half * 128 + (head & 1) * 64 + dd; }
    if (c < 2048) return c;
    const int cg = (c >= 2560) ? 1 : 0, ch = (c - 2048) & 511;
    return 2048 + (ch >> 7) * 256 + cg * 128 + (ch & 127);
}
__device__ __forceinline__ void transpose_item(const float* W, int K, int N, bf16* WT, int k0, int n0s, int n0d, LAS float* scr, int lane) {
    float wv[32];
#pragma unroll
    for (int i = 0; i < 32; ++i) wv[i] = __builtin_nontemporal_load(W + (size_t)(k0 + 2 * i + (lane >> 5)) * N + n0s + (lane & 31));
#pragma unroll
    for (int i = 0; i < 32; ++i) scr[(2 * i + (lane >> 5)) * 33 + (lane & 31)] = wv[i];
    LDS_WAIT(); asm volatile("" ::: "memory");
    const int c = lane & 7;
#pragma unroll
    for (int j = 0; j < 4; ++j) { const int n = (lane >> 3) + 8 * j; const LAS float* s = scr + (8 * c) * 33 + n;
        v4u o; o.x = pk2(s[0 * 33], s[1 * 33]); o.y = pk2(s[2 * 33], s[3 * 33]); o.z = pk2(s[4 * 33], s[5 * 33]); o.w = pk2(s[6 * 33], s[7 * 33]);
        *(GAS v4u*)(WT + (size_t)(n0d + n) * K + k0 + 8 * c) = o; }
    LDS_WAIT(); asm volatile("" ::: "memory");
}
__device__ __forceinline__ void cvt_flat(const float* src, bf16* dst, size_t n, size_t gtid, size_t nthr) {
    for (size_t i = gtid * 8; i < n; i += nthr * 8) {
        const v4f a = __builtin_nontemporal_load((const v4f*)(src + i)), b = __builtin_nontemporal_load((const v4f*)(src + i + 4));
        v4u o; o.x = pk2(a.x, a.y); o.y = pk2(a.z, a.w); o.z = pk2(b.x, b.y); o.w = pk2(b.z, b.w);
        *(v4u*)(dst + i) = o;
    }
}

struct EpiInProj {
    static constexpr bool PERM = true, AFTER_DRAIN = false;
    const float* bias; bf16 *Q, *K, *V, *G, *U; const float *cosT, *sinT; float *ccp, *ccs;
    __device__ __forceinline__ void operator()(const pg8::f32x4 (&acc)[2][2][4][2], const pg8::Unit& u, int wr, int wc, int fr, int fq) const {
        const int s0 = wc * 32 + 8 * fq, pn = u.pn;
        const int rowb = u.pm * 256 + wr * 64 + fr;
        if (pn < 4) {
            const int reg = pn >> 1, head = 2 * (pn & 1) + (s0 >> 6), dd0 = s0 & 63;
            const int c0 = reg * 512 + head * 128 + dd0;
            float b0[8], b1[8];
            { const v4f x0 = *(const v4f*)(bias + c0), x1 = *(const v4f*)(bias + c0 + 4), y0 = *(const v4f*)(bias + c0 + 64), y1 = *(const v4f*)(bias + c0 + 68);
#pragma unroll
              for (int i = 0; i < 4; ++i) { b0[i] = x0[i]; b0[4 + i] = x1[i]; b1[i] = y0[i]; b1[4 + i] = y1[i]; } }
            bf16* dst = reg ? K : Q; const float sc = reg ? 0.08838834764831845f : 1.f;
#pragma unroll
            for (int ai = 0; ai < 2; ++ai)
#pragma unroll
                for (int m = 0; m < 4; ++m) {
                    const int row = rowb + ai * 128 + m * 16;
                    const int pidx = row < TP ? (row & 2047) : 2048 + ((row - TP) & 3);
                    const v4f c0v = *(const v4f*)(cosT + pidx * 64 + dd0), c1v = *(const v4f*)(cosT + pidx * 64 + dd0 + 4);
                    const v4f s0v = *(const v4f*)(sinT + pidx * 64 + dd0), s1v = *(const v4f*)(sinT + pidx * 64 + dd0 + 4);
                    float o1[8], o2[8];
#pragma unroll
                    for (int i = 0; i < 8; ++i) {
                        const float t1 = acc[ai][0][m][i >> 2][i & 3] + b0[i], t2 = acc[ai][1][m][i >> 2][i & 3] + b1[i];
                        const float cc = (i < 4) ? c0v[i & 3] : c1v[i & 3], ss = (i < 4) ? s0v[i & 3] : s1v[i & 3];
                        o1[i] = (t1 * cc - t2 * ss) * sc; o2[i] = (t1 * ss + t2 * cc) * sc;
                    }
                    bf16* p = dst + (size_t)row * QS + head * 128 + dd0;
                    *(v4u*)p = pack8(o1); *(v4u*)(p + 64) = pack8(o2);
                }
        } else if (pn < 8) {
            const bool isg = pn >= 6; bf16* dst = isg ? G : V;
#pragma unroll
            for (int bj = 0; bj < 2; ++bj) {
                const int c0 = 256 * pn + 128 * bj + s0, dcol = c0 - (isg ? 1536 : 1024);
                const v4f x0 = *(const v4f*)(bias + c0), x1 = *(const v4f*)(bias + c0 + 4);
#pragma unroll
                for (int ai = 0; ai < 2; ++ai)
#pragma unroll
                    for (int m = 0; m < 4; ++m) {
                        const int row = rowb + ai * 128 + m * 16;
                        float o[8];
#pragma unroll
                        for (int i = 0; i < 8; ++i) { float v = acc[ai][bj][m][i >> 2][i & 3] + ((i < 4) ? x0[i & 3] : x1[i & 3]); o[i] = isg ? silu_f(v) : v; }
                        *(v4u*)(dst + (size_t)row * QS + dcol) = pack8(o);
                    }
            }
        } else {
            const int ch0 = 128 * (pn - 8) + s0;
            const v4f a0 = *(const v4f*)(bias + 2048 + ch0), a1 = *(const v4f*)(bias + 2048 + ch0 + 4), g0 = *(const v4f*)(bias + 2560 + ch0), g1 = *(const v4f*)(bias + 2560 + ch0 + 4);
#pragma unroll
            for (int ai = 0; ai < 2; ++ai)
#pragma unroll
                for (int m = 0; m < 4; ++m) {
                    const int row = rowb + ai * 128 + m * 16;
                    float o[8];
#pragma unroll
                    for (int i = 0; i < 8; ++i) {
                        const float a = acc[ai][0][m][i >> 2][i & 3] + ((i < 4) ? a0[i & 3] : a1[i & 3]), g = acc[ai][1][m][i >> 2][i & 3] + ((i < 4) ? g0[i & 3] : g1[i & 3]);
                        o[i] = a / (1.f + __expf(-g));
                    }
                    *(v4u*)(U + (size_t)row * RW + ch0) = pack8(o);
                    float* cp = nullptr;
                    if (row < TP) { const int t = row & 2047; if (t >= 2018) cp = ccp + ((size_t)(row >> 11) * 30 + (t - 2018)) * 512 + ch0; }
                    else { const int rs = row - TP; cp = ccs + ((size_t)(rs >> 2) * 30 + 26 + (rs & 3)) * 512 + ch0; }
                    if (cp) { *(v4f*)cp = (v4f){o[0], o[1], o[2], o[3]}; *(v4f*)(cp + 4) = (v4f){o[4], o[5], o[6], o[7]}; }
                }
        }
    }
};
struct EpiOutProj {
    static constexpr bool PERM = true, AFTER_DRAIN = false;
    const float* res_f; const bf16* res_b; bf16* Z;
    __device__ __forceinline__ void operator()(const pg8::f32x4 (&acc)[2][2][4][2], const pg8::Unit& u, int wr, int wc, int fr, int fq) const {
        const int col0 = u.pn * 256 + wc * 32 + 8 * fq;
#pragma unroll
        for (int ai = 0; ai < 2; ++ai)
#pragma unroll
            for (int m = 0; m < 4; ++m) {
                const size_t ro = (size_t)(u.pm * 256 + ai * 128 + wr * 64 + m * 16 + fr) * D;
#pragma unroll
                for (int bj = 0; bj < 2; ++bj) { const size_t o = ro + col0 + bj * 128; float r8[8];
                    if (res_f) { const v4f a = *(const v4f*)(res_f + o), b = *(const v4f*)(res_f + o + 4); r8[0] = a.x; r8[1] = a.y; r8[2] = a.z; r8[3] = a.w; r8[4] = b.x; r8[5] = b.y; r8[6] = b.z; r8[7] = b.w; }
                    else unpack8(*(const v4u*)(res_b + o), r8);
                    v4u w; w.x = cvtpk(ALPHA * r8[0] + acc[ai][bj][m][0][0], ALPHA * r8[1] + acc[ai][bj][m][0][1]); w.y = cvtpk(ALPHA * r8[2] + acc[ai][bj][m][0][2], ALPHA * r8[3] + acc[ai][bj][m][0][3]);
                    w.z = cvtpk(ALPHA * r8[4] + acc[ai][bj][m][1][0], ALPHA * r8[5] + acc[ai][bj][m][1][1]); w.w = cvtpk(ALPHA * r8[6] + acc[ai][bj][m][1][2], ALPHA * r8[7] + acc[ai][bj][m][1][3]);
                    *(v4u*)(Z + o) = w; }
            }
    }
};
__device__ __forceinline__ unsigned sg_off(int row, int ch) { return (unsigned)(row * 128 + ((ch ^ ((row >> 1) & 7)) << 4)); }
template <class EpiS> __device__ __forceinline__ void sgemm_unit(LAS unsigned char* lds, const bf16* A, const bf16* Bt, int pn, int row0, const EpiS& E, int tid) {
    const int lane = tid & 63, wave = __builtin_amdgcn_readfirstlane(tid >> 6), r = lane & 31, hl = lane >> 5, mt = wave >> 2, nq = wave & 3;
    const int srow = tid >> 3, sch = tid & 7;
    const unsigned char* ag = (const unsigned char*)(A + (size_t)(row0 + srow) * D) + sch * 16;
    const unsigned char* bg = (const unsigned char*)(Bt + (size_t)(pn * 256 + srow) * D) + sch * 16;
    v4u ra0, ra1, ra2, ra3, rb0[4], rb1[4], rb2[4], rb3[4];
#define SG_LOAD(RA, RB, kc) do { RA = *(const v4u*)(ag + (kc) * 128); _Pragma("unroll") for (int q = 0; q < 4; ++q) RB[q] = *(const v4u*)(bg + (size_t)q * 64 * D * 2 + (kc) * 128); } while (0)
    SG_LOAD(ra0, rb0, 0); SG_LOAD(ra1, rb1, 1); SG_LOAD(ra2, rb2, 2); SG_LOAD(ra3, rb3, 3);
    f32x16 acc0, acc1;
#pragma unroll
    for (int i = 0; i < 16; ++i) { acc0[i] = 0.f; acc1[i] = 0.f; }
#define SG_STAGE(RA, RB, kc) do { LAS unsigned char* buf = lds + ((kc) & 1) * 40960; \
        *(LAS v4u*)(buf + sg_off(srow, sch)) = RA; _Pragma("unroll") for (int q = 0; q < 4; ++q) *(LAS v4u*)(buf + 8192 + sg_off(64 * q + srow, sch)) = RB[q]; \
        if ((kc) + 4 < 16) SG_LOAD(RA, RB, (kc) + 4); \
        __syncthreads(); \
        bf16x8 fa[4], fx0[4], fx1[4];                   \
        _Pragma("unroll") for (int ks = 0; ks < 4; ++ks) { fa[ks] = *(const LAS bf16x8*)(buf + sg_off(32 * mt + r, 2 * ks + hl)); \
            fx0[ks] = *(const LAS bf16x8*)(buf + 8192 + sg_off(32 * nq + r, 2 * ks + hl)); fx1[ks] = *(const LAS bf16x8*)(buf + 8192 + sg_off(128 + 32 * nq + r, 2 * ks + hl)); } \
        __builtin_amdgcn_sched_barrier(0); \
        _Pragma("unroll") for (int ks = 0; ks < 4; ++ks) { acc0 = __builtin_amdgcn_mfma_f32_32x32x16_bf16(fa[ks], fx0[ks], acc0, 0, 0, 0); acc1 = __builtin_amdgcn_mfma_f32_32x32x16_bf16(fa[ks], fx1[ks], acc1, 0, 0, 0); } } while (0)
    SG_STAGE(ra0, rb0, 0); SG_STAGE(ra1, rb1, 1); SG_STAGE(ra2, rb2, 2); SG_STAGE(ra3, rb3, 3); SG_STAGE(ra0, rb0, 4); SG_STAGE(ra1, rb1, 5); SG_STAGE(ra2, rb2, 6); SG_STAGE(ra3, rb3, 7);
    SG_STAGE(ra0, rb0, 8); SG_STAGE(ra1, rb1, 9); SG_STAGE(ra2, rb2, 10); SG_STAGE(ra3, rb3, 11); SG_STAGE(ra0, rb0, 12); SG_STAGE(ra1, rb1, 13); SG_STAGE(ra2, rb2, 14); SG_STAGE(ra3, rb3, 15);
#undef SG_STAGE
#undef SG_LOAD
#pragma unroll
    for (int i = 0; i < 16; ++i) E(row0 + 32 * mt + (i & 3) + 8 * (i >> 2) + 4 * hl, pn, 32 * nq + r, acc0[i], acc1[i]);
    __syncthreads();
}
struct SEpiInProj {
    const float* bias; bf16 *Q, *K, *V, *G, *U; const float *cosT, *sinT; float* ccs;
    __device__ __forceinline__ void operator()(int row, int pn, int s, float v0, float v1) const {
        if (pn < 4) { const int reg = pn >> 1, head = 2 * (pn & 1) + (s >> 6), dd = s & 63, c0 = reg * 512 + head * 128 + dd, pidx = 2048 + ((row - TP) & 3);
            const float t1 = v0 + bias[c0], t2 = v1 + bias[c0 + 64], cc = cosT[pidx * 64 + dd], ss = sinT[pidx * 64 + dd], sc = reg ? 0.08838834764831845f : 1.f;
            bf16* p = (reg ? K : Q) + (size_t)row * QS + head * 128 + dd; p[0] = (bf16)(cvtpk((t1 * cc - t2 * ss) * sc, 0.f) & 0xffffu); p[64] = (bf16)(cvtpk((t1 * ss + t2 * cc) * sc, 0.f) & 0xffffu);
        } else if (pn < 8) { const bool isg = pn >= 6; bf16* dst = (isg ? G : V) + (size_t)row * QS + (256 * pn - (isg ? 1536 : 1024)) + s;
            const float a = v0 + bias[256 * pn + s], b = v1 + bias[256 * pn + 128 + s];
            dst[0] = (bf16)(cvtpk(isg ? silu_f(a) : a, 0.f) & 0xffffu); dst[128] = (bf16)(cvtpk(isg ? silu_f(b) : b, 0.f) & 0xffffu);
        } else { const int ch = 128 * (pn - 8) + s; const float a = v0 + bias[2048 + ch], g = v1 + bias[2560 + ch], u = a / (1.f + __expf(-g));
            U[(size_t)row * RW + ch] = (bf16)(cvtpk(u, 0.f) & 0xffffu); const int rs = row - TP; ccs[((size_t)(rs >> 2) * 30 + 26 + (rs & 3)) * 512 + ch] = u; }
    }
};
struct SEpiOutProj { const float* res_f; const bf16* res_b; bf16* Z;
    __device__ __forceinline__ void operator()(int row, int pn, int s, float v0, float v1) const { const size_t o = (size_t)row * D + pn * 256 + s;
        const float r0 = res_f ? res_f[o] : bf2f(res_b[o]), r1 = res_f ? res_f[o + 128] : bf2f(res_b[o + 128]);
        Z[o] = (bf16)(cvtpk(ALPHA * r0 + v0, 0.f) & 0xffffu); Z[o + 128] = (bf16)(cvtpk(ALPHA * r1 + v1, 0.f) & 0xffffu); } };
struct SEpiQ { bf16* QP;
    __device__ __forceinline__ void operator()(int row, int pn, int s, float v0, float v1) const { bf16* p = QP + (size_t)row * 2048 + pn * 256 + s; p[0] = (bf16)(cvtpk(v0, 0.f) & 0xffffu); p[128] = (bf16)(cvtpk(v1, 0.f) & 0xffffu); } };

struct OrderM {
    int nM, nN, nwg, G, c, mult;
    __device__ void init(int M, int N, int G_, int c_, int mult_) { nM = M / pg8::BM; nN = N / pg8::BM; nwg = nM * nN; G = G_; c = c_; mult = mult_; }
    __device__ bool next(int i, pg8::Unit& u) const {
        const long L = (long)i * G + c; if (L >= (long)nwg * mult) return false;
        int wgid = (int)(L % nwg); { const int q = nwg / pg8::NXCD, r = nwg % pg8::NXCD, xcd = wgid % pg8::NXCD, off = wgid / pg8::NXCD; wgid = (xcd < r ? xcd * (q + 1) : r * (q + 1) + (xcd - r) * q) + off; }
        const int nig = pg8::WGM * nN, gid = wgid / nig, fm = gid * pg8::WGM, gsz = (nM - fm) < pg8::WGM ? (nM - fm) : pg8::WGM;
        u.pm = fm + ((wgid % nig) % gsz); u.pn = (wgid % nig) / gsz; return true;
    }
    __device__ __forceinline__ void a_ready(const pg8::Unit&) const {}
    __device__ __forceinline__ void done(const pg8::Unit&) const {}
};
__device__ __forceinline__ void load_tile128(LAS unsigned char* dst, int stride, const bf16* src, size_t row0, int coff, int tid) {
#pragma unroll
    for (int i = 0; i < 4; ++i) { const int idx = tid + 512 * i, j = idx >> 4, c16 = idx & 15;
        *(LAS v4u*)(dst + j * stride + c16 * 16) = *(const v4u*)(src + (row0 + j) * RW + coff + c16 * 8); }
}
typedef short s16x4 __attribute__((ext_vector_type(4)));
typedef short v4i16_t __attribute__((ext_vector_type(4)));
__device__ __forceinline__ unsigned offb(unsigned row, unsigned ch) { return 256u * row + 16u * (ch ^ (((row & 3u) << 2) | ((row >> 2) & 3u))); }
__device__ __forceinline__ s16x4 trrd(LAS unsigned char* p) { return __builtin_bit_cast(s16x4, __builtin_amdgcn_ds_read_tr16_b64_v4i16((LAS v4i16_t*)p)); }
__device__ __forceinline__ bf16x8 tr_frag(LAS unsigned char* img, int rowlo, int rowhi, int c, int lane) {
    const unsigned blk = (lane >> 4) & 1, q = (lane & 15) >> 2, p = lane & 3, ch = 4 * c + 2 * blk + (p >> 1), o8 = 8 * (p & 1);
    const s16x4 lo = trrd(img + offb(rowlo + q, ch) + o8), hi = trrd(img + offb(rowhi + q, ch) + o8);
    return __builtin_shufflevector(lo, hi, 0, 1, 2, 3, 4, 5, 6, 7);
}
__device__ __forceinline__ bf16x8 row_frag(LAS unsigned char* img, int row0, int ks, int lane) { return *(const LAS bf16x8*)(img + offb(row0 + (lane & 31), 2 * ks + (lane >> 5))); }
__device__ __forceinline__ int crow16(int i, int hl) { return (i & 3) + 8 * (i >> 2) + 4 * hl; }
__device__ __forceinline__ void stage_tile(LAS unsigned char* img, const bf16* src, size_t row0, int coff, float rsc0, float rsc1, bool scaled, int tid, int stride = RW) {
#pragma unroll
    for (int i = 0; i < 4; ++i) { const int idx = tid + 512 * i, j = idx >> 4, ch = idx & 15;
        v4u w = *(const v4u*)(src + (row0 + j) * stride + coff + ch * 8);
        if (scaled) { const float sc = exp2f(rsc0 + (float)j * rsc1); float f[8]; unpack8(w, f);
            w.x = cvtpk(f[0] * sc, f[1] * sc); w.y = cvtpk(f[2] * sc, f[3] * sc); w.z = cvtpk(f[4] * sc, f[5] * sc); w.w = cvtpk(f[6] * sc, f[7] * sc); }
        *(LAS v4u*)(img + offb(j, ch)) = w; }
}
__device__ __forceinline__ void tile_load(v4u (&w)[4], const bf16* src, size_t row0, int coff, int tid, int stride = RW) {
#pragma unroll
    for (int i = 0; i < 4; ++i) { const int idx = tid + 512 * i, j = idx >> 4, ch = idx & 15; w[i] = *(const v4u*)(src + (row0 + j) * stride + coff + ch * 8); }
}
__device__ __forceinline__ void tile_store(LAS unsigned char* img, const v4u (&win)[4], float rsc0, float rsc1, bool scaled, int tid) {
#pragma unroll
    for (int i = 0; i < 4; ++i) { const int idx = tid + 512 * i, j = idx >> 4, ch = idx & 15; v4u w = win[i];
        if (scaled) { const float sc = exp2f(rsc0 + (float)j * rsc1); float f[8]; unpack8(w, f);
            w.x = cvtpk(f[0] * sc, f[1] * sc); w.y = cvtpk(f[2] * sc, f[3] * sc); w.z = cvtpk(f[4] * sc, f[5] * sc); w.w = cvtpk(f[6] * sc, f[7] * sc); }
        *(LAS v4u*)(img + offb(j, ch)) = w; }
}
__device__ __forceinline__ void st_state_bf16(bf16* dst, const f32x16 (&run)[2], int mt, int ntb, int r, int hl) {
    const bool odd = (r & 1) != 0;
#pragma unroll
    for (int t = 0; t < 2; ++t)
#pragma unroll
        for (int i = 0; i < 16; i += 2) {
            const float a0 = run[t][i], a1 = run[t][i + 1];
            const float b0 = __builtin_bit_cast(float, __builtin_amdgcn_update_dpp(0, __builtin_bit_cast(int, a0), 0xB1, 0xf, 0xf, false));
            const float b1 = __builtin_bit_cast(float, __builtin_amdgcn_update_dpp(0, __builtin_bit_cast(int, a1), 0xB1, 0xf, 0xf, false));
            const unsigned w = odd ? cvtpk(b1, a1) : cvtpk(a0, b0);
            const int row = 32 * mt + (odd ? crow16(i + 1, hl) : crow16(i, hl));
            *(unsigned*)(dst + row * 128 + 32 * (ntb + t) + (r & 30)) = w; }
}
__device__ __forceinline__ void kvgroup_unit(LAS unsigned char* lds, int gu, const bf16* Kb, const bf16* Vb, bf16* LP, bf16* GT, int tid) {
    const int h = gu & 3, g = (gu >> 2) & 3, b = gu >> 4, lane = tid & 63, wave = __builtin_amdgcn_readfirstlane(tid >> 6), r = lane & 31, hl = lane >> 5;
    const int mt = wave >> 1, ntb = (wave & 1) * 2; const float lg2 = l2gamma(h), cd = exp2f(128.f * lg2);
    LAS unsigned char* Ks = lds; LAS unsigned char* Vs = lds + 32768;
    f32x16 run[2];
#pragma unroll
    for (int t = 0; t < 2; ++t)
#pragma unroll
        for (int i = 0; i < 16; ++i) run[t][i] = 0.f;
    v4u kw[4], vw[4];
    tile_load(kw, Kb, (size_t)(b * 16 + 4 * g) * 128, h * 128, tid, QS); tile_load(vw, Vb, (size_t)(b * 16 + 4 * g) * 128, h * 128, tid, QS);
#pragma unroll 1
    for (int rr = 0; rr < 4; ++rr) {
        const int n = 4 * g + rr;
        tile_store(Ks, kw, 127.f * lg2, -lg2, true, tid); tile_store(Vs, vw, 0.f, 0.f, false, tid);
        if (rr < 3) { tile_load(kw, Kb, (size_t)(b * 16 + n + 1) * 128, h * 128, tid, QS); tile_load(vw, Vb, (size_t)(b * 16 + n + 1) * 128, h * 128, tid, QS); }
        __syncthreads();
        if (rr > 0) st_state_bf16(LP + (size_t)((b * 16 + n) * 4 + h) * 16384, run, mt, ntb, r, hl);
        f32x16 acc[2];
#pragma unroll
        for (int t = 0; t < 2; ++t)
#pragma unroll
            for (int i = 0; i < 16; ++i) acc[t][i] = 0.f;
#pragma unroll
        for (int ks = 0; ks < 8; ++ks) { const bf16x8 a = tr_frag(Ks, 16 * ks + 8 * hl, 16 * ks + 8 * hl + 4, mt, lane);
#pragma unroll
            for (int t = 0; t < 2; ++t) { const bf16x8 bb = tr_frag(Vs, 16 * ks + 8 * hl, 16 * ks + 8 * hl + 4, ntb + t, lane); acc[t] = __builtin_amdgcn_mfma_f32_32x32x16_bf16(a, bb, acc[t], 0, 0, 0); } }
#pragma unroll
        for (int t = 0; t < 2; ++t)
#pragma unroll
            for (int i = 0; i < 16; ++i) run[t][i] = run[t][i] * cd + acc[t][i];
        __syncthreads();
    }
    st_state_bf16(GT + (size_t)gu * 16384, run, mt, ntb, r, hl);
}
__device__ __forceinline__ void sample_pair_unit(LAS unsigned char* lds, int pu, int l, const bf16* Qb, const bf16* Kb, const bf16* Vb, const bf16* Gb, const float* state_in, float* state_out, bf16* A2, int tid) {
    const int half = tid >> 8, ht = tid & 255, lane = tid & 63, dq = (tid >> 6) & 3;
    const int su = 2 * pu + half, b = su >> 2, h = su & 3, row0 = TP + 4 * b;
    LAS float* base = (LAS float*)(lds + half * 16384);
    LAS float* qT = base;
    LAS float* kT = base + 512;
    LAS float* vs = base + 1024;
    LAS float* sc = base + 1536;
    LAS float* part = base + 1600;
    if (ht < 192) { const int which = ht >> 6, t = (ht >> 4) & 3, ch = ht & 15;
        const bf16* src = which == 0 ? Qb : which == 1 ? Kb : Vb; float f[8]; unpack8(*(const v4u*)(src + (size_t)(row0 + t) * QS + h * 128 + ch * 8), f);
        if (which == 2) {
#pragma unroll
            for (int x = 0; x < 8; ++x) vs[t * 128 + ch * 8 + x] = f[x];
        } else { LAS float* dst = which == 0 ? qT : kT;
#pragma unroll
            for (int x = 0; x < 8; ++x) dst[(ch * 8 + x) * 4 + t] = f[x]; } }
    __syncthreads();
    const float lg2 = l2gamma(h);
    {
        const v4f qa = *(const LAS v4f*)(qT + (2 * lane) * 4), qb = *(const LAS v4f*)(qT + (2 * lane + 1) * 4), ka = *(const LAS v4f*)(kT + (2 * lane) * 4), kb = *(const LAS v4f*)(kT + (2 * lane + 1) * 4);
        const float qx = dq == 0 ? qa.x : dq == 1 ? qa.y : dq == 2 ? qa.z : qa.w, qy = dq == 0 ? qb.x : dq == 1 ? qb.y : dq == 2 ? qb.z : qb.w;
#pragma unroll
        for (int jj = 0; jj < 4; ++jj) { float sp = qx * ka[jj] + qy * kb[jj]; sp = wave_sum(sp); if (lane == 0) sc[dq * 4 + jj] = (jj <= dq) ? sp * exp2f((float)(dq - jj) * lg2) : 0.f; }
    }
    const size_t sbase = ((size_t)(l * 128 + b) * 4 + h) * 16384;
    const float g4 = exp2f(4.f * lg2), g3 = exp2f(3.f * lg2), g2 = exp2f(2.f * lg2), g1 = exp2f(lg2);
    float vt[4][2], cross[4][2];
#pragma unroll
    for (int t = 0; t < 4; ++t) { vt[t][0] = vs[t * 128 + 2 * lane]; vt[t][1] = vs[t * 128 + 2 * lane + 1]; cross[t][0] = 0.f; cross[t][1] = 0.f; }
    typedef float v2f __attribute__((ext_vector_type(2)));
#pragma unroll 1
    for (int db = 0; db < 32; db += 16) {
    v2f rin[16];
#pragma unroll
    for (int dd = 0; dd < 16; ++dd) rin[dd] = __builtin_nontemporal_load((const v2f*)(state_in + sbase + (size_t)(32 * dq + db + dd) * 128 + 2 * lane));
#pragma unroll
    for (int dd = 0; dd < 16; ++dd) { const int d = 32 * dq + db + dd;
        const v2f r = rin[dd];
        const v4f q4 = *(const LAS v4f*)(qT + d * 4), k4 = *(const LAS v4f*)(kT + d * 4);
        const float k0 = k4.x * g3, k1 = k4.y * g2, k2 = k4.z * g1, k3 = k4.w;
        v2f rn;
#pragma unroll
        for (int c = 0; c < 2; ++c) { cross[0][c] += q4.x * r[c]; cross[1][c] += q4.y * r[c]; cross[2][c] += q4.z * r[c]; cross[3][c] += q4.w * r[c];
            rn[c] = g4 * r[c] + (k0 * vt[0][c] + k1 * vt[1][c] + k2 * vt[2][c] + k3 * vt[3][c]); }
        __builtin_nontemporal_store(rn, (v2f*)(state_out + sbase + (size_t)d * 128 + 2 * lane)); }
    }
#pragma unroll
    for (int t = 0; t < 4; ++t) *(LAS v2f*)(part + (dq * 4 + t) * 128 + 2 * lane) = (v2f){cross[t][0], cross[t][1]};
    __syncthreads();
    {   const int t = dq; float o[2];
#pragma unroll
        for (int c = 0; c < 2; ++c) { const int e = 2 * lane + c; float oc = 0.f;
#pragma unroll
            for (int q = 0; q < 4; ++q) oc += part[(q * 4 + t) * 128 + e];
            float oi = 0.f;
#pragma unroll
            for (int jj = 0; jj < 4; ++jj) oi += sc[t * 4 + jj] * vs[jj * 128 + e];
            o[c] = oi + exp2f((float)(t + 1) * lg2) * oc; }
        const float mean = wave_sum(o[0] + o[1]) * (1.f / 128.f), d0 = o[0] - mean, d1 = o[1] - mean;
        const float rstd = rsqrtf(wave_sum(d0 * d0 + d1 * d1) * (1.f / 128.f) + LN_EPS);
        const int row = row0 + t; const unsigned gw2 = *(const unsigned*)(Gb + (size_t)row * QS + h * 128 + 2 * lane);
        *(unsigned*)(A2 + (size_t)row * D + h * 128 + 2 * lane) = cvtpk(d0 * rstd * bflo(gw2), d1 * rstd * bfhi(gw2)); }
    __syncthreads();
}
template <int NT> __device__ __forceinline__ void conv_unit(LAS unsigned char* lds, int cu, int l, const bf16* Ub, const float* cache_in, const float* dwk, const float* dwb, const float* lng, const float* lnb, bf16* A2, int tid) {
    constexpr int NR = NT + 30;
    LAS unsigned char* us = lds; LAS float* ys = (LAS float*)(lds + 65536);
    const int lane = tid & 63, wave = __builtin_amdgcn_readfirstlane(tid >> 6);
    int row0;
    if (NT == 32) { row0 = cu * 32; const int t0 = row0 & 2047;
        v4u w[(NR * 64 + NTHR - 1) / NTHR];
#pragma unroll
        for (int it = 0; it < (NR * 64 + NTHR - 1) / NTHR; ++it) { const int idx = tid + it * NTHR, i = idx >> 6, ch = idx & 63; w[it] = (v4u){0u, 0u, 0u, 0u};
            if (idx < NR * 64 && t0 - 30 + i >= 0) w[it] = *(const v4u*)(Ub + (size_t)(row0 - 30 + i) * RW + ch * 8); }
#pragma unroll
        for (int it = 0; it < (NR * 64 + NTHR - 1) / NTHR; ++it) { const int idx = tid + it * NTHR, i = idx >> 6, ch = idx & 63; if (idx < NR * 64) *(LAS v4u*)(us + i * 1024 + ch * 16) = w[it]; }
    } else { row0 = TP + 4 * cu;
        for (int idx = tid; idx < NR * 64; idx += NTHR) { const int i = idx >> 6, ch = idx & 63; v4u w;
            if (i < 30) { const float* cp = cache_in + ((size_t)(l * 128 + cu) * 30 + i) * 512 + ch * 8; const v4f a = *(const v4f*)cp, b = *(const v4f*)(cp + 4);
                w.x = cvtpk(a.x, a.y); w.y = cvtpk(a.z, a.w); w.z = cvtpk(b.x, b.y); w.w = cvtpk(b.z, b.w); }
            else w = *(const v4u*)(Ub + (size_t)(row0 + i - 30) * RW + ch * 8);
            *(LAS v4u*)(us + i * 1024 + ch * 16) = w; }
    }
    float wk[31];
#pragma unroll
    for (int k = 0; k < 31; ++k) wk[k] = dwk[k * 512 + tid];
    const float bb = dwb[tid];
    __syncthreads();
    constexpr int CT = (NT < 8) ? NT : 8;
#pragma unroll 1
    for (int c0 = 0; c0 < NT; c0 += CT) {
        float y[CT];
#pragma unroll
        for (int t = 0; t < CT; ++t) y[t] = bb;
#pragma unroll
        for (int i = 0; i < CT + 30; ++i) { const float val = bf2f(*(const LAS bf16*)(us + (c0 + i) * 1024 + tid * 2));
#pragma unroll
            for (int t = 0; t < CT; ++t) { if (i - t >= 0 && i - t < 31) y[t] += wk[i - t] * val; } }
#pragma unroll
        for (int t = 0; t < CT; ++t) ys[(c0 + t) * 512 + tid] = y[t];
    }
    __syncthreads();
    constexpr int TPW = (NT + 7) / 8;
    const v4f ga = *(const v4f*)(lng + 4 * lane), gb = *(const v4f*)(lng + 256 + 4 * lane), ba = *(const v4f*)(lnb + 4 * lane), bbv = *(const v4f*)(lnb + 256 + 4 * lane);
#pragma unroll
    for (int tt = 0; tt < TPW; ++tt) { const int t = wave * TPW + tt;
        if (t < NT) {
            v4f a = *(const LAS v4f*)(ys + t * 512 + 4 * lane), b = *(const LAS v4f*)(ys + t * 512 + 256 + 4 * lane);
            const float mean = wave_sum((a.x + a.y) + (a.z + a.w) + (b.x + b.y) + (b.z + b.w)) * (1.f / 512.f);
            a = a - mean; b = b - mean;
            const float rstd = rsqrtf(wave_sum((a.x * a.x + a.y * a.y) + (a.z * a.z + a.w * a.w) + (b.x * b.x + b.y * b.y) + (b.z * b.z + b.w * b.w)) * (1.f / 512.f) + LN_EPS);
            a = a * rstd * ga + ba; b = b * rstd * gb + bbv;
            v2u wa, wb; wa.x = cvtpk(silu_f(a.x), silu_f(a.y)); wa.y = cvtpk(silu_f(a.z), silu_f(a.w)); wb.x = cvtpk(silu_f(b.x), silu_f(b.y)); wb.y = cvtpk(silu_f(b.z), silu_f(b.w));
            bf16* op = A2 + (size_t)(row0 + t) * D + 512 + 4 * lane; *(v2u*)op = wa; *(v2u*)(op + 256) = wb; }
    }
    __syncthreads();
}
__device__ __forceinline__ float sum32_f(float v) {
    v += __builtin_bit_cast(float, __builtin_amdgcn_update_dpp(0, __builtin_bit_cast(int, v), 0xB1, 0xf, 0xf, false));
    v += __builtin_bit_cast(float, __builtin_amdgcn_update_dpp(0, __builtin_bit_cast(int, v), 0x4E, 0xf, 0xf, false));
    v += __builtin_bit_cast(float, __builtin_amdgcn_update_dpp(0, __builtin_bit_cast(int, v), 0x141, 0xf, 0xf, false));
    v += __builtin_bit_cast(float, __builtin_amdgcn_update_dpp(0, __builtin_bit_cast(int, v), 0x128, 0xf, 0xf, false));
    { const unsigned a = __builtin_bit_cast(unsigned, v); const auto r = __builtin_amdgcn_permlane16_swap(a, a, false, false); unsigned r0 = r[0], r1 = r[1]; asm volatile("" : "+v"(r0), "+v"(r1)); v = __builtin_bit_cast(float, r0) + __builtin_bit_cast(float, r1); }
    return v;
}
__device__ __forceinline__ void ret_unit(LAS unsigned char* lds, int uidx, int l, const bf16* Qb, const bf16* Kb, const bf16* Vb, const bf16* Gb, const bf16* LP, const bf16* GT, float* state_out, bf16* A2, int tid) {
    const int h = uidx & 3, bn = uidx >> 2, n = bn & 15, b = bn >> 4, g = n >> 2, rr = n & 3; const size_t row0 = (size_t)bn * 128;
    const int lane = tid & 63, wave = __builtin_amdgcn_readfirstlane(tid >> 6), r = lane & 31, hl = lane >> 5, s = wave & 3, eh = wave >> 2;
    LAS unsigned char* Qs = lds; LAS unsigned char* Ks = lds + 32768; LAS unsigned char* Vs = lds + 65536; LAS float* stat = (LAS float*)(lds + 98304);
    const float lg2 = l2gamma(h);
    LAS unsigned char* Rs = lds + 100352;
    v4u qw[4], kw[4], vw[4];
    tile_load(qw, Qb, row0, h * 128, tid, QS); tile_load(kw, Kb, row0, h * 128, tid, QS); tile_load(vw, Vb, row0, h * 128, tid, QS);
    {
        const int d = tid >> 2, e0 = (tid & 3) * 32; const float cd4 = exp2f(512.f * lg2), gam = exp2f(lg2), cr = exp2f((float)(128 * rr) * lg2);
        const float w2 = (g > 2) ? 1.f : 0.f, w1 = (g > 1) ? ((g > 2) ? cd4 : 1.f) : 0.f, w0 = (g > 0) ? ((g > 2) ? cd4 * cd4 : (g > 1) ? cd4 : 1.f) : 0.f;
#pragma unroll
        for (int hf = 0; hf < 2; ++hf) {
            v4f gb[3][4], lpb[4];
#pragma unroll
            for (int gp = 0; gp < 3; ++gp) { const bf16* src = GT + (size_t)((b * 4 + gp) * 4 + h) * 16384 + d * 128 + e0 + 16 * hf;
#pragma unroll
                for (int x = 0; x < 4; ++x) gb[gp][x] = (v4f){0.f, 0.f, 0.f, 0.f};
                if (gp < g) { const v4u w0_ = *(const v4u*)src, w1_ = *(const v4u*)(src + 8);
                    gb[gp][0] = (v4f){bflo(w0_.x), bfhi(w0_.x), bflo(w0_.y), bfhi(w0_.y)}; gb[gp][1] = (v4f){bflo(w0_.z), bfhi(w0_.z), bflo(w0_.w), bfhi(w0_.w)};
                    gb[gp][2] = (v4f){bflo(w1_.x), bfhi(w1_.x), bflo(w1_.y), bfhi(w1_.y)}; gb[gp][3] = (v4f){bflo(w1_.z), bfhi(w1_.z), bflo(w1_.w), bfhi(w1_.w)}; } }
#pragma unroll
            for (int x = 0; x < 4; ++x) lpb[x] = (v4f){0.f, 0.f, 0.f, 0.f};
            if (rr > 0) { const bf16* src = LP + (size_t)((b * 16 + n) * 4 + h) * 16384 + d * 128 + e0 + 16 * hf; const v4u w0_ = *(const v4u*)src, w1_ = *(const v4u*)(src + 8);
                lpb[0] = (v4f){bflo(w0_.x), bfhi(w0_.x), bflo(w0_.y), bfhi(w0_.y)}; lpb[1] = (v4f){bflo(w0_.z), bfhi(w0_.z), bflo(w0_.w), bfhi(w0_.w)};
                lpb[2] = (v4f){bflo(w1_.x), bfhi(w1_.x), bflo(w1_.y), bfhi(w1_.y)}; lpb[3] = (v4f){bflo(w1_.z), bfhi(w1_.z), bflo(w1_.w), bfhi(w1_.w)}; }
            v4f rv[4];
#pragma unroll
            for (int x = 0; x < 4; ++x) rv[x] = gb[0][x] * w0 + gb[1][x] * w1 + gb[2][x] * w2;
            if (n == 15) { const bf16* src = GT + (size_t)((b * 4 + 3) * 4 + h) * 16384 + d * 128 + e0 + 16 * hf; float* dst = state_out + ((size_t)((l * 8 + b) * 4 + h)) * 16384 + d * 128 + e0 + 16 * hf;
                const v4u w0_ = *(const v4u*)src, w1_ = *(const v4u*)(src + 8);
                *(v4f*)(dst + 0) = rv[0] * cd4 + (v4f){bflo(w0_.x), bfhi(w0_.x), bflo(w0_.y), bfhi(w0_.y)}; *(v4f*)(dst + 4) = rv[1] * cd4 + (v4f){bflo(w0_.z), bfhi(w0_.z), bflo(w0_.w), bfhi(w0_.w)};
                *(v4f*)(dst + 8) = rv[2] * cd4 + (v4f){bflo(w1_.x), bfhi(w1_.x), bflo(w1_.y), bfhi(w1_.y)}; *(v4f*)(dst + 12) = rv[3] * cd4 + (v4f){bflo(w1_.z), bfhi(w1_.z), bflo(w1_.w), bfhi(w1_.w)}; }
#pragma unroll
            for (int x = 0; x < 2; ++x) { const v4f o0 = (rv[2 * x] * cr + lpb[2 * x]) * gam, o1 = (rv[2 * x + 1] * cr + lpb[2 * x + 1]) * gam;
                *(LAS v4u*)(Rs + offb(d, (e0 >> 3) + 2 * hf + x)) = (v4u){cvtpk(o0.x, o0.y), cvtpk(o0.z, o0.w), cvtpk(o1.x, o1.y), cvtpk(o1.z, o1.w)}; }
            asm volatile("" ::: "memory");
        }
    }
    asm volatile("" ::: "memory");
    tile_store(Qs, qw, 0.f, lg2, true, tid); tile_store(Ks, kw, 0.f, -lg2, true, tid); tile_store(Vs, vw, 0.f, 0.f, false, tid);
    __syncthreads();
    f32x16 st[4];
#pragma unroll
    for (int mt = 0; mt < 4; ++mt) {
#pragma unroll
        for (int i = 0; i < 16; ++i) st[mt][i] = 0.f;
        if (mt <= s) {
#pragma unroll
            for (int ks = 0; ks < 8; ++ks) st[mt] = __builtin_amdgcn_mfma_f32_32x32x16_bf16(row_frag(Ks, 32 * mt, ks, lane), row_frag(Qs, 32 * s, ks, lane), st[mt], 0, 0, 0);
            if (mt == s) {
#pragma unroll
                for (int i = 0; i < 16; ++i) st[mt][i] = (crow16(i, hl) > r) ? 0.f : st[mt][i];
            }
        }
    }
    f32x16 oa[2];
#pragma unroll
    for (int t = 0; t < 2; ++t)
#pragma unroll
        for (int i = 0; i < 16; ++i) oa[t][i] = 0.f;
#pragma unroll
    for (int mt = 0; mt < 4; ++mt) if (mt <= s) {
#pragma unroll
        for (int s2 = 0; s2 < 2; ++s2) {
            u32x4v pa; pa.x = cvtpk(st[mt][8 * s2], st[mt][8 * s2 + 1]); pa.y = cvtpk(st[mt][8 * s2 + 2], st[mt][8 * s2 + 3]); pa.z = cvtpk(st[mt][8 * s2 + 4], st[mt][8 * s2 + 5]); pa.w = cvtpk(st[mt][8 * s2 + 6], st[mt][8 * s2 + 7]);
            const bf16x8 a = __builtin_bit_cast(bf16x8, pa);
#pragma unroll
            for (int t = 0; t < 2; ++t) oa[t] = __builtin_amdgcn_mfma_f32_32x32x16_bf16(a, tr_frag(Vs, 32 * mt + 16 * s2 + 4 * hl, 32 * mt + 16 * s2 + 8 + 4 * hl, 2 * eh + t, lane), oa[t], 0, 0, 0);
        }
    }
#pragma unroll
    for (int ks = 0; ks < 8; ++ks) { const bf16x8 a = row_frag(Qs, 32 * s, ks, lane);
#pragma unroll
        for (int t = 0; t < 2; ++t) oa[t] = __builtin_amdgcn_mfma_f32_32x32x16_bf16(a, tr_frag(Rs, 16 * ks + 8 * hl, 16 * ks + 8 * hl + 4, 2 * eh + t, lane), oa[t], 0, 0, 0); }
#pragma unroll
    for (int i = 0; i < 16; ++i) { float ps = oa[0][i] + oa[1][i], pq = oa[0][i] * oa[0][i] + oa[1][i] * oa[1][i];
        ps = sum32_f(ps); pq = sum32_f(pq);
        if (r == 0) { stat[(wave * 32 + crow16(i, hl)) * 2] = ps; stat[(wave * 32 + crow16(i, hl)) * 2 + 1] = pq; } }
    v4u gw[4]; tile_load(gw, Gb, row0, h * 128, tid, QS);
    __syncthreads();
#pragma unroll
    for (int i = 0; i < 16; ++i) { const int rl = crow16(i, hl);
        const float sm = stat[(s * 32 + rl) * 2] + stat[((s + 4) * 32 + rl) * 2], sq = stat[(s * 32 + rl) * 2 + 1] + stat[((s + 4) * 32 + rl) * 2 + 1];
        const float mean = sm * (1.f / 128.f), var = fmaxf(sq * (1.f / 128.f) - mean * mean, 0.f), rstd = rsqrtf(var + LN_EPS);
#pragma unroll
        for (int t = 0; t < 2; ++t) { const int e = 64 * eh + 32 * t + r;
            *(LAS bf16*)(Qs + offb(32 * s + rl, e >> 3) + (e & 7) * 2) = (bf16)(cvtpk((oa[t][i] - mean) * rstd, 0.f) & 0xffffu); } }
    __syncthreads();
#pragma unroll
    for (int i = 0; i < 4; ++i) { const int idx = tid + 512 * i, j = idx >> 4, ch = idx & 15;
        float o8[8], g8[8]; unpack8(*(const LAS v4u*)(Qs + offb(j, ch)), o8); unpack8(gw[i], g8);
        v4u w; w.x = cvtpk(o8[0] * g8[0], o8[1] * g8[1]); w.y = cvtpk(o8[2] * g8[2], o8[3] * g8[3]); w.z = cvtpk(o8[4] * g8[4], o8[5] * g8[5]); w.w = cvtpk(o8[6] * g8[6], o8[7] * g8[7]);
        *(v4u*)(A2 + (row0 + j) * D + h * 128 + ch * 8) = w; }
    __syncthreads();
}
__host__ __device__ __forceinline__ void ce_desc(float& a, float& b) { const float hi = fmaxf(a, b), lo = fminf(a, b); a = hi; b = lo; }
template <int N> __host__ __device__ __forceinline__ void bitonic_sort_desc(float (&a)[N]) {
#pragma unroll
    for (int k = 2; k <= N; k <<= 1)
#pragma unroll
        for (int j = k >> 1; j > 0; j >>= 1)
#pragma unroll
            for (int i = 0; i < N; ++i) { const int p = i ^ j; if (p > i) { if ((i & k) == 0) ce_desc(a[i], a[p]); else ce_desc(a[p], a[i]); } }
}
template <int N> __host__ __device__ __forceinline__ void bitonic_merge_desc(float (&a)[N]) {
#pragma unroll
    for (int j = N >> 1; j > 0; j >>= 1)
#pragma unroll
        for (int i = 0; i < N; ++i) { const int p = i ^ j; if (p > i) ce_desc(a[i], a[p]); }
}
__host__ __device__ __forceinline__ void merge_top16(float (&a)[16], const float (&b)[16]) {
#pragma unroll
    for (int i = 0; i < 16; ++i) a[i] = fmaxf(a[i], b[15 - i]);
    bitonic_merge_desc<16>(a);
}
__host__ __device__ __forceinline__ void top16_of_64(float (&g0)[16], float (&g1)[16], float (&g2)[16], float (&g3)[16]) {
    bitonic_sort_desc<16>(g0); bitonic_sort_desc<16>(g1); bitonic_sort_desc<16>(g2); bitonic_sort_desc<16>(g3);
    merge_top16(g0, g1); merge_top16(g2, g3); merge_top16(g0, g2);
}
__host__ __device__ __forceinline__ float pack_low(float v, unsigned mask, unsigned code) { unsigned u = __builtin_bit_cast(unsigned, v); u = (u & ~mask) | code; return __builtin_bit_cast(float, u); }
__host__ __device__ constexpr int cand_i(int n) { return n < 16 ? 0 : n < 24 ? 1 : n < 29 ? 2 : n < 33 ? 3 : n < 36 ? 4 : n < 38 ? 5 : n < 40 ? 6 : n < 42 ? 7 : n - 34; }
__host__ __device__ constexpr int cand_j(int n) { return n < 16 ? n : n < 24 ? n - 16 : n < 29 ? n - 24 : n < 33 ? n - 29 : n < 36 ? n - 33 : n < 38 ? n - 36 : n < 40 ? n - 38 : n < 42 ? n - 40 : 0; }
__host__ __device__ __forceinline__ void top16_pair_sums(const float (&v1)[16], const float (&v2)[16], float (&c0)[16]) {
    float c1[16], c2[16], c3[16];
    const float ninf = __builtin_bit_cast(float, 0xff800000u);
#define PS_C(n) pack_low(v1[cand_i(n)] + v2[cand_j(n)], 0xffu, (unsigned)((cand_i(n) << 4) | cand_j(n)))
#pragma unroll
    for (int n = 0; n < 16; ++n) { c0[n] = PS_C(n); c1[n] = PS_C(16 + n); c2[n] = PS_C(32 + n); }
    c3[0] = PS_C(48); c3[1] = PS_C(49);
#pragma unroll
    for (int n = 2; n < 16; ++n) c3[n] = ninf;
#undef PS_C
    top16_of_64(c0, c1, c2, c3);
}

__device__ __forceinline__ void route_stage_keys(LAS unsigned char* lds, int head, int l, const bf16* KEYS, int tid) {
    stage_tile(lds, KEYS + (size_t)((l * 2 + 0) * 8 + head) * 16384, 0, 0, 0.f, 0.f, false, tid, 128);
    stage_tile(lds + 32768, KEYS + (size_t)((l * 2 + 1) * 8 + head) * 16384, 0, 0, 0.f, 0.f, false, tid, 128);
}
__device__ __forceinline__ void route_unit(LAS unsigned char* lds, int head, int tok0, int ntok, const bf16* QP, unsigned short* RI, float* RG, int tid) {
    const int wave = __builtin_amdgcn_readfirstlane(tid >> 6), lane = tid & 63, side = wave >> 2, sub = wave & 3, r = lane & 31, hl = lane >> 5;
    LAS unsigned char* Ks = lds + side * 32768; LAS unsigned char* Qs = lds + 65536 + side * 32768;
    stage_tile(lds + 65536, QP, tok0, head * 256, 0.f, 0.f, false, tid, 2048); stage_tile(lds + 98304, QP, tok0, head * 256 + 128, 0.f, 0.f, false, tid, 2048);
    __syncthreads();
    f32x16 acc[4];
#pragma unroll
    for (int mt = 0; mt < 4; ++mt)
#pragma unroll
        for (int i = 0; i < 16; ++i) acc[mt][i] = 0.f;
#pragma unroll
    for (int ks = 0; ks < 8; ++ks) { const bf16x8 bq = row_frag(Qs, 32 * sub, ks, lane);
#pragma unroll
        for (int mt = 0; mt < 4; ++mt) acc[mt] = __builtin_amdgcn_mfma_f32_32x32x16_bf16(row_frag(Ks, 32 * mt, ks, lane), bq, acc[mt], 0, 0, 0); }
    float g0[16], g1[16], g2[16], g3[16];
#pragma unroll
    for (int i = 0; i < 16; ++i) { const unsigned kr = (unsigned)((i & 3) + 8 * (i >> 2) + 4 * hl);
        g0[i] = pack_low(acc[0][i], 127u, kr); g1[i] = pack_low(acc[1][i], 127u, 32u + kr); g2[i] = pack_low(acc[2][i], 127u, 64u + kr); g3[i] = pack_low(acc[3][i], 127u, 96u + kr); }
    top16_of_64(g0, g1, g2, g3);
#pragma unroll
    for (int i = 0; i < 16; ++i) { const unsigned a = __builtin_bit_cast(unsigned, g0[15 - i]); const auto rr = __builtin_amdgcn_permlane32_swap(a, a, false, false); unsigned r0 = rr[0], r1 = rr[1]; asm volatile("" : "+v"(r0), "+v"(r1));
        g1[i] = __builtin_bit_cast(float, hl ? r0 : r1); }
#pragma unroll
    for (int i = 0; i < 16; ++i) g0[i] = fmaxf(g0[i], g1[i]);
    bitonic_merge_desc<16>(g0);
    __syncthreads();
    LAS float* cand = (LAS float*)(lds + 65536);
    if (hl == 0) { LAS v4f* p = (LAS v4f*)(cand + ((side * 128) + sub * 32 + r) * 16);
#pragma unroll
        for (int x = 0; x < 4; ++x) p[x] = (v4f){g0[4 * x], g0[4 * x + 1], g0[4 * x + 2], g0[4 * x + 3]}; }
    __syncthreads();
    if (tid < ntok) {
        float v1[16], v2[16], c0[16];
#pragma unroll
        for (int x = 0; x < 4; ++x) { const v4f a = *(const LAS v4f*)(cand + tid * 16 + 4 * x), b = *(const LAS v4f*)(cand + (128 + tid) * 16 + 4 * x);
            v1[4 * x] = a.x; v1[4 * x + 1] = a.y; v1[4 * x + 2] = a.z; v1[4 * x + 3] = a.w; v2[4 * x] = b.x; v2[4 * x + 1] = b.y; v2[4 * x + 2] = b.z; v2[4 * x + 3] = b.w; }
        top16_pair_sums(v1, v2, c0);
        float e[16], se = 0.f;
#pragma unroll
        for (int k = 0; k < 16; ++k) { e[k] = __expf(c0[k] - c0[0]); se += e[k]; }
        const float inv = 1.f / se;
        const LAS unsigned* cb = (const LAS unsigned*)cand;
        unsigned short* ri = RI + (size_t)(tok0 + tid) * NSEL + head * 16; float* rg = RG + (size_t)(tok0 + tid) * NSEL + head * 16;
#pragma unroll
        for (int x = 0; x < 4; ++x) { int ii[4]; float gg[4];
#pragma unroll
            for (int y = 0; y < 4; ++y) { const int k = 4 * x + y; const unsigned code = __builtin_bit_cast(unsigned, c0[k]) & 0xffu;
                const unsigned e1 = cb[tid * 16 + (code >> 4)] & 127u, e2 = cb[(128 + tid) * 16 + (code & 15u)] & 127u;
                ii[y] = (int)(e1 * 128u + e2); gg[y] = e[k] * inv; }
            *(v2u*)(ri + 4 * x) = (v2u){(unsigned)ii[0] | ((unsigned)ii[1] << 16), (unsigned)ii[2] | ((unsigned)ii[3] << 16)}; *(v4f*)(rg + 4 * x) = (v4f){gg[0], gg[1], gg[2], gg[3]}; }
    }
    __syncthreads();
}
template <int NR> __device__ __forceinline__ void quant_rows(const float* src, unsigned char* dstl, int row, float* scale_out, int offset_binary, int lane) {
    v4f v[NR][4]; float m[NR];
#pragma unroll
    for (int r = 0; r < NR; ++r)
#pragma unroll
        for (int j = 0; j < 4; ++j) v[r][j] = __builtin_nontemporal_load((const v4f*)(src + (size_t)r * D + 256 * j + 4 * lane));
#pragma unroll
    for (int r = 0; r < NR; ++r) { float mm = 0.f;
#pragma unroll
        for (int j = 0; j < 4; ++j) mm = fmaxf(mm, fmaxf(fmaxf(fabsf(v[r][j].x), fabsf(v[r][j].y)), fmaxf(fabsf(v[r][j].z), fabsf(v[r][j].w))));
        m[r] = mm; }
#pragma unroll
    for (int r = 0; r < NR; ++r) m[r] = wave_max(m[r]);
    const int off = offset_binary ? 128 : 0;
#pragma unroll
    for (int r = 0; r < NR; ++r) { const float sc = m[r] > 0.f ? 127.f / m[r] : 0.f; v4u o;
#pragma unroll
        for (int j = 0; j < 4; ++j) { unsigned w = 0;
#pragma unroll
            for (int e = 0; e < 4; ++e) { const int q = (int)rintf(v[r][j][e] * sc) + off; w |= ((unsigned)q & 0xffu) << (8 * e); }
            o[j] = w; }
        __builtin_nontemporal_store(o, (v4u*)(dstl + (size_t)(lane >> 3) * (16384 * 128) + (size_t)(row + r) * 128 + 16 * (lane & 7)));
        if (lane == 0) scale_out[r] = m[r] * (1.f / 127.f); }
}
__device__ __forceinline__ float ub0(unsigned w) { return (float)(w & 0xffu); }
__device__ __forceinline__ float ub1(unsigned w) { return (float)((w >> 8) & 0xffu); }
__device__ __forceinline__ float ub2(unsigned w) { return (float)((w >> 16) & 0xffu); }
__device__ __forceinline__ float ub3(unsigned w) { return (float)(w >> 24); }
struct SliceMap { int vx, rank, cnt; };
__device__ __forceinline__ SliceMap slice_map(unsigned* bar, volatile LAS unsigned* MISC, int G, int bx, int tid) {
    if (tid == 0) { const unsigned x = xb_xcc_id(); unsigned bad = (x >= 8u) ? 1u : 0u, mine = 0u;
#pragma unroll 1
        for (unsigned j = 0; j < 16; ++j) { const unsigned c = xb_ld(&bar[XB_XCNT(j)]); bad |= (j < 8u) ? (c == 0u ? 1u : 0u) : (c != 0u ? 1u : 0u); mine = (j == x) ? c : mine; }
        if (!bad) { MISC[12] = x; MISC[13] = MISC[10]; MISC[14] = mine; }
        else { MISC[12] = (unsigned)(bx & 7); MISC[13] = (unsigned)(bx >> 3); MISC[14] = (unsigned)((G - (bx & 7) + 7) >> 3); } }
    __syncthreads();
    SliceMap m; m.vx = (int)MISC[12]; m.rank = (int)MISC[13]; m.cnt = (int)MISC[14];
    __syncthreads();
    return m;
}
#define DPP_XOR1 0xB1
#define DPP_XOR2 0x4E
#define DPP_HMIR 0x141
#define DPP_ROR8 0x128
__device__ __forceinline__ int sum8_i(int t) { t += __builtin_amdgcn_update_dpp(0, t, DPP_XOR1, 0xf, 0xf, false); t += __builtin_amdgcn_update_dpp(0, t, DPP_XOR2, 0xf, 0xf, false); t += __builtin_amdgcn_update_dpp(0, t, DPP_HMIR, 0xf, 0xf, false); return t; }
__device__ __forceinline__ void expert_u_sweep(int tok0, int step, int vx, const unsigned char* XQ, const unsigned short* RI, const unsigned char* UB, int* PD, int lane) {
    const int g = lane >> 3, c = lane & 7;
    const unsigned char* us = UB + (size_t)vx * (16384 * 128) + 16 * c;
    const bool b0 = c & 1, b1 = c & 2, b2 = c & 4;
    v4u en[2]; v4u xn;
    if (tok0 < T) {
#pragma unroll
        for (int x = 0; x < 2; ++x) en[x] = *(const v4u*)(RI + (size_t)tok0 * NSEL + 16 * g + 8 * x);
        xn = *(const v4u*)(XQ + (size_t)tok0 * D + 128 * vx + 16 * c); }
#pragma unroll 1
    for (int tok = tok0; tok < T; tok += step) {
        int ev[16];
#pragma unroll
        for (int x = 0; x < 2; ++x)
#pragma unroll
            for (int y = 0; y < 4; ++y) { ev[8 * x + 2 * y] = (int)(en[x][y] & 0xffffu); ev[8 * x + 2 * y + 1] = (int)(en[x][y] >> 16); }
        const v4u xw = xn;
        v4u ub[16];
#pragma unroll
        for (int kk = 0; kk < 16; ++kk) ub[kk] = *(const v4u*)(us + (size_t)ev[kk] * 128);
        const int tn = tok + step;
        if (tn < T) {
#pragma unroll
            for (int x = 0; x < 2; ++x) en[x] = *(const v4u*)(RI + (size_t)tn * NSEL + 16 * g + 8 * x);
            xn = *(const v4u*)(XQ + (size_t)tn * D + 128 * vx + 16 * c); }
        int t[16];
#pragma unroll
        for (int kk = 0; kk < 16; ++kk) { int a = __builtin_amdgcn_sdot4((int)ub[kk].x, (int)xw.x, 0, false); a = __builtin_amdgcn_sdot4((int)ub[kk].y, (int)xw.y, a, false);
            a = __builtin_amdgcn_sdot4((int)ub[kk].z, (int)xw.z, a, false); a = __builtin_amdgcn_sdot4((int)ub[kk].w, (int)xw.w, a, false); t[kk] = sum8_i(a); }
        int lo, hi;
        { const int a0 = b0 ? t[2] : t[0], a1 = b0 ? t[6] : t[4], a2 = b0 ? t[10] : t[8], a3 = b0 ? t[14] : t[12]; const int c0 = b1 ? a1 : a0, c1 = b1 ? a3 : a2; lo = b2 ? c1 : c0; }
        { const int a0 = b0 ? t[3] : t[1], a1 = b0 ? t[7] : t[5], a2 = b0 ? t[11] : t[9], a3 = b0 ? t[15] : t[13]; const int c0 = b1 ? a1 : a0, c1 = b1 ? a3 : a2; hi = b2 ? c1 : c0; }
        typedef int v2i __attribute__((ext_vector_type(2)));
        *(v2i*)(PD + ((size_t)vx * T + tok) * NSEL + 2 * lane) = (v2i){lo, hi};
    }
}
template <int NT> __device__ __forceinline__ void expert_coefs(int tok, int dt, const int* PD, const float* SX, const unsigned short* RI, const float* RG, const float* SU, const float* SV, unsigned char* CQ, float* CS, int lane) {
    int pd[NT][2][8], ev[NT][2]; float gv[NT][2], sxv[NT];
#pragma unroll
    for (int t = 0; t < NT; ++t) { const int tk = (tok + t * dt < T) ? tok + t * dt : tok;
        sxv[t] = SX[tk];
#pragma unroll
        for (int kh = 0; kh < 2; ++kh) { const int k = 64 * kh + lane; ev[t][kh] = (int)RI[(size_t)tk * NSEL + k]; gv[t][kh] = RG[(size_t)tk * NSEL + k];
#pragma unroll
            for (int x = 0; x < 8; ++x) pd[t][kh][x] = __builtin_nontemporal_load(PD + ((size_t)x * T + tk) * NSEL + k); } }
    float suv[NT][2], svv[NT][2];
#pragma unroll
    for (int t = 0; t < NT; ++t)
#pragma unroll
        for (int kh = 0; kh < 2; ++kh) { suv[t][kh] = SU[ev[t][kh]]; svv[t][kh] = SV[ev[t][kh]]; }
#pragma unroll
    for (int t = 0; t < NT; ++t) { const int tk = tok + t * dt; float cv[2];
#pragma unroll
        for (int kh = 0; kh < 2; ++kh) { int sum = 0;
#pragma unroll
            for (int x = 0; x < 8; ++x) sum += pd[t][kh][x];
            const float dot = (float)sum * (suv[t][kh] * sxv[t]);
            cv[kh] = gv[t][kh] * 0.5f * dot * (1.f + erff(dot * 0.7071067811865476f)) * svv[t][kh]; }
        const float mx = wave_max(fmaxf(fabsf(cv[0]), fabsf(cv[1]))), qs = mx > 0.f ? 127.f / mx : 0.f;
        if (tk < T) { CQ[(size_t)tk * NSEL + lane] = (unsigned char)((int)rintf(cv[0] * qs) & 0xff); CQ[(size_t)tk * NSEL + 64 + lane] = (unsigned char)((int)rintf(cv[1] * qs) & 0xff);
            if (lane == 0) CS[tk] = mx * (1.f / 127.f); } }
}
__device__ __forceinline__ void expert_v_sweep(int tok0, int step, int vx, const unsigned short* RI, const unsigned char* CQ, const float* CS, const unsigned char* VB, bf16* FF, int lane) {
    const int g = lane >> 3, c = lane & 7;
    const unsigned char* vs = VB + (size_t)vx * (16384 * 128) + 16 * c;
    const bool b3 = (lane & 8) != 0; const int jj = 2 * ((lane >> 5) & 1) + ((lane >> 4) & 1), e0 = 2 * ((lane >> 3) & 1);
    v4u en[2]; v4u cqn; float csn = 0.f;
    if (tok0 < T) {
#pragma unroll
        for (int x = 0; x < 2; ++x) en[x] = *(const v4u*)(RI + (size_t)tok0 * NSEL + 16 * g + 8 * x);
        cqn = *(const v4u*)(CQ + (size_t)tok0 * NSEL + 16 * g); csn = CS[tok0]; }
#pragma unroll 1
    for (int tok = tok0; tok < T; tok += step) {
        int ev[16];
#pragma unroll
        for (int x = 0; x < 2; ++x)
#pragma unroll
            for (int y = 0; y < 4; ++y) { ev[8 * x + 2 * y] = (int)(en[x][y] & 0xffffu); ev[8 * x + 2 * y + 1] = (int)(en[x][y] >> 16); }
        const v4u cq = cqn; const float cs = csn;
        v4u vb[16];
#pragma unroll
        for (int kk = 0; kk < 16; ++kk) vb[kk] = *(const v4u*)(vs + (size_t)ev[kk] * 128);
        const int tn = tok + step;
        if (tn < T) {
#pragma unroll
            for (int x = 0; x < 2; ++x) en[x] = *(const v4u*)(RI + (size_t)tn * NSEL + 16 * g + 8 * x);
            cqn = *(const v4u*)(CQ + (size_t)tn * NSEL + 16 * g); csn = CS[tn]; }
        int acc[16];
#pragma unroll
        for (int i = 0; i < 16; ++i) acc[i] = 0;
#pragma unroll
        for (int blk = 0; blk < 4; ++blk) { const int cw = (int)cq[blk];
#pragma unroll
            for (int j = 0; j < 4; ++j) { const unsigned a = vb[4 * blk][j], b = vb[4 * blk + 1][j], cc = vb[4 * blk + 2][j], d = vb[4 * blk + 3][j];
                const unsigned ablo = __builtin_amdgcn_perm(a, b, 0x01050004u), abhi = __builtin_amdgcn_perm(a, b, 0x03070206u), cdlo = __builtin_amdgcn_perm(cc, d, 0x01050004u), cdhi = __builtin_amdgcn_perm(cc, d, 0x03070206u);
                const unsigned t0 = __builtin_amdgcn_perm(cdlo, ablo, 0x05040100u), t1 = __builtin_amdgcn_perm(cdlo, ablo, 0x07060302u), t2 = __builtin_amdgcn_perm(cdhi, abhi, 0x05040100u), t3 = __builtin_amdgcn_perm(cdhi, abhi, 0x07060302u);
                acc[4 * j] = __builtin_amdgcn_sdot4((int)t0, cw, acc[4 * j], false); acc[4 * j + 1] = __builtin_amdgcn_sdot4((int)t1, cw, acc[4 * j + 1], false);
                acc[4 * j + 2] = __builtin_amdgcn_sdot4((int)t2, cw, acc[4 * j + 2], false); acc[4 * j + 3] = __builtin_amdgcn_sdot4((int)t3, cw, acc[4 * j + 3], false); } }
        int r8[8], r4[4];
#pragma unroll
        for (int i = 0; i < 8; ++i) { const auto r = __builtin_amdgcn_permlane32_swap((unsigned)acc[i], (unsigned)acc[i + 8], false, false); unsigned r0 = r[0], r1 = r[1]; asm volatile("" : "+v"(r0), "+v"(r1)); r8[i] = (int)(r0 + r1); }
#pragma unroll
        for (int i = 0; i < 4; ++i) { const auto r = __builtin_amdgcn_permlane16_swap((unsigned)r8[i], (unsigned)r8[i + 4], false, false); unsigned r0 = r[0], r1 = r[1]; asm volatile("" : "+v"(r0), "+v"(r1)); r4[i] = (int)(r0 + r1); }
        int r2[2];
#pragma unroll
        for (int i = 0; i < 2; ++i) { const int keep = b3 ? r4[i + 2] : r4[i], send = b3 ? r4[i] : r4[i + 2]; r2[i] = keep + __builtin_amdgcn_update_dpp(0, send, DPP_ROR8, 0xf, 0xf, false); }
        *(unsigned*)(FF + (size_t)tok * D + 256 * jj + 4 * (8 * vx + c) + e0) = cvtpk((float)r2[0] * cs, (float)r2[1] * cs);
    }
}
__device__ __forceinline__ int xcd_row(int x, int j) { return j < 2048 ? 2048 * x + j : TP + 64 * x + (j - 2048); }
template <int NT> __device__ __forceinline__ void ln2_tokens(int xq_, int tok, int dt, const bf16* X1, const bf16* FF, const float* g2, const float* b2, float* outf, bf16* outb, int lane) {
    v2u xw[NT][4], fw[NT][4];
#pragma unroll
    for (int t = 0; t < NT; ++t) { const int jx = tok + t * dt, tk = xcd_row(xq_, jx);
#pragma unroll
        for (int j = 0; j < 4; ++j) { xw[t][j] = (v2u){0u, 0u}; fw[t][j] = (v2u){0u, 0u};
            if (jx < 2112) { xw[t][j] = __builtin_nontemporal_load((const v2u*)(X1 + (size_t)tk * D + 256 * j + 4 * lane)); fw[t][j] = __builtin_nontemporal_load((const v2u*)(FF + (size_t)tk * D + 256 * j + 4 * lane)); } } }
    v4f ga[4], ba[4];
#pragma unroll
    for (int j = 0; j < 4; ++j) { ga[j] = *(const v4f*)(g2 + 256 * j + 4 * lane); ba[j] = *(const v4f*)(b2 + 256 * j + 4 * lane); }
#pragma unroll
    for (int t = 0; t < NT; ++t) { const int jx = tok + t * dt, tk = xcd_row(xq_, jx);
        float z[16]; float s = 0.f;
#pragma unroll
        for (int j = 0; j < 4; ++j) { z[4 * j] = ALPHA * bflo(xw[t][j].x) + bflo(fw[t][j].x); z[4 * j + 1] = ALPHA * bfhi(xw[t][j].x) + bfhi(fw[t][j].x); z[4 * j + 2] = ALPHA * bflo(xw[t][j].y) + bflo(fw[t][j].y); z[4 * j + 3] = ALPHA * bfhi(xw[t][j].y) + bfhi(fw[t][j].y);
            s += (z[4 * j] + z[4 * j + 1]) + (z[4 * j + 2] + z[4 * j + 3]); }
        const float mean = wave_sum(s) * (1.f / D); float q = 0.f;
#pragma unroll
        for (int i = 0; i < 16; ++i) { z[i] -= mean; q += z[i] * z[i]; }
        const float rstd = rsqrtf(wave_sum(q) * (1.f / D) + LN_EPS);
        if (jx < 2112) {
#pragma unroll
            for (int j = 0; j < 4; ++j) { const int c0c = 256 * j + 4 * lane; v4f o;
#pragma unroll
                for (int e = 0; e < 4; ++e) o[e] = z[4 * j + e] * rstd * ga[j][e] + ba[j][e];
                if (outf) __builtin_nontemporal_store(o, (v4f*)(outf + (size_t)tk * D + c0c));
                if (outb) { v2u w; w.x = cvtpk(o.x, o.y); w.y = cvtpk(o.z, o.w); *(v2u*)(outb + (size_t)tk * D + c0c) = w; } } }
    }
}

#define QUANT_ITEMS(ly, lo, hi, widx, nw) do { for (int qi = (lo) + (widx); qi < (hi); qi += (nw)) { const int tb = qi >> 12, rr = (ly) * 16384 + 4 * (qi & 4095); \
        quant_rows<4>((tb ? ka->in[17] : ka->in[16]) + (size_t)rr * D, (tb ? VB : UB), rr & 16383, (tb ? SV : SU) + rr, 0, lanel); } } while (0)
__device__ __forceinline__ void xl_barrier(unsigned* xw, unsigned x, unsigned nloc, unsigned round, bool lead) {
    asm volatile("s_waitcnt vmcnt(0)" ::: "memory");
    __syncthreads();
    if (lead) {
        unsigned* sub = xw + 64 * x; unsigned* gen = xw + 1024 + 64 * x;
        const unsigned old = xb_add(sub, 1u), g = round;
        if (old + 1u == (g + 1u) * nloc) xb_add(gen, 1u);
        else { unsigned sp = 0; while (xb_ld(gen) <= g) { __builtin_amdgcn_s_sleep(1); if (++sp > (1u << 22)) break; } }
        __builtin_amdgcn_fence(__ATOMIC_ACQUIRE, "agent");
        asm volatile("s_waitcnt vmcnt(0)" ::: "memory");
    }
    __syncthreads();
}
struct Args { const float* in[20]; float* out; unsigned char* ws; int ph_lo, ph_hi; };
__global__ void __launch_bounds__(NTHR, 2) mk_fwd(Args args) {
    extern __shared__ __attribute__((aligned(16))) unsigned char lds_raw[];
    LAS unsigned char* lds = (LAS unsigned char*)lds_raw;
    volatile LAS unsigned* MISC = (volatile LAS unsigned*)(lds + MISC_OFF);
    const int G = gridDim.x, bx = blockIdx.x, vcu = (G % 8 == 0) ? (bx % 8) * (G / 8) + bx / 8 : bx;
    gu32* ctl = (gu32*)(args.ws + WS_CTL);
    { int t0 = threadIdx.x; asm volatile("" : "+v"(t0)); for (int u = t0; u < (LDS_BYTES - LDSCTL_OFF) / 4; u += NTHR) ((LAS unsigned*)(lds + LDSCTL_OFF))[u] = 0u; }
    __syncthreads();
    const int wid_s = __builtin_amdgcn_readfirstlane(threadIdx.x >> 6);
    XcdBarrier bar; bar.lead = false; bar.bar = (unsigned*)(ctl + CW_BAR); bar.x = 0; bar.st = nullptr;
    if (!MK_PER_PHASE) bar = xcd_barrier_post((unsigned*)(ctl + CW_BAR), MISC + 8);
    const int lo = args.ph_lo, hi = args.ph_hi;
    int cb_ = blockIdx.x;
#define IN(k) (lo <= (k) && (k) < hi)
#define KAS __attribute__((address_space(4)))
#define KTID(var) unsigned mm_##var = ~0u; asm volatile("" : "+s"(mm_##var)); int var = (wid_s << 6) | (int)__builtin_amdgcn_mbcnt_hi(mm_##var, __builtin_amdgcn_mbcnt_lo(mm_##var, 0u))
#define LAUNDER() KTID(tl); asm volatile("" : "+v"(tl)); const KAS Args* ka = (const KAS Args*)__builtin_amdgcn_kernarg_segment_ptr(); asm volatile("" : "+s"(ka)); int bxl = blockIdx.x; asm volatile("" : "+s"(bxl)); (void)bxl; int cbl = cb_; asm volatile("" : "+s"(cbl)); const int xv = cbl & 7, rv = cbl >> 3; (void)xv; (void)rv; \
    const int lanel = tl & 63, wavel = __builtin_amdgcn_readfirstlane(tl >> 6); const int gw = vcu * NWAVES + wavel, NGW = G * NWAVES; const size_t gtid = (size_t)vcu * NTHR + tl, NGT = (size_t)G * NTHR; (void)lanel; (void)wavel; (void)gw; (void)NGW; (void)gtid; (void)NGT; \
    unsigned char* ws = ka->ws; float* out = ka->out; (void)out; \
    float* cosT = (float*)(ws + WS_ROPE); float* sinT = cosT + 2052 * 64; (void)sinT; \
    bf16* WinT = (bf16*)(ws + WS_WIN); bf16* WoutT = (bf16*)(ws + WS_WOUT); bf16* WqT = (bf16*)(ws + WS_WQ); bf16* KEYS = (bf16*)(ws + WS_KEYS); \
    unsigned char* UB = ws + WS_UB; unsigned char* VB = ws + WS_VB; float* SU = (float*)(ws + WS_SU); float* SV = (float*)(ws + WS_SV); (void)SU; (void)SV; bf16* XB = (bf16*)(ws + WS_XB); float* XF = (float*)(ws + WS_XF); \
    bf16* Qb = (bf16*)(ws + WS_Q); bf16* Kb = (bf16*)(ws + WS_K); bf16* Vb = (bf16*)(ws + WS_V); bf16* Gb = (bf16*)(ws + WS_G); bf16* Ub = (bf16*)(ws + WS_U); \
    bf16* KV = (bf16*)(ws + WS_KV); bf16* GT = (bf16*)(ws + WS_GT); (void)GT; unsigned char* XQ = ws + WS_XQ; float* SX = (float*)(ws + WS_SX); float* CC = (float*)(ws + WS_CC); (void)XQ; (void)SX; (void)CC; int* PD = (int*)(ws + WS_PD); bf16* FF = (bf16*)(ws + WS_FF); (void)PD; (void)FF; unsigned char* CQ = ws + WS_CQ; float* CS = (float*)(ws + WS_CS); (void)CQ; (void)CS; bf16* A2 = (bf16*)(ws + WS_A2); float* Z1 = (float*)(ws + WS_Z1); bf16* X1B = (bf16*)(ws + WS_X1B); \
    bf16* QP = (bf16*)(ws + WS_QP); unsigned short* RI = (unsigned short*)(ws + WS_RI); float* RG = (float*)(ws + WS_RG); \
    (void)WinT; (void)WoutT; (void)WqT; (void)KEYS; (void)UB; (void)VB; (void)XB; (void)XF; (void)Qb; (void)Kb; (void)Vb; (void)Gb; (void)Ub; (void)KV; (void)A2; (void)Z1; (void)X1B; (void)QP; (void)RI; (void)RG
#ifndef BARX
#define BARX 1
#endif
#define SEAM(k) do { if (IN(k) && IN((k) + 1)) { KTID(bt_); XcdBarrier bl_ = bar; bl_.lead = (bt_ == 0); asm volatile("" : "+s"(bl_.bar)); for (int bq = 0; bq < BARX; ++bq) xcd_barrier(bl_); } } while (0)
#define SEAM_X(k) do { if (IN(k) && IN((k) + 1)) { if (!xl) { KTID(bt_); XcdBarrier bl_ = bar; bl_.lead = (bt_ == 0); asm volatile("" : "+s"(bl_.bar)); xcd_barrier(bl_); } \
    else { KTID(bt_); unsigned* xw_ = (unsigned*)(ctl + CW_XL); asm volatile("" : "+s"(xw_)); int cq_ = cb_; asm volatile("" : "+s"(cq_)); xl_barrier(xw_, (unsigned)(cq_ & 7), (unsigned)NXW, (unsigned)xl_round, bt_ == 0); ++xl_round; } } } while (0)
    if (IN(0) && EN(0)) {
        LAUNDER(); for (int rep = 0; rep < REP(0); ++rep) {
        LAS float* scr = (LAS float*)(lds + wavel * 16384);
        for (int it = gw; it < 6144; it += NGW) {
            const int l = it / 3072; int r = it % 3072;
            if (r < 1536) { const int kb = r / 96, nb = r % 96; transpose_item(ka->in[4] + (size_t)l * D * INW, D, INW, WinT + (size_t)l * INW * D, kb * 64, nb * 32, inproj_slot(nb * 32), scr, lanel); continue; } r -= 1536;
            if (r < 512) { const int kb = r / 32, nb = r % 32; transpose_item(ka->in[10] + (size_t)l * D * D, D, D, WoutT + (size_t)l * D * D, kb * 64, nb * 32, nb * 32, scr, lanel); continue; } r -= 512;
            { const int kb = r / 64, nb = r % 64; transpose_item(ka->in[13] + (size_t)l * D * 2048, D, 2048, WqT + (size_t)l * 2048 * D, kb * 64, nb * 32, nb * 32, scr, lanel); }
        }
        for (int l = 0; l < NL; ++l) { cvt_flat(ka->in[14] + (size_t)l * 131072, KEYS + (size_t)(l * 2 + 0) * 131072, 131072, gtid, NGT); cvt_flat(ka->in[15] + (size_t)l * 131072, KEYS + (size_t)(l * 2 + 1) * 131072, 131072, gtid, NGT); }
        cvt_flat(ka->in[0], XB, (size_t)TP * D, gtid, NGT);
        cvt_flat(ka->in[1], XB + (size_t)TP * D, (size_t)TS * D, gtid, NGT);
        for (size_t i = gtid; i < 2052 * 64; i += NGT) { const int p = (int)(i >> 6), j = (int)(i & 63); const double pos = (p < 2048) ? (double)p : (double)(16384 + (p - 2048));
            const double ang = pos * INV_FREQ[j]; const double kq = rint(ang * 0.15915494309189535); const double rr = ang - kq * 6.283185307179586;
            const float rf = (float)rr; cosT[i] = __cosf(rf); sinT[i] = __sinf(rf); }
    } }
    SEAM(0);
    const int NXW = G >> 3;
    int xl, xl_round = 0;
    {   KTID(t0_);
        if (t0_ == 0) { unsigned bad = MK_PER_PHASE ? 1u : 0u; const unsigned x = xb_xcc_id(); bad |= (x >= 8u) ? 1u : 0u; unsigned* bw = (unsigned*)(ctl + CW_BAR);
#pragma unroll 1
            for (unsigned j = 0; j < 16; ++j) { const unsigned c = xb_ld(&bw[XB_XCNT(j)]); bad |= (j < 8u) ? (c != (unsigned)NXW ? 1u : 0u) : (c != 0u ? 1u : 0u); }
            const unsigned rk = MISC[10]; bad |= (rk >= (unsigned)NXW) ? 1u : 0u;
#ifdef XL_OFF
            bad = 1u;
#endif
            MISC[16] = bad ? 0u : 1u; MISC[17] = bad ? (unsigned)bx : (x + 8u * rk); }
        __syncthreads();
        xl = __builtin_amdgcn_readfirstlane((int)MISC[16]); cb_ = __builtin_amdgcn_readfirstlane((int)MISC[17]);
        __syncthreads(); }
#pragma unroll 1
    for (int l = 0; l < NL; ++l) {
        const int pb = 1 + PPL * l;
        if (IN(pb) && EN(1)) {
            LAUNDER(); {
            pg8::Gemm g{XB, WinT + (size_t)l * INW * D, TP, INW, D}; OrderM S; S.init(TP, INW, G, cbl, REP(1));
            EpiInProj E{ka->in[5] + l * INW, Qb, Kb, Vb, Gb, Ub, cosT, sinT, out + O_CCP + (size_t)l * 8 * 30 * 512, out + O_CCS + (size_t)l * 128 * 30 * 512};
            pg8::gemm_phase<EpiInProj, OrderM, PG8_ALIGN, PG8_SP2>(lds, g, S, E, tl);
            { const SEpiInProj SE{ka->in[5] + l * INW, Qb, Kb, Vb, Gb, Ub, cosT, sinT, out + O_CCS + (size_t)l * 128 * 30 * 512};
              for (int sr = 0; sr < SGREP; ++sr) for (int u = rv; u < 12; u += NXW) sgemm_unit(lds, XB, WinT + (size_t)l * INW * D, u, TP + 64 * xv, SE, tl);
              if (NXW > 12) { if (rv >= 12) QUANT_ITEMS(l, 0, 2272, ((rv - 12) * 8 + xv) * NWAVES + wavel, (NXW - 12) * 8 * NWAVES); }
              else QUANT_ITEMS(l, 0, 2272, gw, NGW); }
        } }
        SEAM_X(pb);
        if (IN(pb + 1) && EN(2)) {
            LAUNDER(); for (int rep = 0; rep < REP(2); ++rep) {
            for (int u = rv; u < 16; u += NXW) kvgroup_unit(lds, 16 * xv + u, Kb, Vb, KV, GT, tl);
            for (int u = rv; u < 32; u += NXW) sample_pair_unit(lds, 32 * xv + u, l, Qb, Kb, Vb, Gb, ka->in[2], out + O_SRS, A2, tl);
            const bool split = (NXW == 32);
            const int u0 = split ? (rv < 16 ? rv : 32 + (rv - 16)) : rv, ust = split ? 16 : NXW, uend = split ? (rv < 16 ? 32 : 80) : 80;
            for (int u = u0; u < uend; u += ust) {
                if (u < 64) conv_unit<32>(lds, 64 * xv + u, l, Ub, ka->in[3], ka->in[6] + (size_t)l * 31 * 512, ka->in[7] + l * 512, ka->in[8] + l * 512, ka->in[9] + l * 512, A2, tl);
                else conv_unit<4>(lds, 16 * xv + (u - 64), l, Ub, ka->in[3], ka->in[6] + (size_t)l * 31 * 512, ka->in[7] + l * 512, ka->in[8] + l * 512, ka->in[9] + l * 512, A2, tl); }
        } }
        SEAM_X(pb + 1);
        if (IN(pb + 2) && EN(3)) { LAUNDER(); for (int rep = 0; rep < REP(3); ++rep) { for (int u = rv; u < 64; u += NXW) ret_unit(lds, 64 * xv + u, l, Qb, Kb, Vb, Gb, KV, GT, out + O_SRP, A2, tl); } }
        SEAM_X(pb + 2);
        if (IN(pb + 3) && EN(4)) {
            LAUNDER(); {
            pg8::Gemm g{A2, WoutT + (size_t)l * D * D, TP, D, D}; OrderM S; S.init(TP, D, G, cbl, REP(4));
            EpiOutProj E{nullptr, XB, X1B};
            pg8::gemm_phase<EpiOutProj, OrderM, PG8_ALIGN, PG8_SP2>(lds, g, S, E, tl);
            { const SEpiOutProj SE{nullptr, XB, X1B};
              for (int sr = 0; sr < SGREP; ++sr) for (int u = rv; u < 4; u += NXW) sgemm_unit(lds, A2, WoutT + (size_t)l * D * D, u, TP + 64 * xv, SE, tl);
              if (NXW > 4) { if (rv >= 4) QUANT_ITEMS(l, 2272, 5456, ((rv - 4) * 8 + xv) * NWAVES + wavel, (NXW - 4) * 8 * NWAVES); }
              else QUANT_ITEMS(l, 2272, 5456, gw, NGW); }
        } }
        SEAM_X(pb + 3);
        if (IN(pb + 4) && EN(5)) {
            LAUNDER();
            const float* gp = ka->in[11] + l * D; const float* bp = ka->in[12] + l * D;
            constexpr int LR = 3;
            v4f gg[4], bb[4];
#pragma unroll
            for (int j = 0; j < 4; ++j) { gg[j] = *(const v4f*)(gp + lanel * 4 + 256 * j); bb[j] = *(const v4f*)(bp + lanel * 4 + 256 * j); }
            const int xwv = NXW * NWAVES;
            for (int j0 = rv * NWAVES + wavel; j0 < 2112; j0 += LR * xwv) {
                v2u zw[LR][4];
#pragma unroll
                for (int t = 0; t < LR; ++t) { const int row = xcd_row(xv, (j0 + t * xwv < 2112) ? j0 + t * xwv : j0);
#pragma unroll
                    for (int j = 0; j < 4; ++j) zw[t][j] = *(const v2u*)(X1B + (size_t)row * D + lanel * 4 + 256 * j); }
#pragma unroll
                for (int t = 0; t < LR; ++t) { if (j0 + t * xwv < 2112) { const int row = xcd_row(xv, j0 + t * xwv);
                    bf16* zr = X1B + (size_t)row * D + lanel * 4; v4f v[4]; float s = 0.f;
#pragma unroll
                    for (int j = 0; j < 4; ++j) { const v2u w = zw[t][j]; v[j] = (v4f){bflo(w.x), bfhi(w.x), bflo(w.y), bfhi(w.y)}; s += (v[j].x + v[j].y) + (v[j].z + v[j].w); }
                    const float mean = wave_sum(s) * (1.f / D); float q = 0.f;
#pragma unroll
                    for (int j = 0; j < 4; ++j) { v[j] = v[j] - mean; q += (v[j].x * v[j].x + v[j].y * v[j].y) + (v[j].z * v[j].z + v[j].w * v[j].w); }
                    const float rstd = rsqrtf(wave_sum(q) * (1.f / D) + LN_EPS);
#pragma unroll
                    for (int j = 0; j < 4; ++j) { const v4f o = v[j] * rstd * gg[j] + bb[j];
                        v2u w; w.x = cvtpk(o.x, o.y); w.y = cvtpk(o.z, o.w); *(v2u*)(zr + 256 * j) = w; v[j] = o; }
                    float mx = 0.f;
#pragma unroll
                    for (int j = 0; j < 4; ++j) mx = fmaxf(mx, fmaxf(fmaxf(fabsf(v[j].x), fabsf(v[j].y)), fmaxf(fabsf(v[j].z), fabsf(v[j].w))));
                    mx = wave_max(mx); const float xs = mx > 0.f ? 127.f / mx : 0.f;
                    v4u xq;
#pragma unroll
                    for (int j = 0; j < 4; ++j) { unsigned w = 0;
#pragma unroll
                        for (int e = 0; e < 4; ++e) w |= ((unsigned)((int)rintf(v[j][e] * xs)) & 0xffu) << (8 * e);
                        xq[j] = w; }
                    *(v4u*)(XQ + (size_t)row * D + 16 * lanel) = xq; if (lanel == 0) SX[row] = mx * (1.f / 127.f);
                } }
            }
        }
        SEAM_X(pb + 4);
        if (IN(pb + 5) && EN(6)) {
            LAUNDER(); {
            pg8::Gemm g{X1B, WqT + (size_t)l * 2048 * D, TP, 2048, D}; OrderM S; S.init(TP, 2048, G, cbl, REP(6));
            pg8::EpiBf16<0> E{QP, 2048, nullptr, 0, 0, 1.f};
            pg8::gemm_phase<pg8::EpiBf16<0>, OrderM, PG8_ALIGN, PG8_SP2>(lds, g, S, E, tl);
            { const SEpiQ SE{QP};
              for (int sr = 0; sr < SGREP; ++sr) for (int u = rv; u < 8; u += NXW) sgemm_unit(lds, X1B, WqT + (size_t)l * 2048 * D, u, TP + 64 * xv, SE, tl);
              const bool idle = (NXW > 8);
              if (idle) { if (rv >= 8) QUANT_ITEMS(l, 5456, 8192, ((rv - 8) * 8 + xv) * NWAVES + wavel, (NXW - 8) * 8 * NWAVES); }
              else QUANT_ITEMS(l, 5456, 8192, gw, NGW);
              if (l == 0) { const size_t i0 = idle ? (rv >= 8 ? (size_t)((rv - 8) * 8 + xv) * NTHR + tl : (size_t)-1) : gtid, istep = idle ? (size_t)(NXW - 8) * 8 * NTHR : NGT;
                  if (i0 != (size_t)-1) for (size_t i = i0; i < (size_t)NL * 128 * 26 * 128; i += istep) {
                      const size_t c4 = i & 127, rr = (i >> 7) % 26, lb = (i >> 7) / 26;
                      __builtin_nontemporal_store(__builtin_nontemporal_load((const v4f*)(ka->in[3] + (lb * 30 + rr + 4) * 512 + c4 * 4)), (v4f*)(out + O_CCS + (lb * 30 + rr) * 512 + c4 * 4)); } } }
        } }
        if (IN(pb + 5) && IN(pb + 6) && EN(7)) { LAUNDER(); route_stage_keys(lds, rv & 7, l, KEYS, tl); }
        SEAM_X(pb + 5);
        if (IN(pb + 6) && EN(7)) { LAUNDER(); for (int rep = 0; rep < REP(7); ++rep) { { const int head = rv & 7, slot = rv >> 3, nslot = NXW >> 3; if (!IN(pb + 5)) route_stage_keys(lds, head, l, KEYS, tl);
            for (int t = slot; t < 16; t += nslot) route_unit(lds, head, (16 * xv + t) * 128, 128, QP, RI, RG, tl);
            if (slot == 0) route_unit(lds, head, TP + 64 * xv, 64, QP, RI, RG, tl); } } }
        SEAM(pb + 6);
        if (IN(pb + 7) && EN(8)) {
            LAUNDER(); for (int rep = 0; rep < REP(8); ++rep) {
            const SliceMap sm = slice_map((unsigned*)((gu32*)(ws + WS_CTL) + CW_BAR), MISC, G, bxl, tl);
            const unsigned char* ub = UB;
            expert_u_sweep(sm.rank * NWAVES + wavel, sm.cnt * NWAVES, sm.vx, XQ, RI, ub, PD, lanel);
        } }
        SEAM(pb + 7);
        if (IN(pb + 8) && EN(9)) {
            LAUNDER(); for (int rep = 0; rep < REP(9); ++rep) {
            for (int tok = gw; tok < T; tok += 3 * NGW) expert_coefs<3>(tok, NGW, PD, SX, RI, RG, SU + l * 16384, SV + l * 16384, CQ, CS, lanel);
        } }
        SEAM(pb + 8);
        if (IN(pb + 9) && EN(10)) {
            LAUNDER(); for (int rep = 0; rep < REP(10); ++rep) {
            const SliceMap sm = slice_map((unsigned*)((gu32*)(ws + WS_CTL) + CW_BAR), MISC, G, bxl, tl);
            const unsigned char* vb = VB;
            expert_v_sweep(sm.rank * NWAVES + wavel, sm.cnt * NWAVES, sm.vx, RI, CQ, CS, vb, FF, lanel);
        } }
        SEAM(pb + 9);
        if (IN(pb + 10) && EN(11)) {
            LAUNDER(); for (int rep = 0; rep < REP(11); ++rep) {
            float* of = (l == NL - 1) ? out + O_YP : nullptr; bf16* ob = (l == NL - 1) ? nullptr : XB;
            const int xwv = NXW * NWAVES;
            for (int j0 = rv * NWAVES + wavel; j0 < 2112; j0 += 3 * xwv) ln2_tokens<3>(xv, j0, xwv, X1B, FF, ka->in[18] + l * D, ka->in[19] + l * D, of, ob, lanel);
        } }
        if (l + 1 < NL) SEAM_X(pb + 10);
    }
#undef IN
#undef SEAM
#undef SEAM_X
#undef LAUNDER
}

extern "C" void kernel_launch(void* const* d_in, const int* in_sizes, int n_in, void* d_out, int out_size, void* d_ws, size_t ws_size, hipStream_t stream) {
    static int grid = 0;
    if (grid == 0) {
        if (n_in != 20 || out_size != (int)O_END || ws_size < WS_END) { fprintf(stderr, "kernel_launch: unexpected shapes: n_in %d out %d ws %zu\n", n_in, out_size, ws_size); grid = -1; return; }
        int dev = 0, cus = 0, per_cu = 0;
        if (hipGetDevice(&dev) != hipSuccess || hipDeviceGetAttribute(&cus, hipDeviceAttributeMultiprocessorCount, dev) != hipSuccess) { grid = -1; return; }
        if (hipFuncSetAttribute((const void*)mk_fwd, hipFuncAttributeMaxDynamicSharedMemorySize, LDS_BYTES) != hipSuccess) { fprintf(stderr, "kernel_launch: hipFuncSetAttribute failed\n"); grid = -1; return; }
        if (hipOccupancyMaxActiveBlocksPerMultiprocessor(&per_cu, (const void*)mk_fwd, NTHR, LDS_BYTES) != hipSuccess || per_cu < 1) { fprintf(stderr, "kernel_launch: occupancy query says %d blocks per CU\n", per_cu); (void)hipGetLastError(); grid = -1; return; }
        grid = cus - (cus % 64);
        if (grid < 64) { fprintf(stderr, "kernel_launch: needs at least 64 CUs, found %d\n", cus); grid = -1; return; }
    }
    if (grid < 0) return;
    (void)hipMemsetAsync((char*)d_ws + WS_CTL, 0, CTL_ZERO_BYTES, stream);
    Args a{};
    for (int i = 0; i < 20; ++i) a.in[i] = (const float*)d_in[i];
    a.out = (float*)d_out; a.ws = (unsigned char*)d_ws;
#if MK_PER_PHASE
    for (int p = 0; p < N_PHASES; ++p) { a.ph_lo = p; a.ph_hi = p + 1; hipLaunchKernelGGL(mk_fwd, dim3(grid), dim3(NTHR), LDS_BYTES, stream, a); }
#else
    a.ph_lo = 0; a.ph_hi = N_PHASES; hipLaunchKernelGGL(mk_fwd, dim3(grid), dim3(NTHR), LDS_BYTES, stream, a);
#endif
}
```

```cpp
#include <hip/hip_runtime.h>
#include <cstdio>
#include <cstdint>
namespace pg8 {
#define PG8_LAS __attribute__((address_space(3)))
typedef unsigned short bf16_t;
typedef short bf16x8 __attribute__((ext_vector_type(8)));
typedef float f32x4 __attribute__((ext_vector_type(4)));
typedef unsigned u32x4 __attribute__((ext_vector_type(4)));
constexpr int BM = 256, BK = 64, HALF = 128, HTB = HALF * BK * 2  , STAGE_BYTES = 8 * HTB, NXCD = 8, WGM = 8;

__host__ __device__ __forceinline__ int lds_byte(int r, int c) { const int st = (r >> 4) * 2 + (c >> 5), rr = r & 15, cc = c & 31, ob = rr * 64 + cc * 2; return st * 1024 + (ob ^ (((ob >> 9) & 1) << 5)); }
__host__ __device__ __forceinline__ void stage_rc(int b, int& R, int& C) { const int st = b / 1024, sb = b % 1024, swz = sb ^ (((sb >> 9) & 1) << 5); R = (st >> 1) * 16 + swz / 64; C = (st & 1) * 32 + (swz % 64) / 2; }
__host__ __device__ __forceinline__ int perm32(int rho) { const int n = rho >> 4, i = rho & 15; return 8 * (i >> 2) + 4 * n + (i & 3); }

struct Unit { int pm, pn; };
struct Gemm { const bf16_t* A; const bf16_t* Bt; int M, N, K; };

struct StaticOrder {
    int nM, nN, nwg, G, c;
    __host__ __device__ void init(int M, int N, int G_, int c_) { nM = M / BM; nN = N / BM; nwg = nM * nN; G = G_; c = c_; }
    __host__ __device__ bool next(int i, Unit& u) const {
        const long L = (long)i * G + c; if (L >= nwg) return false;
        int wgid = (int)L; { const int q = nwg / NXCD, r = nwg % NXCD, xcd = wgid % NXCD, off = wgid / NXCD; wgid = (xcd < r ? xcd * (q + 1) : r * (q + 1) + (xcd - r) * q) + off; }
        const int nig = WGM * nN, gid = wgid / nig, fm = gid * WGM, gsz = (nM - fm) < WGM ? (nM - fm) : WGM;
        u.pm = fm + ((wgid % nig) % gsz); u.pn = (wgid % nig) / gsz; return true;
    }
    __device__ __forceinline__ void a_ready(const Unit&) const {}
    __device__ __forceinline__ void done(const Unit&) const {}
};

__device__ __forceinline__ unsigned cvt_pk_bf16(float lo, float hi) { unsigned r; asm volatile("v_cvt_pk_bf16_f32 %0, %1, %2" : "=v"(r) : "v"(lo), "v"(hi)); return r; }
typedef float f32x2 __attribute__((ext_vector_type(2)));
__device__ __forceinline__ f32x2 gelu_pk(f32x2 v) {
    const f32x2 av = __builtin_elementwise_abs(v), d = av * 0.2316418882f + 1.0f;
    f32x2 t; t.x = __builtin_amdgcn_rcpf(d.x); t.y = __builtin_amdgcn_rcpf(d.y);
    f32x2 q = t * 0.5307027145f + (-0.7265760135f); q = q * t + 0.7107068705f; q = q * t + (-0.142248368f); q = q * t + 0.127414796f; q = q * t;
    const f32x2 s = (v * v) * (-0.72134752044f);
    f32x2 e; e.x = __builtin_amdgcn_exp2f(s.x); e.y = __builtin_amdgcn_exp2f(s.y);
    const f32x2 m = v * (q * e), r = v - m;
    f32x2 o; o.x = v.x < 0.f ? m.x : r.x; o.y = v.y < 0.f ? m.y : r.y; return o;
}

template <int ACT  > struct EpiBf16 {
    static constexpr bool PERM = true, AFTER_DRAIN = false; static_assert(ACT == 0 || ACT == 1, "EpiBf16: ACT is 0 (none) or 1 (gelu_pk)");
    bf16_t* O; int ldc; const float* bias; int split_cols; size_t split_stride; float scale0;
    __device__ __forceinline__ void operator()(const f32x4 (&acc)[2][2][4][2], const Unit& u, int wr, int wc, int fr, int fq) const {
        const int row0 = u.pm * BM + wr * 64 + fr; int colt = u.pn * BM; bf16_t* base = O;
        float sc = 1.f; if (split_cols) { const int t = colt / split_cols; base += (size_t)t * split_stride; colt -= t * split_cols; if (t == 0) sc = scale0; }
        const int col0 = colt + wc * 32 + 8 * fq, bcol0 = u.pn * BM + wc * 32 + 8 * fq;
        f32x4 bv[2][2];
#pragma unroll
        for (int bj = 0; bj < 2; ++bj)
#pragma unroll
            for (int n = 0; n < 2; ++n) bv[bj][n] = bias ? *(const f32x4*)(bias + bcol0 + bj * HALF + 4 * n) : (f32x4){0.f, 0.f, 0.f, 0.f};
#pragma unroll
        for (int ai = 0; ai < 2; ++ai)
#pragma unroll
            for (int m = 0; m < 4; ++m) { bf16_t* rowp = base + (size_t)(row0 + ai * HALF + m * 16) * ldc + col0;
#pragma unroll
                for (int bj = 0; bj < 2; ++bj) { f32x4 v0 = acc[ai][bj][m][0] + bv[bj][0], v1 = acc[ai][bj][m][1] + bv[bj][1];
                    if (ACT == 1) { f32x2 a = gelu_pk((f32x2){v0[0], v0[1]}), b = gelu_pk((f32x2){v0[2], v0[3]}), c = gelu_pk((f32x2){v1[0], v1[1]}), d = gelu_pk((f32x2){v1[2], v1[3]});
                        v0 = (f32x4){a.x, a.y, b.x, b.y}; v1 = (f32x4){c.x, c.y, d.x, d.y}; }
                    v0 = v0 * sc; v1 = v1 * sc; u32x4 w; w.x = cvt_pk_bf16(v0[0], v0[1]); w.y = cvt_pk_bf16(v0[2], v0[3]); w.z = cvt_pk_bf16(v1[0], v1[1]); w.w = cvt_pk_bf16(v1[2], v1[3]);
                    *(u32x4*)(rowp + bj * HALF) = w; } }
    }
};


template <class Epi, class Sched, bool ALIGN_EPI = false, bool SP2 = false>
__device__ __forceinline__ void gemm_phase(PG8_LAS unsigned char* lds, const Gemm g, const Sched& S, const Epi& E, const int tid) {
    const int wid = __builtin_amdgcn_readfirstlane(tid >> 6), lane = tid & 63, wr = wid >> 2, wc = wid & 3, fr = lane & 15, fq = lane >> 4;
    const int K = g.K, nt = K / BK;
    unsigned voffA[2], voffB[2];
#pragma unroll
    for (int i = 0; i < 2; ++i) { int R, C; stage_rc(tid * 16 + i * 8192, R, C); const int Rb = Epi::PERM ? ((R & ~31) + perm32(R & 31)) : R;
        voffA[i] = (unsigned)(R * K + C) * 2u; voffB[i] = (unsigned)(Rb * K + C) * 2u; }
    const size_t kstep = (size_t)(BK * 2);
    const size_t hstep = (size_t)HALF * K * 2;
    const size_t tstep = 2 * hstep;
    const unsigned ldsw = (unsigned)wid * 1024u;
    const int aoff = lds_byte(wr * 64 + fr, fq * 8), boff = lds_byte(wc * 32 + fr, fq * 8);
#define PG8_SA(b, h) (((b) * 2 + (h)) * HTB)
#define PG8_SB(b, h) ((4 + (b) * 2 + (h)) * HTB)
#define PG8_STAGE(bufoff, gbase, voff) do { _Pragma("unroll") for (int _i = 0; _i < 2; ++_i) \
        __builtin_amdgcn_global_load_lds((const unsigned*)((const char*)(gbase) + (voff)[_i]), (PG8_LAS unsigned*)(lds + (bufoff) + ldsw + _i * 8192), 16, 0, 0); } while (0)
#define PG8_LDA(dst, b, h) do { _Pragma("unroll") for (int m = 0; m < 4; ++m) _Pragma("unroll") for (int k = 0; k < 2; ++k) dst[m][k] = *(const PG8_LAS bf16x8*)(lds + PG8_SA(b, h) + aoff + m * 2048 + k * 1024); } while (0)
#define PG8_LDB(dst, b, h) do { _Pragma("unroll") for (int n = 0; n < 2; ++n) _Pragma("unroll") for (int k = 0; k < 2; ++k) dst[n][k] = *(const PG8_LAS bf16x8*)(lds + PG8_SB(b, h) + boff + n * 2048 + k * 1024); } while (0)
#define PG8_MMA(ai, bj, At, Bt) do { __builtin_amdgcn_s_setprio(1); _Pragma("unroll") for (int m = 0; m < 4; ++m) _Pragma("unroll") for (int n = 0; n < 2; ++n) _Pragma("unroll") for (int k = 0; k < 2; ++k) \
        acc[ai][bj][m][n] = __builtin_amdgcn_mfma_f32_16x16x32_bf16(Bt[n][k], At[m][k], acc[ai][bj][m][n], 0, 0, 0); __builtin_amdgcn_s_setprio(0); } while (0)
#define PG8_WAIT_V(n) asm volatile("s_waitcnt vmcnt(" #n ")" ::: "memory")
#define PG8_WAIT_L(n) asm volatile("s_waitcnt lgkmcnt(" #n ")" ::: "memory")
#define PG8_BAR __builtin_amdgcn_s_barrier()
#define PG8_SCHED __builtin_amdgcn_sched_barrier(0)
    Unit cur, nxt; int ui = 0;
    if (!S.next(0, cur)) return;
    f32x4 acc[2][2][4][2];
#pragma unroll
    for (int a = 0; a < 2; ++a)
#pragma unroll
        for (int b = 0; b < 2; ++b)
#pragma unroll
            for (int m = 0; m < 4; ++m)
#pragma unroll
                for (int n = 0; n < 2; ++n) acc[a][b][m][n] = (f32x4){0.f, 0.f, 0.f, 0.f};
    bf16x8 At[4][2], B0[2][2], B1[2][2];
    const char* cA = (const char*)g.A + (size_t)cur.pm * tstep; const char* cB = (const char*)g.Bt + (size_t)cur.pn * tstep;
    S.a_ready(cur);
    if constexpr (SP2) {
        PG8_STAGE(PG8_SB(0, 0), cB, voffB); PG8_STAGE(PG8_SB(0, 1), cB + hstep, voffB); PG8_STAGE(PG8_SA(0, 0), cA, voffA); PG8_STAGE(PG8_SA(0, 1), cA + hstep, voffA);
        if (wr == 1) PG8_BAR;
        PG8_WAIT_V(2); PG8_BAR;
        PG8_STAGE(PG8_SB(1, 0), cB + kstep, voffB); PG8_STAGE(PG8_SA(1, 0), cA + kstep, voffA); PG8_STAGE(PG8_SB(1, 1), cB + hstep + kstep, voffB);
        PG8_WAIT_V(6); PG8_BAR;
    } else {
        PG8_STAGE(PG8_SB(0, 0), cB, voffB); PG8_STAGE(PG8_SA(0, 0), cA, voffA); PG8_STAGE(PG8_SB(0, 1), cB + hstep, voffB); PG8_STAGE(PG8_SA(0, 1), cA + hstep, voffA);
        if (wr == 1) PG8_BAR;
        PG8_WAIT_V(4); PG8_BAR;
        PG8_STAGE(PG8_SB(1, 0), cB + kstep, voffB); PG8_STAGE(PG8_SA(1, 0), cA + kstep, voffA); PG8_STAGE(PG8_SB(1, 1), cB + hstep + kstep, voffB);
        PG8_WAIT_V(6); PG8_BAR;
    }
    for (;;) {
        const bool has_next = S.next(ui + 1, nxt);
        const char* nA = has_next ? (const char*)g.A + (size_t)nxt.pm * tstep : cA; const char* nB = has_next ? (const char*)g.Bt + (size_t)nxt.pn * tstep : cB;
        for (int t = 0; t < nt; t += 2) {
            const bool last = (t == nt - 2);
            const char* a1 = cA + (size_t)(t + 1) * kstep;
            const char* a2 = last ? nA : cA + (size_t)(t + 2) * kstep; const char* b2 = last ? nB : cB + (size_t)(t + 2) * kstep;
            const char* a3 = a2 + kstep; const char* b3 = b2 + kstep;
            if (last && has_next) S.a_ready(nxt);
            if constexpr (SP2) {
            PG8_LDB(B0, 0, 0); PG8_LDB(B1, 0, 1); PG8_SCHED; PG8_LDA(At, 0, 0); PG8_STAGE(PG8_SA(1, 1), a1 + hstep, voffA);
            PG8_WAIT_V(8); PG8_WAIT_L(0); PG8_BAR; PG8_MMA(0, 0, At, B0); PG8_MMA(0, 1, At, B1); PG8_BAR; PG8_SCHED;
            PG8_LDA(At, 0, 1); PG8_STAGE(PG8_SB(0, 0), b2, voffB); PG8_STAGE(PG8_SB(0, 1), b2 + hstep, voffB); PG8_STAGE(PG8_SA(0, 0), a2, voffA);
            PG8_WAIT_V(8); PG8_WAIT_L(0); PG8_BAR; PG8_MMA(1, 0, At, B0); PG8_MMA(1, 1, At, B1); PG8_BAR; PG8_SCHED;
            PG8_LDB(B0, 1, 0); PG8_LDB(B1, 1, 1); PG8_SCHED; PG8_LDA(At, 1, 0); PG8_STAGE(PG8_SA(0, 1), a2 + hstep, voffA);
            PG8_WAIT_V(8); PG8_WAIT_L(0); PG8_BAR; PG8_MMA(0, 0, At, B0); PG8_MMA(0, 1, At, B1); PG8_BAR; PG8_SCHED;
            PG8_LDA(At, 1, 1); PG8_STAGE(PG8_SB(1, 0), b3, voffB); PG8_STAGE(PG8_SB(1, 1), b3 + hstep, voffB); PG8_STAGE(PG8_SA(1, 0), a3, voffA);
            PG8_WAIT_V(8); PG8_WAIT_L(0); PG8_BAR; PG8_MMA(1, 0, At, B0); PG8_MMA(1, 1, At, B1); PG8_BAR; PG8_SCHED;
            } else {
            PG8_LDB(B0, 0, 0); PG8_SCHED; PG8_LDA(At, 0, 0); PG8_STAGE(PG8_SA(1, 1), a1 + hstep, voffA);
            PG8_WAIT_L(8); PG8_BAR; PG8_WAIT_L(0); PG8_MMA(0, 0, At, B0); PG8_BAR; PG8_SCHED;
            PG8_LDB(B1, 0, 1); PG8_STAGE(PG8_SB(0, 0), b2, voffB);
            PG8_BAR; PG8_WAIT_L(0); PG8_MMA(0, 1, At, B1); PG8_BAR;
            PG8_LDA(At, 0, 1); PG8_STAGE(PG8_SA(0, 0), a2, voffA);
            PG8_BAR; PG8_WAIT_L(0); PG8_MMA(1, 0, At, B0); PG8_BAR; PG8_SCHED;
            PG8_STAGE(PG8_SB(0, 1), b2 + hstep, voffB);
            PG8_WAIT_V(6); PG8_BAR; PG8_MMA(1, 1, At, B1); PG8_BAR;
            PG8_LDB(B0, 1, 0); PG8_SCHED; PG8_LDA(At, 1, 0); PG8_STAGE(PG8_SA(0, 1), a2 + hstep, voffA);
            PG8_WAIT_L(8); PG8_BAR; PG8_WAIT_L(0); PG8_MMA(0, 0, At, B0); PG8_BAR; PG8_SCHED;
            PG8_LDB(B1, 1, 1); PG8_STAGE(PG8_SB(1, 0), b3, voffB);
            PG8_BAR; PG8_WAIT_L(0); PG8_MMA(0, 1, At, B1); PG8_BAR;
            PG8_LDA(At, 1, 1); PG8_STAGE(PG8_SA(1, 0), a3, voffA);
            PG8_BAR; PG8_WAIT_L(0); PG8_MMA(1, 0, At, B0); PG8_BAR; PG8_SCHED;
            PG8_STAGE(PG8_SB(1, 1), b3 + hstep, voffB);
            PG8_WAIT_V(6); PG8_BAR; PG8_MMA(1, 1, At, B1); PG8_BAR;
            }
        }
        if constexpr (ALIGN_EPI) { if (wr == 0) PG8_BAR; }
        if constexpr (!Epi::AFTER_DRAIN) { E(acc, cur, wr, wc, fr, fq); S.done(cur); }
        if (!has_next) break;
#pragma unroll
        for (int a = 0; a < 2; ++a)
#pragma unroll
            for (int b = 0; b < 2; ++b)
#pragma unroll
                for (int m = 0; m < 4; ++m)
#pragma unroll
                    for (int n = 0; n < 2; ++n) acc[a][b][m][n] = (f32x4){0.f, 0.f, 0.f, 0.f};
        cur = nxt; cA = nA; cB = nB; ++ui;
        if constexpr (ALIGN_EPI) { if (wr == 1) PG8_BAR; }
    }
    PG8_WAIT_V(0);
    if constexpr (!ALIGN_EPI) { if (wr == 0) PG8_BAR; }
    PG8_BAR;
    if constexpr (Epi::AFTER_DRAIN) { E.fused(acc, cur, wr, wc, fr, fq, lds, wid, lane); S.done(cur); }
#undef PG8_SA
#undef PG8_SB
#undef PG8_STAGE
#undef PG8_LDA
#undef PG8_LDB
#undef PG8_MMA
#undef PG8_WAIT_V
#undef PG8_WAIT_L
#undef PG8_BAR
#undef PG8_SCHED
}
}
#define GAS __attribute__((address_space(1)))
#define LAS __attribute__((address_space(3)))
typedef unsigned short bf16;
typedef unsigned v4u __attribute__((ext_vector_type(4)));
typedef float f32x4 __attribute__((ext_vector_type(4)));
typedef short bf16x8 __attribute__((ext_vector_type(8)));
typedef GAS unsigned gu32;
typedef GAS unsigned long long gu64;
#define RLX_AGENT __ATOMIC_RELAXED, __HIP_MEMORY_SCOPE_AGENT
#define LDS_WAIT() asm volatile("s_waitcnt lgkmcnt(0)" ::: "memory")
#define VM_WAIT() asm volatile("s_waitcnt vmcnt(0)" ::: "memory")
__device__ __forceinline__ unsigned long long rt() { return __builtin_amdgcn_s_memrealtime(); }
__device__ __forceinline__ unsigned f2bf(float f) { unsigned u = __builtin_bit_cast(unsigned, f); return (u + 0x7fffu + ((u >> 16) & 1u)) >> 16; }
__device__ __forceinline__ unsigned pk2(float lo, float hi) { return f2bf(lo) | (f2bf(hi) << 16); }

#define XB_TMO      128
#define XB_XCNT(j)  (256  + 64 * (j))
#define XB_XSUB(j)  (1280 + 64 * (j))
#define XB_XGEN(j)  (2304 + 64 * (j))
#define XB_TOP      3328
#define XB_TOPGEN   3392
#define XCD_BAR_WORDS 3456
#define XB_SPIN_CAP (1u << 18)

__device__ __forceinline__ unsigned xb_ld(unsigned* p)              { return __hip_atomic_load(p, __ATOMIC_RELAXED, __HIP_MEMORY_SCOPE_AGENT); }
__device__ __forceinline__ unsigned xb_add(unsigned* p, unsigned v) { return __hip_atomic_fetch_add(p, v, __ATOMIC_RELAXED, __HIP_MEMORY_SCOPE_AGENT); }
__device__ __forceinline__ unsigned xb_xcc_id() { return (unsigned)__builtin_amdgcn_s_getreg((3 << 11) | 20) & 0xFu; }
#define XB_SPIN(cond, bar) do { unsigned _sp = 0; while (cond) { __builtin_amdgcn_s_sleep(1); \
    if ((++_sp & 255u) == 0u) { if (xb_ld(&(bar)[XB_TMO])) break; if (_sp > XB_SPIN_CAP) { atomicAdd(&(bar)[XB_TMO], 1u); break; } } } } while (0)

struct XcdBarrier {
    bool lead; unsigned* bar; unsigned x;
    volatile LAS unsigned* st;
};

__device__ __forceinline__ XcdBarrier xcd_barrier_post(unsigned* bar, volatile LAS unsigned* st) {
    XcdBarrier b; b.bar = bar; b.x = xb_xcc_id(); b.st = st;
    if (threadIdx.x == 0) st[2] = xb_add(&bar[XB_XCNT(b.x)], 1u);
    return b;
}
__device__ __forceinline__ void xcd_barrier_complete(unsigned* bar, unsigned x, unsigned& nloc, unsigned& nx) {
    const unsigned G = gridDim.x * gridDim.y * gridDim.z;
    unsigned sum, cnt, mine, sp = 0u;
    for (;;) {
        sum = 0u; cnt = 0u; mine = 0u;
#pragma unroll
        for (unsigned j = 0; j < 16; ++j) { const unsigned c = xb_ld(&bar[XB_XCNT(j)]); sum += c; cnt += (c > 0u) ? 1u : 0u; mine = (j == x) ? c : mine; }
        if (sum == G) break;
        __builtin_amdgcn_s_sleep(1);
        if ((++sp & 255u) == 0u) { if (xb_ld(&bar[XB_TMO])) break; if (sp > XB_SPIN_CAP) { atomicAdd(&bar[XB_TMO], 1u); break; } }
    }
    nloc = mine > 0u ? mine : 1u; nx = cnt > 0u ? cnt : 1u;
}

__device__ __forceinline__ void xcd_barrier(const XcdBarrier& b) {
    asm volatile("s_waitcnt vmcnt(0)" ::: "memory");
    __syncthreads();
    if (b.lead) {
        unsigned* bar = b.bar;
        __builtin_amdgcn_s_waitcnt(0);
        unsigned nloc = b.st[0], nx = b.st[1];
        if (nloc == 0u) { xcd_barrier_complete(bar, b.x, nloc, nx); b.st[0] = nloc; b.st[1] = nx; }
        const unsigned old = xb_add(&bar[XB_XSUB(b.x)], 1u);
        const unsigned gen = old / nloc;
        if (old + 1u == (gen + 1u) * nloc) {
            __builtin_amdgcn_fence(__ATOMIC_RELEASE, "agent");
            asm volatile("s_waitcnt vmcnt(0)" ::: "memory");
            const unsigned og = xb_add(&bar[XB_TOP], 1u);
            const unsigned tg = og / nx;
            if (og + 1u == (tg + 1u) * nx) xb_add(&bar[XB_TOPGEN], 1u);
            else XB_SPIN(xb_ld(&bar[XB_TOPGEN]) == tg, bar);
            __builtin_amdgcn_fence(__ATOMIC_ACQUIRE, "agent");
            xb_add(&bar[XB_XGEN(b.x)], 1u);
            asm volatile("s_waitcnt vmcnt(0)" ::: "memory");
        } else {
            XB_SPIN(xb_ld(&bar[XB_XGEN(b.x)]) == gen, bar);
            __builtin_amdgcn_fence(__ATOMIC_ACQUIRE, "agent");
            asm volatile("s_waitcnt vmcnt(0)" ::: "memory");
        }
    }
    __syncthreads();
}
#ifndef PG8_SP2
#define PG8_SP2 true
#endif
#ifndef PG8_ALIGN
#define PG8_ALIGN true
#endif
#ifndef DIS
#define DIS 0
#endif
#define EN(k) (!((DIS >> (k)) & 1))
#ifndef REPMASK
#define REPMASK 0
#endif
#define REP(k) ((((REPMASK) >> (k)) & 1) ? 2 : 1)
#ifndef SGREP
#define SGREP 1
#endif
#ifndef MK_PER_PHASE
#define MK_PER_PHASE 0
#endif

constexpr int NWAVES = 8, NTHR = 512;
constexpr int D = 1024, TP = 16384, TS = 512, T = TP + TS, NL = 2;
constexpr int INW = 3072, RW = 512, QS = 2048;
constexpr int PHD = 8, NSEL = 128;
constexpr float ALPHA = 1.4142135623730951f, LN_EPS = 1e-5f;
constexpr int PPL = 11, N_PHASES = 1 + PPL * 2;
constexpr size_t O_YP = 0, O_YS = 16777216, O_SRP = 17301504, O_CCP = 18350080, O_SRS = 18595840, O_CCS = 35373056, O_END = 39305216;
constexpr size_t MiB = 1u << 20;
constexpr size_t WS_CTL = 0, CTL_ZERO_BYTES = 1 * MiB;
constexpr size_t WS_ROPE = 1 * MiB;
constexpr size_t WS_WIN = 4 * MiB, WS_WOUT = 16 * MiB, WS_WQ = 20 * MiB, WS_KEYS = 28 * MiB;
constexpr size_t WS_UB = 32 * MiB, WS_VB = 64 * MiB;
constexpr size_t WS_SU = 3 * MiB, WS_SV = 3 * MiB + 131072;
constexpr size_t WS_GT = 96 * MiB, WS_XQ = 328 * MiB  , WS_SX = 3 * MiB + 524288, WS_CC = 363 * MiB;
static_assert(WS_CC + (size_t)16896 * 128 * 4 <= 377 * MiB, "CC inside the dead KV region");
constexpr size_t WS_CQ = 372 * MiB, WS_CS = 3 * MiB + 786432;
constexpr size_t WS_PD = 260 * MiB, WS_FF = 377 * MiB;
constexpr size_t WS_XB = 160 * MiB, WS_XF = 194 * MiB;
constexpr size_t WS_Q = 260 * MiB, WS_K = WS_Q + 1024, WS_V = WS_Q + 2048, WS_G = WS_Q + 3072, WS_U = 328 * MiB;
constexpr size_t WS_KV = 345 * MiB, WS_A2 = 377 * MiB, WS_Z1 = 411 * MiB, WS_X1B = 160 * MiB  , WS_END = 511 * MiB;
constexpr size_t WS_QP = WS_Q;
constexpr size_t WS_RI = 411 * MiB, WS_RG = 416 * MiB;
constexpr int CW_BAR = 4096;
constexpr int CW_XL = 49152;
constexpr int RING_BYTES = 131072, LDSCTL_OFF = 139264, MISC_OFF = LDSCTL_OFF + 320, LDS_BYTES = 147456;
constexpr int R1_LO = 2;
constexpr int PST = 272;

typedef float v4f __attribute__((ext_vector_type(4)));
typedef unsigned v2u __attribute__((ext_vector_type(2)));
typedef unsigned u32x4v __attribute__((ext_vector_type(4)));
typedef float f32x16 __attribute__((ext_vector_type(16)));

__device__ __forceinline__ float bflo(unsigned w) { return __uint_as_float(w << 16); }
__device__ __forceinline__ float bfhi(unsigned w) { return __uint_as_float(w & 0xffff0000u); }
__device__ __forceinline__ float bf2f(bf16 b) { return __uint_as_float((unsigned)b << 16); }
#define WAVE_REDUCE(OP) \
    v = OP(v, __builtin_bit_cast(float, __builtin_amdgcn_update_dpp(0, __builtin_bit_cast(int, v), 0xB1, 0xf, 0xf, false))); \
    v = OP(v, __builtin_bit_cast(float, __builtin_amdgcn_update_dpp(0, __builtin_bit_cast(int, v), 0x4E, 0xf, 0xf, false))); \
    v = OP(v, __builtin_bit_cast(float, __builtin_amdgcn_update_dpp(0, __builtin_bit_cast(int, v), 0x141, 0xf, 0xf, false))); \
    v = OP(v, __builtin_bit_cast(float, __builtin_amdgcn_update_dpp(0, __builtin_bit_cast(int, v), 0x128, 0xf, 0xf, false))); \
    { const unsigned a = __builtin_bit_cast(unsigned, v); const auto r = __builtin_amdgcn_permlane16_swap(a, a, false, false); unsigned r0 = r[0], r1 = r[1]; asm volatile("" : "+v"(r0), "+v"(r1)); v = OP(__builtin_bit_cast(float, r0), __builtin_bit_cast(float, r1)); } \
    { const unsigned a = __builtin_bit_cast(unsigned, v); const auto r = __builtin_amdgcn_permlane32_swap(a, a, false, false); unsigned r0 = r[0], r1 = r[1]; asm volatile("" : "+v"(r0), "+v"(r1)); v = OP(__builtin_bit_cast(float, r0), __builtin_bit_cast(float, r1)); }
__device__ __forceinline__ float wr_add(float a, float b) { return a + b; }
__device__ __forceinline__ float wave_sum(float v) { WAVE_REDUCE(wr_add) return v; }
__device__ __forceinline__ float wave_max(float v) { WAVE_REDUCE(fmaxf) return v; }
#undef WAVE_REDUCE
__device__ __forceinline__ float silu_f(float x) { return x / (1.f + __expf(-x)); }
__device__ __forceinline__ float l2gamma(int h) { return h == 0 ? -0.04580368961312479f : h == 1 ? -0.02272007650008353f : h == 2 ? -0.011315313227834146f : -0.005646563141142063f; }
__device__ __forceinline__ void unpack8(const v4u w, float (&f)[8]) {
    f[0] = bflo(w.x); f[1] = bfhi(w.x); f[2] = bflo(w.y); f[3] = bfhi(w.y); f[4] = bflo(w.z); f[5] = bfhi(w.z); f[6] = bflo(w.w); f[7] = bfhi(w.w);
}
typedef float f32x2_t __attribute__((ext_vector_type(2))); typedef __bf16 bf16x2_t __attribute__((ext_vector_type(2)));
__device__ __forceinline__ unsigned cvtpk(float lo, float hi) { f32x2_t v = {lo, hi}; bf16x2_t b = __builtin_convertvector(v, bf16x2_t); return __builtin_bit_cast(unsigned, b); }
__device__ __forceinline__ v4u pack8(const float (&f)[8]) { v4u w; w.x = pk2(f[0], f[1]); w.y = pk2(f[2], f[3]); w.z = pk2(f[4], f[5]); w.w = pk2(f[6], f[7]); return w; }

__device__ const double INV_FREQ[64] = {
1.0, 0.8659643233600653, 0.7498942093324559, 0.6493816315762113, 0.5623413251903491, 0.4869675251658631, 0.4216965034285822, 0.3651741272548377, 0.31622776601683794, 0.27384196342643613, 0.23713737056616552, 0.2053525026457146, 0.1778279410038923, 0.1539926526059492, 0.1333521432163324, 0.11547819846894582, 0.1, 0.08659643233600653, 0.07498942093324558, 0.06493816315762113, 0.05623413251903491, 0.04869675251658631, 0.042169650342858224, 0.03651741272548377, 0.03162277660168379, 0.027384196342643614, 0.023713737056616554, 0.02053525026457146, 0.01778279410038923, 0.01539926526059492, 0.01333521432163324, 0.011547819846894581, 0.01, 0.008659643233600654, 0.007498942093324558, 0.006493816315762113, 0.005623413251903491, 0.004869675251658631, 0.004216965034285823, 0.003651741272548377, 0.0031622776601683794, 0.0027384196342643613, 0.0023713737056616554, 0.002053525026457146, 0.0017782794100389228, 0.001539926526059492, 0.001333521432163324, 0.0011547819846894581, 0.001, 0.0008659643233600654, 0.0007498942093324559, 0.0006493816315762113, 0.0005623413251903491, 0.0004869675251658631, 0.00042169650342858224, 0.0003651741272548377, 0.00031622776601683794, 0.0002738419634264361, 0.00023713737056616554, 0.0002053525026457146, 0.00017782794100389227, 0.0001539926526059492, 0.0001333521432163324, 0.00011547819846894582};

__device__ __forceinline__ int inproj_slot(int c) {
    if (c < 1024) { const int reg = c >> 9, cc = c & 511, head = cc >> 7, half = (cc >> 6) & 1, dd = cc & 63; return reg * 512 + (head >> 1) * 256 + half * 128 + (head & 1) * 64 + dd; }
    if (c < 2048) return c;
    const int cg = (c >= 2560) ? 1 : 0, ch = (c - 2048) & 511;
    return 2048 + (ch >> 7) * 256 + cg * 128 + (ch & 127);
}
__device__ __forceinline__ void transpose_item(const float* W, int K, int N, bf16* WT, int k0, int n0s, int n0d, LAS float* scr, int lane) {
    float wv[32];
#pragma unroll
    for (int i = 0; i < 32; ++i) wv[i] = __builtin_nontemporal_load(W + (size_t)(k0 + 2 * i + (lane >> 5)) * N + n0s + (lane & 31));
#pragma unroll
    for (int i = 0; i < 32; ++i) scr[(2 * i + (lane >> 5)) * 33 + (lane & 31)] = wv[i];
    LDS_WAIT(); asm volatile("" ::: "memory");
    const int c = lane & 7;
#pragma unroll
    for (int j = 0; j < 4; ++j) { const int n = (lane >> 3) + 8 * j; const LAS float* s = scr + (8 * c) * 33 + n;
        v4u o; o.x = pk2(s[0 * 33], s[1 * 33]); o.y = pk2(s[2 * 33], s[3 * 33]); o.z = pk2(s[4 * 33], s[5 * 33]); o.w = pk2(s[6 * 33], s[7 * 33]);
        *(GAS v4u*)(WT + (size_t)(n0d + n) * K + k0 + 8 * c) = o; }
    LDS_WAIT(); asm volatile("" ::: "memory");
}
__device__ __forceinline__ void cvt_flat(const float* src, bf16* dst, size_t n, size_t gtid, size_t nthr) {
    for (size_t i = gtid * 8; i < n; i += nthr * 8) {
        const v4f a = __builtin_nontemporal_load((const v4f*)(src + i)), b = __builtin_nontemporal_load((const v4f*)(src + i + 4));
        v4u o; o.x = pk2(a.x, a.y); o.y = pk2(a.z, a.w); o.z = pk2(b.x, b.y); o.w = pk2(b.z, b.w);
        *(v4u*)(dst + i) = o;
    }
}

struct EpiInProj {
    static constexpr bool PERM = true, AFTER_DRAIN = false;
    const float* bias; bf16 *Q, *K, *V, *G, *U; const float *cosT, *sinT; float *ccp, *ccs;
    __device__ __forceinline__ void operator()(const pg8::f32x4 (&acc)[2][2][4][2], const pg8::Unit& u, int wr, int wc, int fr, int fq) const {
        const int s0 = wc * 32 + 8 * fq, pn = u.pn;
        const int rowb = u.pm * 256 + wr * 64 + fr;
        if (pn < 4) {
            const int reg = pn >> 1, head = 2 * (pn & 1) + (s0 >> 6), dd0 = s0 & 63;
            const int c0 = reg * 512 + head * 128 + dd0;
            float b0[8], b1[8];
            { const v4f x0 = *(const v4f*)(bias + c0), x1 = *(const v4f*)(bias + c0 + 4), y0 = *(const v4f*)(bias + c0 + 64), y1 = *(const v4f*)(bias + c0 + 68);
#pragma unroll
              for (int i = 0; i < 4; ++i) { b0[i] = x0[i]; b0[4 + i] = x1[i]; b1[i] = y0[i]; b1[4 + i] = y1[i]; } }
            bf16* dst = reg ? K : Q; const float sc = reg ? 0.08838834764831845f : 1.f;
#pragma unroll
            for (int ai = 0; ai < 2; ++ai)
#pragma unroll
                for (int m = 0; m < 4; ++m) {
                    const int row = rowb + ai * 128 + m * 16;
                    const int pidx = row < TP ? (row & 2047) : 2048 + ((row - TP) & 3);
                    const v4f c0v = *(const v4f*)(cosT + pidx * 64 + dd0), c1v = *(const v4f*)(cosT + pidx * 64 + dd0 + 4);
                    const v4f s0v = *(const v4f*)(sinT + pidx * 64 + dd0), s1v = *(const v4f*)(sinT + pidx * 64 + dd0 + 4);
                    float o1[8], o2[8];
#pragma unroll
                    for (int i = 0; i < 8; ++i) {
                        const float t1 = acc[ai][0][m][i >> 2][i & 3] + b0[i], t2 = acc[ai][1][m][i >> 2][i & 3] + b1[i];
                        const float cc = (i < 4) ? c0v[i & 3] : c1v[i & 3], ss = (i < 4) ? s0v[i & 3] : s1v[i & 3];
                        o1[i] = (t1 * cc - t2 * ss) * sc; o2[i] = (t1 * ss + t2 * cc) * sc;
                    }
                    bf16* p = dst + (size_t)row * QS + head * 128 + dd0;
                    *(v4u*)p = pack8(o1); *(v4u*)(p + 64) = pack8(o2);
                }
        } else if (pn < 8) {
            const bool isg = pn >= 6; bf16* dst = isg ? G : V;
#pragma unroll
            for (int bj = 0; bj < 2; ++bj) {
                const int c0 = 256 * pn + 128 * bj + s0, dcol = c0 - (isg ? 1536 : 1024);
                const v4f x0 = *(const v4f*)(bias + c0), x1 = *(const v4f*)(bias + c0 + 4);
#pragma unroll
                for (int ai = 0; ai < 2; ++ai)
#pragma unroll
                    for (int m = 0; m < 4; ++m) {
                        const int row = rowb + ai * 128 + m * 16;
                        float o[8];
#pragma unroll
                        for (int i = 0; i < 8; ++i) { float v = acc[ai][bj][m][i >> 2][i & 3] + ((i < 4) ? x0[i & 3] : x1[i & 3]); o[i] = isg ? silu_f(v) : v; }
                        *(v4u*)(dst + (size_t)row * QS + dcol) = pack8(o);
                    }
            }
        } else {
            const int ch0 = 128 * (pn - 8) + s0;
            const v4f a0 = *(const v4f*)(bias + 2048 + ch0), a1 = *(const v4f*)(bias + 2048 + ch0 + 4), g0 = *(const v4f*)(bias + 2560 + ch0), g1 = *(const v4f*)(bias + 2560 + ch0 + 4);
#pragma unroll
            for (int ai = 0; ai < 2; ++ai)
#pragma unroll
                for (int m = 0; m < 4; ++m) {
                    const int row = rowb + ai * 128 + m * 16;
                    float o[8];
#pragma unroll
                    for (int i = 0; i < 8; ++i) {
                        const float a = acc[ai][0][m][i >> 2][i & 3] + ((i < 4) ? a0[i & 3] : a1[i & 3]), g = acc[ai][1][m][i >> 2][i & 3] + ((i < 4) ? g0[i & 3] : g1[i & 3]);
                        o[i] = a / (1.f + __expf(-g));
                    }
                    *(v4u*)(U + (size_t)row * RW + ch0) = pack8(o);
                    float* cp = nullptr;
                    if (row < TP) { const int t = row & 2047; if (t >= 2018) cp = ccp + ((size_t)(row >> 11) * 30 + (t - 2018)) * 512 + ch0; }
                    else { const int rs = row - TP; cp = ccs + ((size_t)(rs >> 2) * 30 + 26 + (rs & 3)) * 512 + ch0; }
                    if (cp) { *(v4f*)cp = (v4f){o[0], o[1], o[2], o[3]}; *(v4f*)(cp + 4) = (v4f){o[4], o[5], o[6], o[7]}; }
                }
        }
    }
};
struct EpiOutProj {
    static constexpr bool PERM = true, AFTER_DRAIN = false;
    const float* res_f; const bf16* res_b; bf16* Z;
    __device__ __forceinline__ void operator()(const pg8::f32x4 (&acc)[2][2][4][2], const pg8::Unit& u, int wr, int wc, int fr, int fq) const {
        const int col0 = u.pn * 256 + wc * 32 + 8 * fq;
#pragma unroll
        for (int ai = 0; ai < 2; ++ai)
#pragma unroll
            for (int m = 0; m < 4; ++m) {
                const size_t ro = (size_t)(u.pm * 256 + ai * 128 + wr * 64 + m * 16 + fr) * D;
#pragma unroll
                for (int bj = 0; bj < 2; ++bj) { const size_t o = ro + col0 + bj * 128; float r8[8];
                    if (res_f) { const v4f a = *(const v4f*)(res_f + o), b = *(const v4f*)(res_f + o + 4); r8[0] = a.x; r8[1] = a.y; r8[2] = a.z; r8[3] = a.w; r8[4] = b.x; r8[5] = b.y; r8[6] = b.z; r8[7] = b.w; }
                    else unpack8(*(const v4u*)(res_b + o), r8);
                    v4u w; w.x = cvtpk(ALPHA * r8[0] + acc[ai][bj][m][0][0], ALPHA * r8[1] + acc[ai][bj][m][0][1]); w.y = cvtpk(ALPHA * r8[2] + acc[ai][bj][m][0][2], ALPHA * r8[3] + acc[ai][bj][m][0][3]);
                    w.z = cvtpk(ALPHA * r8[4] + acc[ai][bj][m][1][0], ALPHA * r8[5] + acc[ai][bj][m][1][1]); w.w = cvtpk(ALPHA * r8[6] + acc[ai][bj][m][1][2], ALPHA * r8[7] + acc[ai][bj][m][1][3]);
                    *(v4u*)(Z + o) = w; }
            }
    }
};
__device__ __forceinline__ unsigned sg_off(int row, int ch) { return (unsigned)(row * 128 + ((ch ^ ((row >> 1) & 7)) << 4)); }
template <class EpiS> __device__ __forceinline__ void sgemm_unit(LAS unsigned char* lds, const bf16* A, const bf16* Bt, int pn, int row0, const EpiS& E, int tid) {
    const int lane = tid & 63, wave = __builtin_amdgcn_readfirstlane(tid >> 6), r = lane & 31, hl = lane >> 5, mt = wave >> 2, nq = wave & 3;
    const int srow = tid >> 3, sch = tid & 7;
    const unsigned char* ag = (const unsigned char*)(A + (size_t)(row0 + srow) * D) + sch * 16;
    const unsigned char* bg = (const unsigned char*)(Bt + (size_t)(pn * 256 + srow) * D) + sch * 16;
    v4u ra0, ra1, ra2, ra3, rb0[4], rb1[4], rb2[4], rb3[4];
#define SG_LOAD(RA, RB, kc) do { RA = *(const v4u*)(ag + (kc) * 128); _Pragma("unroll") for (int q = 0; q < 4; ++q) RB[q] = *(const v4u*)(bg + (size_t)q * 64 * D * 2 + (kc) * 128); } while (0)
    SG_LOAD(ra0, rb0, 0); SG_LOAD(ra1, rb1, 1); SG_LOAD(ra2, rb2, 2); SG_LOAD(ra3, rb3, 3);
    f32x16 acc0, acc1;
#pragma unroll
    for (int i = 0; i < 16; ++i) { acc0[i] = 0.f; acc1[i] = 0.f; }
#define SG_STAGE(RA, RB, kc) do { LAS unsigned char* buf = lds + ((kc) & 1) * 40960; \
        *(LAS v4u*)(buf + sg_off(srow, sch)) = RA; _Pragma("unroll") for (int q = 0; q < 4; ++q) *(LAS v4u*)(buf + 8192 + sg_off(64 * q + srow, sch)) = RB[q]; \
        if ((kc) + 4 < 16) SG_LOAD(RA, RB, (kc) + 4); \
        __syncthreads(); \
        bf16x8 fa[4], fx0[4], fx1[4];                   \
        _Pragma("unroll") for (int ks = 0; ks < 4; ++ks) { fa[ks] = *(const LAS bf16x8*)(buf + sg_off(32 * mt + r, 2 * ks + hl)); \
            fx0[ks] = *(const LAS bf16x8*)(buf + 8192 + sg_off(32 * nq + r, 2 * ks + hl)); fx1[ks] = *(const LAS bf16x8*)(buf + 8192 + sg_off(128 + 32 * nq + r, 2 * ks + hl)); } \
        __builtin_amdgcn_sched_barrier(0); \
        _Pragma("unroll") for (int ks = 0; ks < 4; ++ks) { acc0 = __builtin_amdgcn_mfma_f32_32x32x16_bf16(fa[ks], fx0[ks], acc0, 0, 0, 0); acc1 = __builtin_amdgcn_mfma_f32_32x32x16_bf16(fa[ks], fx1[ks], acc1, 0, 0, 0); } } while (0)
    SG_STAGE(ra0, rb0, 0); SG_STAGE(ra1, rb1, 1); SG_STAGE(ra2, rb2, 2); SG_STAGE(ra3, rb3, 3); SG_STAGE(ra0, rb0, 4); SG_STAGE(ra1, rb1, 5); SG_STAGE(ra2, rb2, 6); SG_STAGE(ra3, rb3, 7);
    SG_STAGE(ra0, rb0, 8); SG_STAGE(ra1, rb1, 9); SG_STAGE(ra2, rb2, 10); SG_STAGE(ra3, rb3, 11); SG_STAGE(ra0, rb0, 12); SG_STAGE(ra1, rb1, 13); SG_STAGE(ra2, rb2, 14); SG_STAGE(ra3, rb3, 15);
#undef SG_STAGE
#undef SG_LOAD
#pragma unroll
    for (int i = 0; i < 16; ++i) E(row0 + 32 * mt + (i & 3) + 8 * (i >> 2) + 4 * hl, pn, 32 * nq + r, acc0[i], acc1[i]);
    __syncthreads();
}
struct SEpiInProj {
    const float* bias; bf16 *Q, *K, *V, *G, *U; const float *cosT, *sinT; float* ccs;
    __device__ __forceinline__ void operator()(int row, int pn, int s, float v0, float v1) const {
        if (pn < 4) { const int reg = pn >> 1, head = 2 * (pn & 1) + (s >> 6), dd = s & 63, c0 = reg * 512 + head * 128 + dd, pidx = 2048 + ((row - TP) & 3);
            const float t1 = v0 + bias[c0], t2 = v1 + bias[c0 + 64], cc = cosT[pidx * 64 + dd], ss = sinT[pidx * 64 + dd], sc = reg ? 0.08838834764831845f : 1.f;
            bf16* p = (reg ? K : Q) + (size_t)row * QS + head * 128 + dd; p[0] = (bf16)(cvtpk((t1 * cc - t2 * ss) * sc, 0.f) & 0xffffu); p[64] = (bf16)(cvtpk((t1 * ss + t2 * cc) * sc, 0.f) & 0xffffu);
        } else if (pn < 8) { const bool isg = pn >= 6; bf16* dst = (isg ? G : V) + (size_t)row * QS + (256 * pn - (isg ? 1536 : 1024)) + s;
            const float a = v0 + bias[256 * pn + s], b = v1 + bias[256 * pn + 128 + s];
            dst[0] = (bf16)(cvtpk(isg ? silu_f(a) : a, 0.f) & 0xffffu); dst[128] = (bf16)(cvtpk(isg ? silu_f(b) : b, 0.f) & 0xffffu);
        } else { const int ch = 128 * (pn - 8) + s; const float a = v0 + bias[2048 + ch], g = v1 + bias[2560 + ch], u = a / (1.f + __expf(-g));
            U[(size_t)row * RW + ch] = (bf16)(cvtpk(u, 0.f) & 0xffffu); const int rs = row - TP; ccs[((size_t)(rs >> 2) * 30 + 26 + (rs & 3)) * 512 + ch] = u; }
    }
};
struct SEpiOutProj { const float* res_f; const bf16* res_b; bf16* Z;
    __device__ __forceinline__ void operator()(int row, int pn, int s, float v0, float v1) const { const size_t o = (size_t)row * D + pn * 256 + s;
        const float r0 = res_f ? res_f[o] : bf2f(res_b[o]), r1 = res_f ? res_f[o + 128] : bf2f(res_b[o + 128]);
        Z[o] = (bf16)(cvtpk(ALPHA * r0 + v0, 0.f) & 0xffffu); Z[o + 128] = (bf16)(cvtpk(ALPHA * r1 + v1, 0.f) & 0xffffu); } };
struct SEpiQ { bf16* QP;
    __device__ __forceinline__ void operator()(int row, int pn, int s, float v0, float v1) const { bf16* p = QP + (size_t)row * 2048 + pn * 256 + s; p[0] = (bf16)(cvtpk(v0, 0.f) & 0xffffu); p[128] = (bf16)(cvtpk(v1, 0.f) & 0xffffu); } };

struct OrderM {
    int nM, nN, nwg, G, c, mult;
    __device__ void init(int M, int N, int G_, int c_, int mult_) { nM = M / pg8::BM; nN = N / pg8::BM; nwg = nM * nN; G = G_; c = c_; mult = mult_; }
    __device__ bool next(int i, pg8::Unit& u) const {
        const long L = (long)i * G + c; if (L >= (long)nwg * mult) return false;
        int wgid = (int)(L % nwg); { const int q = nwg / pg8::NXCD, r = nwg % pg8::NXCD, xcd = wgid % pg8::NXCD, off = wgid / pg8::NXCD; wgid = (xcd < r ? xcd * (q + 1) : r * (q + 1) + (xcd - r) * q) + off; }
        const int nig = pg8::WGM * nN, gid = wgid / nig, fm = gid * pg8::WGM, gsz = (nM - fm) < pg8::WGM ? (nM - fm) : pg8::WGM;
        u.pm = fm + ((wgid % nig) % gsz); u.pn = (wgid % nig) / gsz; return true;
    }
    __device__ __forceinline__ void a_ready(const pg8::Unit&) const {}
    __device__ __forceinline__ void done(const pg8::Unit&) const {}
};
__device__ __forceinline__ void load_tile128(LAS unsigned char* dst, int stride, const bf16* src, size_t row0, int coff, int tid) {
#pragma unroll
    for (int i = 0; i < 4; ++i) { const int idx = tid + 512 * i, j = idx >> 4, c16 = idx & 15;
        *(LAS v4u*)(dst + j * stride + c16 * 16) = *(const v4u*)(src + (row0 + j) * RW + coff + c16 * 8); }
}
typedef short s16x4 __attribute__((ext_vector_type(4)));
typedef short v4i16_t __attribute__((ext_vector_type(4)));
__device__ __forceinline__ unsigned offb(unsigned row, unsigned ch) { return 256u * row + 16u * (ch ^ (((row & 3u) << 2) | ((row >> 2) & 3u))); }
__device__ __forceinline__ s16x4 trrd(LAS unsigned char* p) { return __builtin_bit_cast(s16x4, __builtin_amdgcn_ds_read_tr16_b64_v4i16((LAS v4i16_t*)p)); }
__device__ __forceinline__ bf16x8 tr_frag(LAS unsigned char* img, int rowlo, int rowhi, int c, int lane) {
    const unsigned blk = (lane >> 4) & 1, q = (lane & 15) >> 2, p = lane & 3, ch = 4 * c + 2 * blk + (p >> 1), o8 = 8 * (p & 1);
    const s16x4 lo = trrd(img + offb(rowlo + q, ch) + o8), hi = trrd(img + offb(rowhi + q, ch) + o8);
    return __builtin_shufflevector(lo, hi, 0, 1, 2, 3, 4, 5, 6, 7);
}
__device__ __forceinline__ bf16x8 row_frag(LAS unsigned char* img, int row0, int ks, int lane) { return *(const LAS bf16x8*)(img + offb(row0 + (lane & 31), 2 * ks + (lane >> 5))); }
__device__ __forceinline__ int crow16(int i, int hl) { return (i & 3) + 8 * (i >> 2) + 4 * hl; }
__device__ __forceinline__ void stage_tile(LAS unsigned char* img, const bf16* src, size_t row0, int coff, float rsc0, float rsc1, bool scaled, int tid, int stride = RW) {
#pragma unroll
    for (int i = 0; i < 4; ++i) { const int idx = tid + 512 * i, j = idx >> 4, ch = idx & 15;
        v4u w = *(const v4u*)(src + (row0 + j) * stride + coff + ch * 8);
        if (scaled) { const float sc = exp2f(rsc0 + (float)j * rsc1); float f[8]; unpack8(w, f);
            w.x = cvtpk(f[0] * sc, f[1] * sc); w.y = cvtpk(f[2] * sc, f[3] * sc); w.z = cvtpk(f[4] * sc, f[5] * sc); w.w = cvtpk(f[6] * sc, f[7] * sc); }
        *(LAS v4u*)(img + offb(j, ch)) = w; }
}
__device__ __forceinline__ void tile_load(v4u (&w)[4], const bf16* src, size_t row0, int coff, int tid, int stride = RW) {
#pragma unroll
    for (int i = 0; i < 4; ++i) { const int idx = tid + 512 * i, j = idx >> 4, ch = idx & 15; w[i] = *(const v4u*)(src + (row0 + j) * stride + coff + ch * 8); }
}
__device__ __forceinline__ void tile_store(LAS unsigned char* img, const v4u (&win)[4], float rsc0, float rsc1, bool scaled, int tid) {
#pragma unroll
    for (int i = 0; i < 4; ++i) { const int idx = tid + 512 * i, j = idx >> 4, ch = idx & 15; v4u w = win[i];
        if (scaled) { const float sc = exp2f(rsc0 + (float)j * rsc1); float f[8]; unpack8(w, f);
            w.x = cvtpk(f[0] * sc, f[1] * sc); w.y = cvtpk(f[2] * sc, f[3] * sc); w.z = cvtpk(f[4] * sc, f[5] * sc); w.w = cvtpk(f[6] * sc, f[7] * sc); }
        *(LAS v4u*)(img + offb(j, ch)) = w; }
}
__device__ __forceinline__ void st_state_bf16(bf16* dst, const f32x16 (&run)[2], int mt, int ntb, int r, int hl) {
    const bool odd = (r & 1) != 0;
#pragma unroll
    for (int t = 0; t < 2; ++t)
#pragma unroll
        for (int i = 0; i < 16; i += 2) {
            const float a0 = run[t][i], a1 = run[t][i + 1];
            const float b0 = __builtin_bit_cast(float, __builtin_amdgcn_update_dpp(0, __builtin_bit_cast(int, a0), 0xB1, 0xf, 0xf, false));
            const float b1 = __builtin_bit_cast(float, __builtin_amdgcn_update_dpp(0, __builtin_bit_cast(int, a1), 0xB1, 0xf, 0xf, false));
            const unsigned w = odd ? cvtpk(b1, a1) : cvtpk(a0, b0);
            const int row = 32 * mt + (odd ? crow16(i + 1, hl) : crow16(i, hl));
            *(unsigned*)(dst + row * 128 + 32 * (ntb + t) + (r & 30)) = w; }
}
__device__ __forceinline__ void kvgroup_unit(LAS unsigned char* lds, int gu, const bf16* Kb, const bf16* Vb, bf16* LP, bf16* GT, int tid) {
    const int h = gu & 3, g = (gu >> 2) & 3, b = gu >> 4, lane = tid & 63, wave = __builtin_amdgcn_readfirstlane(tid >> 6), r = lane & 31, hl = lane >> 5;
    const int mt = wave >> 1, ntb = (wave & 1) * 2; const float lg2 = l2gamma(h), cd = exp2f(128.f * lg2);
    LAS unsigned char* Ks = lds; LAS unsigned char* Vs = lds + 32768;
    f32x16 run[2];
#pragma unroll
    for (int t = 0; t < 2; ++t)
#pragma unroll
        for (int i = 0; i < 16; ++i) run[t][i] = 0.f;
    v4u kw[4], vw[4];
    tile_load(kw, Kb, (size_t)(b * 16 + 4 * g) * 128, h * 128, tid, QS); tile_load(vw, Vb, (size_t)(b * 16 + 4 * g) * 128, h * 128, tid, QS);
#pragma unroll 1
    for (int rr = 0; rr < 4; ++rr) {
        const int n = 4 * g + rr;
        tile_store(Ks, kw, 127.f * lg2, -lg2, true, tid); tile_store(Vs, vw, 0.f, 0.f, false, tid);
        if (rr < 3) { tile_load(kw, Kb, (size_t)(b * 16 + n + 1) * 128, h * 128, tid, QS); tile_load(vw, Vb, (size_t)(b * 16 + n + 1) * 128, h * 128, tid, QS); }
        __syncthreads();
        if (rr > 0) st_state_bf16(LP + (size_t)((b * 16 + n) * 4 + h) * 16384, run, mt, ntb, r, hl);
        f32x16 acc[2];
#pragma unroll
        for (int t = 0; t < 2; ++t)
#pragma unroll
            for (int i = 0; i < 16; ++i) acc[t][i] = 0.f;
#pragma unroll
        for (int ks = 0; ks < 8; ++ks) { const bf16x8 a = tr_frag(Ks, 16 * ks + 8 * hl, 16 * ks + 8 * hl + 4, mt, lane);
#pragma unroll
            for (int t = 0; t < 2; ++t) { const bf16x8 bb = tr_frag(Vs, 16 * ks + 8 * hl, 16 * ks + 8 * hl + 4, ntb + t, lane); acc[t] = __builtin_amdgcn_mfma_f32_32x32x16_bf16(a, bb, acc[t], 0, 0, 0); } }
#pragma unroll
        for (int t = 0; t < 2; ++t)
#pragma unroll
            for (int i = 0; i < 16; ++i) run[t][i] = run[t][i] * cd + acc[t][i];
        __syncthreads();
    }
    st_state_bf16(GT + (size_t)gu * 16384, run, mt, ntb, r, hl);
}
__device__ __forceinline__ void sample_pair_unit(LAS unsigned char* lds, int pu, int l, const bf16* Qb, const bf16* Kb, const bf16* Vb, const bf16* Gb, const float* state_in, float* state_out, bf16* A2, int tid) {
    const int half = tid >> 8, ht = tid & 255, lane = tid & 63, dq = (tid >> 6) & 3;
    const int su = 2 * pu + half, b = su >> 2, h = su & 3, row0 = TP + 4 * b;
    LAS float* base = (LAS float*)(lds + half * 16384);
    LAS float* qT = base;
    LAS float* kT = base + 512;
    LAS float* vs = base + 1024;
    LAS float* sc = base + 1536;
    LAS float* part = base + 1600;
    if (ht < 192) { const int which = ht >> 6, t = (ht >> 4) & 3, ch = ht & 15;
        const bf16* src = which == 0 ? Qb : which == 1 ? Kb : Vb; float f[8]; unpack8(*(const v4u*)(src + (size_t)(row0 + t) * QS + h * 128 + ch * 8), f);
        if (which == 2) {
#pragma unroll
            for (int x = 0; x < 8; ++x) vs[t * 128 + ch * 8 + x] = f[x];
        } else { LAS float* dst = which == 0 ? qT : kT;
#pragma unroll
            for (int x = 0; x < 8; ++x) dst[(ch * 8 + x) * 4 + t] = f[x]; } }
    __syncthreads();
    const float lg2 = l2gamma(h);
    {
        const v4f qa = *(const LAS v4f*)(qT + (2 * lane) * 4), qb = *(const LAS v4f*)(qT + (2 * lane + 1) * 4), ka = *(const LAS v4f*)(kT + (2 * lane) * 4), kb = *(const LAS v4f*)(kT + (2 * lane + 1) * 4);
        const float qx = dq == 0 ? qa.x : dq == 1 ? qa.y : dq == 2 ? qa.z : qa.w, qy = dq == 0 ? qb.x : dq == 1 ? qb.y : dq == 2 ? qb.z : qb.w;
#pragma unroll
        for (int jj = 0; jj < 4; ++jj) { float sp = qx * ka[jj] + qy * kb[jj]; sp = wave_sum(sp); if (lane == 0) sc[dq * 4 + jj] = (jj <= dq) ? sp * exp2f((float)(dq - jj) * lg2) : 0.f; }
    }
    const size_t sbase = ((size_t)(l * 128 + b) * 4 + h) * 16384;
    const float g4 = exp2f(4.f * lg2), g3 = exp2f(3.f * lg2), g2 = exp2f(2.f * lg2), g1 = exp2f(lg2);
    float vt[4][2], cross[4][2];
#pragma unroll
    for (int t = 0; t < 4; ++t) { vt[t][0] = vs[t * 128 + 2 * lane]; vt[t][1] = vs[t * 128 + 2 * lane + 1]; cross[t][0] = 0.f; cross[t][1] = 0.f; }
    typedef float v2f __attribute__((ext_vector_type(2)));
#pragma unroll 1
    for (int db = 0; db < 32; db += 16) {
    v2f rin[16];
#pragma unroll
    for (int dd = 0; dd < 16; ++dd) rin[dd] = __builtin_nontemporal_load((const v2f*)(state_in + sbase + (size_t)(32 * dq + db + dd) * 128 + 2 * lane));
#pragma unroll
    for (int dd = 0; dd < 16; ++dd) { const int d = 32 * dq + db + dd;
        const v2f r = rin[dd];
        const v4f q4 = *(const LAS v4f*)(qT + d * 4), k4 = *(const LAS v4f*)(kT + d * 4);
        const float k0 = k4.x * g3, k1 = k4.y * g2, k2 = k4.z * g1, k3 = k4.w;
        v2f rn;
#pragma unroll
        for (int c = 0; c < 2; ++c) { cross[0][c] += q4.x * r[c]; cross[1][c] += q4.y * r[c]; cross[2][c] += q4.z * r[c]; cross[3][c] += q4.w * r[c];
            rn[c] = g4 * r[c] + (k0 * vt[0][c] + k1 * vt[1][c] + k2 * vt[2][c] + k3 * vt[3][c]); }
        __builtin_nontemporal_store(rn, (v2f*)(state_out + sbase + (size_t)d * 128 + 2 * lane)); }
    }
#pragma unroll
    for (int t = 0; t < 4; ++t) *(LAS v2f*)(part + (dq * 4 + t) * 128 + 2 * lane) = (v2f){cross[t][0], cross[t][1]};
    __syncthreads();
    {   const int t = dq; float o[2];
#pragma unroll
        for (int c = 0; c < 2; ++c) { const int e = 2 * lane + c; float oc = 0.f;
#pragma unroll
            for (int q = 0; q < 4; ++q) oc += part[(q * 4 + t) * 128 + e];
            float oi = 0.f;
#pragma unroll
            for (int jj = 0; jj < 4; ++jj) oi += sc[t * 4 + jj] * vs[jj * 128 + e];
            o[c] = oi + exp2f((float)(t + 1) * lg2) * oc; }
        const float mean = wave_sum(o[0] + o[1]) * (1.f / 128.f), d0 = o[0] - mean, d1 = o[1] - mean;
        const float rstd = rsqrtf(wave_sum(d0 * d0 + d1 * d1) * (1.f / 128.f) + LN_EPS);
        const int row = row0 + t; const unsigned gw2 = *(const unsigned*)(Gb + (size_t)row * QS + h * 128 + 2 * lane);
        *(unsigned*)(A2 + (size_t)row * D + h * 128 + 2 * lane) = cvtpk(d0 * rstd * bflo(gw2), d1 * rstd * bfhi(gw2)); }
    __syncthreads();
}
template <int NT> __device__ __forceinline__ void conv_unit(LAS unsigned char* lds, int cu, int l, const bf16* Ub, const float* cache_in, const float* dwk, const float* dwb, const float* lng, const float* lnb, bf16* A2, int tid) {
    constexpr int NR = NT + 30;
    LAS unsigned char* us = lds; LAS float* ys = (LAS float*)(lds + 65536);
    const int lane = tid & 63, wave = __builtin_amdgcn_readfirstlane(tid >> 6);
    int row0;
    if (NT == 32) { row0 = cu * 32; const int t0 = row0 & 2047;
        v4u w[(NR * 64 + NTHR - 1) / NTHR];
#pragma unroll
        for (int it = 0; it < (NR * 64 + NTHR - 1) / NTHR; ++it) { const int idx = tid + it * NTHR, i = idx >> 6, ch = idx & 63; w[it] = (v4u){0u, 0u, 0u, 0u};
            if (idx < NR * 64 && t0 - 30 + i >= 0) w[it] = *(const v4u*)(Ub + (size_t)(row0 - 30 + i) * RW + ch * 8); }
#pragma unroll
        for (int it = 0; it < (NR * 64 + NTHR - 1) / NTHR; ++it) { const int idx = tid + it * NTHR, i = idx >> 6, ch = idx & 63; if (idx < NR * 64) *(LAS v4u*)(us + i * 1024 + ch * 16) = w[it]; }
    } else { row0 = TP + 4 * cu;
        for (int idx = tid; idx < NR * 64; idx += NTHR) { const int i = idx >> 6, ch = idx & 63; v4u w;
            if (i < 30) { const float* cp = cache_in + ((size_t)(l * 128 + cu) * 30 + i) * 512 + ch * 8; const v4f a = *(const v4f*)cp, b = *(const v4f*)(cp + 4);
                w.x = cvtpk(a.x, a.y); w.y = cvtpk(a.z, a.w); w.z = cvtpk(b.x, b.y); w.w = cvtpk(b.z, b.w); }
            else w = *(const v4u*)(Ub + (size_t)(row0 + i - 30) * RW + ch * 8);
            *(LAS v4u*)(us + i * 1024 + ch * 16) = w; }
    }
    f32x2_t wp[32];
    { float wprev = 0.f;
#pragma unroll
      for (int k = 0; k < 31; ++k) { const float wcur = dwk[k * 512 + tid]; wp[k] = (f32x2_t){wcur, wprev}; wprev = wcur; }
      wp[31] = (f32x2_t){0.f, wprev}; }
    const float bb = dwb[tid];
    __syncthreads();
    constexpr int CT = (NT < 8) ? NT : 8;
#pragma unroll 1
    for (int c0 = 0; c0 < NT; c0 += CT) {
        static_assert(CT % 2 == 0, "token pairs");
        f32x2_t y2[CT / 2];
#pragma unroll
        for (int t = 0; t < CT / 2; ++t) y2[t] = (f32x2_t){bb, bb};
#pragma unroll
        for (int i = 0; i < CT + 30; ++i) { const float val = bf2f(*(const LAS bf16*)(us + (c0 + i) * 1024 + tid * 2)); const f32x2_t v2 = (f32x2_t){val, val};
#pragma unroll
            for (int t = 0; t < CT; t += 2) { if (i - t >= 0 && i - t < 32) y2[t / 2] = wp[i - t] * v2 + y2[t / 2]; } }
#pragma unroll
        for (int t = 0; t < CT / 2; ++t) { ys[(c0 + 2 * t) * 512 + tid] = y2[t].x; ys[(c0 + 2 * t + 1) * 512 + tid] = y2[t].y; }
    }
    __syncthreads();
    constexpr int TPW = (NT + 7) / 8;
    const v4f ga = *(const v4f*)(lng + 4 * lane), gb = *(const v4f*)(lng + 256 + 4 * lane), ba = *(const v4f*)(lnb + 4 * lane), bbv = *(const v4f*)(lnb + 256 + 4 * lane);
#pragma unroll
    for (int tt = 0; tt < TPW; ++tt) { const int t = wave * TPW + tt;
        if (t < NT) {
            v4f a = *(const LAS v4f*)(ys + t * 512 + 4 * lane), b = *(const LAS v4f*)(ys + t * 512 + 256 + 4 * lane);
            const float mean = wave_sum((a.x + a.y) + (a.z + a.w) + (b.x + b.y) + (b.z + b.w)) * (1.f / 512.f);
            a = a - mean; b = b - mean;
            const float rstd = rsqrtf(wave_sum((a.x * a.x + a.y * a.y) + (a.z * a.z + a.w * a.w) + (b.x * b.x + b.y * b.y) + (b.z * b.z + b.w * b.w)) * (1.f / 512.f) + LN_EPS);
            a = a * rstd * ga + ba; b = b * rstd * gb + bbv;
            v2u wa, wb; wa.x = cvtpk(silu_f(a.x), silu_f(a.y)); wa.y = cvtpk(silu_f(a.z), silu_f(a.w)); wb.x = cvtpk(silu_f(b.x), silu_f(b.y)); wb.y = cvtpk(silu_f(b.z), silu_f(b.w));
            bf16* op = A2 + (size_t)(row0 + t) * D + 512 + 4 * lane; *(v2u*)op = wa; *(v2u*)(op + 256) = wb; }
    }
    __syncthreads();
}
__device__ __forceinline__ float sum32_f(float v) {
    v += __builtin_bit_cast(float, __builtin_amdgcn_update_dpp(0, __builtin_bit_cast(int, v), 0xB1, 0xf, 0xf, false));
    v += __builtin_bit_cast(float, __builtin_amdgcn_update_dpp(0, __builtin_bit_cast(int, v), 0x4E, 0xf, 0xf, false));
    v += __builtin_bit_cast(float, __builtin_amdgcn_update_dpp(0, __builtin_bit_cast(int, v), 0x141, 0xf, 0xf, false));
    v += __builtin_bit_cast(float, __builtin_amdgcn_update_dpp(0, __builtin_bit_cast(int, v), 0x128, 0xf, 0xf, false));
    { const unsigned a = __builtin_bit_cast(unsigned, v); const auto r = __builtin_amdgcn_permlane16_swap(a, a, false, false); unsigned r0 = r[0], r1 = r[1]; asm volatile("" : "+v"(r0), "+v"(r1)); v = __builtin_bit_cast(float, r0) + __builtin_bit_cast(float, r1); }
    return v;
}
__device__ __forceinline__ void ret_unit(LAS unsigned char* lds, int uidx, int l, const bf16* Qb, const bf16* Kb, const bf16* Vb, const bf16* Gb, const bf16* LP, const bf16* GT, float* state_out, bf16* A2, int tid) {
    const int h = uidx & 3, bn = uidx >> 2, n = bn & 15, b = bn >> 4, g = n >> 2, rr = n & 3; const size_t row0 = (size_t)bn * 128;
    const int lane = tid & 63, wave = __builtin_amdgcn_readfirstlane(tid >> 6), r = lane & 31, hl = lane >> 5, s = wave & 3, eh = wave >> 2;
    LAS unsigned char* Qs = lds; LAS unsigned char* Ks = lds + 32768; LAS unsigned char* Vs = lds + 65536; LAS float* stat = (LAS float*)(lds + 98304);
    const float lg2 = l2gamma(h);
    LAS unsigned char* Rs = lds + 100352;
    v4u qw[4], kw[4], vw[4];
    tile_load(qw, Qb, row0, h * 128, tid, QS); tile_load(kw, Kb, row0, h * 128, tid, QS); tile_load(vw, Vb, row0, h * 128, tid, QS);
    {
        const int d = tid >> 2, e0 = (tid & 3) * 32; const float cd4 = exp2f(512.f * lg2), gam = exp2f(lg2), cr = exp2f((float)(128 * rr) * lg2);
        const float w2 = (g > 2) ? 1.f : 0.f, w1 = (g > 1) ? ((g > 2) ? cd4 : 1.f) : 0.f, w0 = (g > 0) ? ((g > 2) ? cd4 * cd4 : (g > 1) ? cd4 : 1.f) : 0.f;
#pragma unroll
        for (int hf = 0; hf < 2; ++hf) {
            v4f gb[3][4], lpb[4];
#pragma unroll
            for (int gp = 0; gp < 3; ++gp) { const bf16* src = GT + (size_t)((b * 4 + gp) * 4 + h) * 16384 + d * 128 + e0 + 16 * hf;
#pragma unroll
                for (int x = 0; x < 4; ++x) gb[gp][x] = (v4f){0.f, 0.f, 0.f, 0.f};
                if (gp < g) { const v4u w0_ = *(const v4u*)src, w1_ = *(const v4u*)(src + 8);
                    gb[gp][0] = (v4f){bflo(w0_.x), bfhi(w0_.x), bflo(w0_.y), bfhi(w0_.y)}; gb[gp][1] = (v4f){bflo(w0_.z), bfhi(w0_.z), bflo(w0_.w), bfhi(w0_.w)};
                    gb[gp][2] = (v4f){bflo(w1_.x), bfhi(w1_.x), bflo(w1_.y), bfhi(w1_.y)}; gb[gp][3] = (v4f){bflo(w1_.z), bfhi(w1_.z), bflo(w1_.w), bfhi(w1_.w)}; } }
#pragma unroll
            for (int x = 0; x < 4; ++x) lpb[x] = (v4f){0.f, 0.f, 0.f, 0.f};
            if (rr > 0) { const bf16* src = LP + (size_t)((b * 16 + n) * 4 + h) * 16384 + d * 128 + e0 + 16 * hf; const v4u w0_ = *(const v4u*)src, w1_ = *(const v4u*)(src + 8);
                lpb[0] = (v4f){bflo(w0_.x), bfhi(w0_.x), bflo(w0_.y), bfhi(w0_.y)}; lpb[1] = (v4f){bflo(w0_.z), bfhi(w0_.z), bflo(w0_.w), bfhi(w0_.w)};
                lpb[2] = (v4f){bflo(w1_.x), bfhi(w1_.x), bflo(w1_.y), bfhi(w1_.y)}; lpb[3] = (v4f){bflo(w1_.z), bfhi(w1_.z), bflo(w1_.w), bfhi(w1_.w)}; }
            v4f rv[4];
#pragma unroll
            for (int x = 0; x < 4; ++x) rv[x] = gb[0][x] * w0 + gb[1][x] * w1 + gb[2][x] * w2;
            if (n == 15) { const bf16* src = GT + (size_t)((b * 4 + 3) * 4 + h) * 16384 + d * 128 + e0 + 16 * hf; float* dst = state_out + ((size_t)((l * 8 + b) * 4 + h)) * 16384 + d * 128 + e0 + 16 * hf;
                const v4u w0_ = *(const v4u*)src, w1_ = *(const v4u*)(src + 8);
                *(v4f*)(dst + 0) = rv[0] * cd4 + (v4f){bflo(w0_.x), bfhi(w0_.x), bflo(w0_.y), bfhi(w0_.y)}; *(v4f*)(dst + 4) = rv[1] * cd4 + (v4f){bflo(w0_.z), bfhi(w0_.z), bflo(w0_.w), bfhi(w0_.w)};
                *(v4f*)(dst + 8) = rv[2] * cd4 + (v4f){bflo(w1_.x), bfhi(w1_.x), bflo(w1_.y), bfhi(w1_.y)}; *(v4f*)(dst + 12) = rv[3] * cd4 + (v4f){bflo(w1_.z), bfhi(w1_.z), bflo(w1_.w), bfhi(w1_.w)}; }
#pragma unroll
            for (int x = 0; x < 2; ++x) { const v4f o0 = (rv[2 * x] * cr + lpb[2 * x]) * gam, o1 = (rv[2 * x + 1] * cr + lpb[2 * x + 1]) * gam;
                *(LAS v4u*)(Rs + offb(d, (e0 >> 3) + 2 * hf + x)) = (v4u){cvtpk(o0.x, o0.y), cvtpk(o0.z, o0.w), cvtpk(o1.x, o1.y), cvtpk(o1.z, o1.w)}; }
            asm volatile("" ::: "memory");
        }
    }
    asm volatile("" ::: "memory");
    tile_store(Qs, qw, 0.f, lg2, true, tid); tile_store(Ks, kw, 0.f, -lg2, true, tid); tile_store(Vs, vw, 0.f, 0.f, false, tid);
    __syncthreads();
    f32x16 st[4];
#pragma unroll
    for (int mt = 0; mt < 4; ++mt) {
#pragma unroll
        for (int i = 0; i < 16; ++i) st[mt][i] = 0.f;
        if (mt <= s) {
#pragma unroll
            for (int ks = 0; ks < 8; ++ks) st[mt] = __builtin_amdgcn_mfma_f32_32x32x16_bf16(row_frag(Ks, 32 * mt, ks, lane), row_frag(Qs, 32 * s, ks, lane), st[mt], 0, 0, 0);
            if (mt == s) {
#pragma unroll
                for (int i = 0; i < 16; ++i) st[mt][i] = (crow16(i, hl) > r) ? 0.f : st[mt][i];
            }
        }
    }
    f32x16 oa[2];
#pragma unroll
    for (int t = 0; t < 2; ++t)
#pragma unroll
        for (int i = 0; i < 16; ++i) oa[t][i] = 0.f;
#pragma unroll
    for (int mt = 0; mt < 4; ++mt) if (mt <= s) {
#pragma unroll
        for (int s2 = 0; s2 < 2; ++s2) {
            u32x4v pa; pa.x = cvtpk(st[mt][8 * s2], st[mt][8 * s2 + 1]); pa.y = cvtpk(st[mt][8 * s2 + 2], st[mt][8 * s2 + 3]); pa.z = cvtpk(st[mt][8 * s2 + 4], st[mt][8 * s2 + 5]); pa.w = cvtpk(st[mt][8 * s2 + 6], st[mt][8 * s2 + 7]);
            const bf16x8 a = __builtin_bit_cast(bf16x8, pa);
#pragma unroll
            for (int t = 0; t < 2; ++t) oa[t] = __builtin_amdgcn_mfma_f32_32x32x16_bf16(a, tr_frag(Vs, 32 * mt + 16 * s2 + 4 * hl, 32 * mt + 16 * s2 + 8 + 4 * hl, 2 * eh + t, lane), oa[t], 0, 0, 0);
        }
    }
#pragma unroll
    for (int ks = 0; ks < 8; ++ks) { const bf16x8 a = row_frag(Qs, 32 * s, ks, lane);
#pragma unroll
        for (int t = 0; t < 2; ++t) oa[t] = __builtin_amdgcn_mfma_f32_32x32x16_bf16(a, tr_frag(Rs, 16 * ks + 8 * hl, 16 * ks + 8 * hl + 4, 2 * eh + t, lane), oa[t], 0, 0, 0); }
#pragma unroll
    for (int i = 0; i < 16; ++i) { float ps = oa[0][i] + oa[1][i], pq = oa[0][i] * oa[0][i] + oa[1][i] * oa[1][i];
        ps = sum32_f(ps); pq = sum32_f(pq);
        if (r == 0) { stat[(wave * 32 + crow16(i, hl)) * 2] = ps; stat[(wave * 32 + crow16(i, hl)) * 2 + 1] = pq; } }
    v4u gw[4]; tile_load(gw, Gb, row0, h * 128, tid, QS);
    __syncthreads();
#pragma unroll
    for (int i = 0; i < 16; ++i) { const int rl = crow16(i, hl);
        const float sm = stat[(s * 32 + rl) * 2] + stat[((s + 4) * 32 + rl) * 2], sq = stat[(s * 32 + rl) * 2 + 1] + stat[((s + 4) * 32 + rl) * 2 + 1];
        const float mean = sm * (1.f / 128.f), var = fmaxf(sq * (1.f / 128.f) - mean * mean, 0.f), rstd = rsqrtf(var + LN_EPS);
#pragma unroll
        for (int t = 0; t < 2; ++t) { const int e = 64 * eh + 32 * t + r;
            *(LAS bf16*)(Qs + offb(32 * s + rl, e >> 3) + (e & 7) * 2) = (bf16)(cvtpk((oa[t][i] - mean) * rstd, 0.f) & 0xffffu); } }
    __syncthreads();
#pragma unroll
    for (int i = 0; i < 4; ++i) { const int idx = tid + 512 * i, j = idx >> 4, ch = idx & 15;
        float o8[8], g8[8]; unpack8(*(const LAS v4u*)(Qs + offb(j, ch)), o8); unpack8(gw[i], g8);
        v4u w; w.x = cvtpk(o8[0] * g8[0], o8[1] * g8[1]); w.y = cvtpk(o8[2] * g8[2], o8[3] * g8[3]); w.z = cvtpk(o8[4] * g8[4], o8[5] * g8[5]); w.w = cvtpk(o8[6] * g8[6], o8[7] * g8[7]);
        *(v4u*)(A2 + (row0 + j) * D + h * 128 + ch * 8) = w; }
    __syncthreads();
}
__host__ __device__ __forceinline__ void ce_desc(float& a, float& b) { const float hi = fmaxf(a, b), lo = fminf(a, b); a = hi; b = lo; }
template <int N> __host__ __device__ __forceinline__ void bitonic_sort_desc(float (&a)[N]) {
#pragma unroll
    for (int k = 2; k <= N; k <<= 1)
#pragma unroll
        for (int j = k >> 1; j > 0; j >>= 1)
#pragma unroll
            for (int i = 0; i < N; ++i) { const int p = i ^ j; if (p > i) { if ((i & k) == 0) ce_desc(a[i], a[p]); else ce_desc(a[p], a[i]); } }
}
template <int N> __host__ __device__ __forceinline__ void bitonic_merge_desc(float (&a)[N]) {
#pragma unroll
    for (int j = N >> 1; j > 0; j >>= 1)
#pragma unroll
        for (int i = 0; i < N; ++i) { const int p = i ^ j; if (p > i) ce_desc(a[i], a[p]); }
}
__host__ __device__ __forceinline__ void sort16_desc(float (&a)[16]) {
    ce_desc(a[0], a[13]); ce_desc(a[1], a[12]); ce_desc(a[2], a[15]); ce_desc(a[3], a[14]); ce_desc(a[4], a[8]); ce_desc(a[5], a[6]); ce_desc(a[7], a[11]); ce_desc(a[9], a[10]); ce_desc(a[0], a[5]); ce_desc(a[1], a[7]); ce_desc(a[2], a[9]); ce_desc(a[3], a[4]); ce_desc(a[6], a[13]); ce_desc(a[8], a[14]); ce_desc(a[10], a[15]); ce_desc(a[11], a[12]); ce_desc(a[0], a[1]); ce_desc(a[2], a[3]); ce_desc(a[4], a[5]); ce_desc(a[6], a[8]); ce_desc(a[7], a[9]); ce_desc(a[10], a[11]); ce_desc(a[12], a[13]); ce_desc(a[14], a[15]); ce_desc(a[0], a[2]); ce_desc(a[1], a[3]); ce_desc(a[4], a[10]); ce_desc(a[5], a[11]); ce_desc(a[6], a[7]); ce_desc(a[8], a[9]); ce_desc(a[12], a[14]); ce_desc(a[13], a[15]); ce_desc(a[1], a[2]); ce_desc(a[3], a[12]); ce_desc(a[4], a[6]); ce_desc(a[5], a[7]); ce_desc(a[8], a[10]); ce_desc(a[9], a[11]); ce_desc(a[13], a[14]); ce_desc(a[1], a[4]); ce_desc(a[2], a[6]); ce_desc(a[5], a[8]); ce_desc(a[7], a[10]); ce_desc(a[9], a[13]); ce_desc(a[11], a[14]); ce_desc(a[2], a[4]); ce_desc(a[3], a[6]); ce_desc(a[9], a[12]); ce_desc(a[11], a[13]); ce_desc(a[3], a[5]); ce_desc(a[6], a[8]); ce_desc(a[7], a[9]); ce_desc(a[10], a[12]); ce_desc(a[3], a[4]); ce_desc(a[5], a[6]); ce_desc(a[7], a[8]); ce_desc(a[9], a[10]); ce_desc(a[11], a[12]); ce_desc(a[6], a[7]); ce_desc(a[8], a[9]);
}
__host__ __device__ __forceinline__ void merge_top16(float (&a)[16], const float (&b)[16]) {
#pragma unroll
    for (int i = 0; i < 16; ++i) a[i] = fmaxf(a[i], b[15 - i]);
    bitonic_merge_desc<16>(a);
}
__host__ __device__ __forceinline__ void top16_of_64(float (&g0)[16], float (&g1)[16], float (&g2)[16], float (&g3)[16]) {
    sort16_desc(g0); sort16_desc(g1); sort16_desc(g2); sort16_desc(g3);
    merge_top16(g0, g1); merge_top16(g2, g3); merge_top16(g0, g2);
}
__host__ __device__ __forceinline__ float pack_low(float v, unsigned mask, unsigned code) { unsigned u = __builtin_bit_cast(unsigned, v); u = (u & ~mask) | code; return __builtin_bit_cast(float, u); }
__host__ __device__ constexpr int cand_i(int n) { return n < 16 ? 0 : n < 24 ? 1 : n < 29 ? 2 : n < 33 ? 3 : n < 36 ? 4 : n < 38 ? 5 : n < 40 ? 6 : n < 42 ? 7 : n - 34; }
__host__ __device__ constexpr int cand_j(int n) { return n < 16 ? n : n < 24 ? n - 16 : n < 29 ? n - 24 : n < 33 ? n - 29 : n < 36 ? n - 33 : n < 38 ? n - 36 : n < 40 ? n - 38 : n < 42 ? n - 40 : 0; }
__host__ __device__ __forceinline__ void top16_pair_sums(const float (&v1)[16], const float (&v2)[16], float (&c0)[16]) {
    float c1[16], c2[16], c3[16];
    const float ninf = __builtin_bit_cast(float, 0xff800000u);
#define PS_C(n) pack_low(v1[cand_i(n)] + v2[cand_j(n)], 0xffu, (unsigned)((cand_i(n) << 4) | cand_j(n)))
#pragma unroll
    for (int n = 0; n < 16; ++n) { c0[n] = PS_C(n); c1[n] = PS_C(16 + n); c2[n] = PS_C(32 + n); }
    c3[0] = PS_C(48); c3[1] = PS_C(49);
#pragma unroll
    for (int n = 2; n < 16; ++n) c3[n] = ninf;
#undef PS_C
    top16_of_64(c0, c1, c2, c3);
}

__device__ __forceinline__ void route_stage_keys(LAS unsigned char* lds, int head, int l, const bf16* KEYS, int tid) {
    stage_tile(lds, KEYS + (size_t)((l * 2 + 0) * 8 + head) * 16384, 0, 0, 0.f, 0.f, false, tid, 128);
    stage_tile(lds + 32768, KEYS + (size_t)((l * 2 + 1) * 8 + head) * 16384, 0, 0, 0.f, 0.f, false, tid, 128);
}
__device__ __forceinline__ void route_unit(LAS unsigned char* lds, int head, int tok0, int ntok, int ntok0, v4u (&qa)[4], v4u (&qb)[4], const bf16* QP, unsigned short* RI, float* RG, int tid) {
    const int wave = __builtin_amdgcn_readfirstlane(tid >> 6), lane = tid & 63, side = wave >> 2, sub = wave & 3, r = lane & 31, hl = lane >> 5;
    LAS unsigned char* Ks = lds + side * 32768; LAS unsigned char* Qs = lds + 65536 + side * 32768;
    tile_store(lds + 65536, qa, 0.f, 0.f, false, tid); tile_store(lds + 98304, qb, 0.f, 0.f, false, tid);
    __syncthreads();
    f32x16 acc[4];
#pragma unroll
    for (int mt = 0; mt < 4; ++mt)
#pragma unroll
        for (int i = 0; i < 16; ++i) acc[mt][i] = 0.f;
#pragma unroll
    for (int ks = 0; ks < 8; ++ks) { const bf16x8 bq = row_frag(Qs, 32 * sub, ks, lane);
#pragma unroll
        for (int mt = 0; mt < 4; ++mt) acc[mt] = __builtin_amdgcn_mfma_f32_32x32x16_bf16(row_frag(Ks, 32 * mt, ks, lane), bq, acc[mt], 0, 0, 0); }
    float g0[16], g1[16], g2[16], g3[16];
#pragma unroll
    for (int i = 0; i < 16; ++i) { const unsigned kr = (unsigned)((i & 3) + 8 * (i >> 2) + 4 * hl);
        g0[i] = pack_low(acc[0][i], 127u, kr); g1[i] = pack_low(acc[1][i], 127u, 32u + kr); g2[i] = pack_low(acc[2][i], 127u, 64u + kr); g3[i] = pack_low(acc[3][i], 127u, 96u + kr); }
    top16_of_64(g0, g1, g2, g3);
#pragma unroll
    for (int i = 0; i < 16; ++i) { const unsigned a = __builtin_bit_cast(unsigned, g0[15 - i]); const auto rr = __builtin_amdgcn_permlane32_swap(a, a, false, false); unsigned r0 = rr[0], r1 = rr[1]; asm volatile("" : "+v"(r0), "+v"(r1));
        g1[i] = __builtin_bit_cast(float, hl ? r0 : r1); }
#pragma unroll
    for (int i = 0; i < 16; ++i) g0[i] = fmaxf(g0[i], g1[i]);
    bitonic_merge_desc<16>(g0);
    __syncthreads();
    LAS float* cand = (LAS float*)(lds + 65536);
    if (hl == 0) { LAS v4f* p = (LAS v4f*)(cand + ((side * 128) + sub * 32 + r) * 16);
#pragma unroll
        for (int x = 0; x < 4; ++x) p[x] = (v4f){g0[4 * x], g0[4 * x + 1], g0[4 * x + 2], g0[4 * x + 3]}; }
    __syncthreads();
    if (ntok0 >= 0) { tile_load(qa, QP, (size_t)ntok0, head * 256, tid, 2048); tile_load(qb, QP, (size_t)ntok0, head * 256 + 128, tid, 2048); }
    {
        const int tk = tid >> 1; const bool pp = (tid & 1) != 0;
        if (tk < ntok) {
        float v1[16], v2[16], c0[16], c1[16];
#pragma unroll
        for (int x = 0; x < 4; ++x) { const v4f a = *(const LAS v4f*)(cand + tk * 16 + 4 * x), b = *(const LAS v4f*)(cand + (128 + tk) * 16 + 4 * x);
            v1[4 * x] = a.x; v1[4 * x + 1] = a.y; v1[4 * x + 2] = a.z; v1[4 * x + 3] = a.w; v2[4 * x] = b.x; v2[4 * x + 1] = b.y; v2[4 * x + 2] = b.z; v2[4 * x + 3] = b.w; }
        const float ninf = __builtin_bit_cast(float, 0xff800000u);
#define PS_C(n) pack_low(v1[cand_i(n)] + v2[cand_j(n)], 0xffu, (unsigned)((cand_i(n) << 4) | cand_j(n)))
#pragma unroll
        for (int n = 0; n < 16; ++n) { const float a0 = PS_C(n), a1 = PS_C(32 + n), b0 = PS_C(16 + n), b1 = (n < 2) ? PS_C(48 + (n & 1)) : ninf; c0[n] = pp ? a1 : a0; c1[n] = pp ? b1 : b0; }
#undef PS_C
        sort16_desc(c0); sort16_desc(c1); merge_top16(c0, c1);
#pragma unroll
        for (int i = 0; i < 16; ++i) c1[i] = __builtin_bit_cast(float, __builtin_amdgcn_update_dpp(0, __builtin_bit_cast(int, c0[15 - i]), 0xB1, 0xf, 0xf, false));
#pragma unroll
        for (int i = 0; i < 16; ++i) c0[i] = fmaxf(c0[i], c1[i]);
        bitonic_merge_desc<16>(c0);
        float e[16], se = 0.f;
#pragma unroll
        for (int k = 0; k < 16; ++k) { e[k] = __expf(c0[k] - c0[0]); se += e[k]; }
        const float inv = 1.f / se;
        const LAS unsigned* cb = (const LAS unsigned*)cand;
        unsigned short* ri = RI + (size_t)(tok0 + tk) * NSEL + head * 16 + (pp ? 8 : 0); float* rg = RG + (size_t)(tok0 + tk) * NSEL + head * 16 + (pp ? 8 : 0);
#pragma unroll
        for (int x = 0; x < 2; ++x) { int ii[4]; float gg[4];
#pragma unroll
            for (int y = 0; y < 4; ++y) { const int k = 4 * x + y; float cl = c0[k], ch = c0[8 + k], el = e[k], eh = e[8 + k]; asm volatile("" : "+v"(cl), "+v"(ch), "+v"(el), "+v"(eh));
                const unsigned code = __builtin_bit_cast(unsigned, pp ? ch : cl) & 0xffu;
                const unsigned e1 = cb[tk * 16 + (code >> 4)] & 127u, e2 = cb[(128 + tk) * 16 + (code & 15u)] & 127u;
                ii[y] = (int)(e1 * 128u + e2); gg[y] = (pp ? eh : el) * inv; }
            *(v2u*)(ri + 4 * x) = (v2u){(unsigned)ii[0] | ((unsigned)ii[1] << 16), (unsigned)ii[2] | ((unsigned)ii[3] << 16)}; *(v4f*)(rg + 4 * x) = (v4f){gg[0], gg[1], gg[2], gg[3]}; }
        }
    }
    __syncthreads();
}
template <int NR> __device__ __forceinline__ void quant_rows(const float* src, unsigned char* dstl, int row, float* scale_out, int offset_binary, int lane, bool i4 = false, bool lob = false) {
    v4f v[NR][4]; float m[NR];
#pragma unroll
    for (int r = 0; r < NR; ++r)
#pragma unroll
        for (int j = 0; j < 4; ++j) v[r][j] = __builtin_nontemporal_load((const v4f*)(src + (size_t)r * D + 256 * j + 4 * lane));
#pragma unroll
    for (int r = 0; r < NR; ++r) { float mm = 0.f;
#pragma unroll
        for (int j = 0; j < 4; ++j) mm = fmaxf(mm, fmaxf(fmaxf(fabsf(v[r][j].x), fabsf(v[r][j].y)), fmaxf(fabsf(v[r][j].z), fabsf(v[r][j].w))));
        m[r] = mm; }
#pragma unroll
    for (int r = 0; r < NR; ++r) m[r] = wave_max(m[r]);
    if (i4) {
#pragma unroll
        for (int r = 0; r < NR; ++r) { float q2 = 0.f;
#pragma unroll
            for (int j = 0; j < 4; ++j) q2 += (v[r][j].x * v[r][j].x + v[r][j].y * v[r][j].y) + (v[r][j].z * v[r][j].z + v[r][j].w * v[r][j].w);
            const float clip = fminf(m[r], 2.5f * sqrtf(wave_sum(q2) * (1.f / D))), sc = clip > 0.f ? 7.f / clip : 0.f; unsigned d0 = 0u, d1 = 0u;
#pragma unroll
            for (int e = 0; e < 4; ++e) {
                const int q0 = (int)rintf(fminf(fmaxf(v[r][0][e] * sc, -7.f), 7.f)), q1 = (int)rintf(fminf(fmaxf(v[r][1][e] * sc, -7.f), 7.f)), q2i = (int)rintf(fminf(fmaxf(v[r][2][e] * sc, -7.f), 7.f)), q3 = (int)rintf(fminf(fmaxf(v[r][3][e] * sc, -7.f), 7.f));
                const int lb = lob ? 8 : 0;
                d0 |= (((unsigned)(q0 + lb) & 15u) << (8 * e)) | (((unsigned)q1 & 15u) << (8 * e + 4)); d1 |= (((unsigned)(q2i + lb) & 15u) << (8 * e)) | (((unsigned)q3 & 15u) << (8 * e + 4)); }
            __builtin_nontemporal_store((v2u){d0, d1}, (v2u*)(dstl + (size_t)(lane >> 4) * (16384 * 128) + (size_t)(row + r) * 128 + 8 * (lane & 15)));
            if (lane == 0) scale_out[r] = clip * (1.f / 7.f); }
        return; }
    const int off = offset_binary ? 128 : 0;
#pragma unroll
    for (int r = 0; r < NR; ++r) { const float sc = m[r] > 0.f ? 127.f / m[r] : 0.f; v4u o;
#pragma unroll
        for (int j = 0; j < 4; ++j) { unsigned w = 0;
#pragma unroll
            for (int e = 0; e < 4; ++e) { const int q = (int)rintf(v[r][j][e] * sc) + off; w |= ((unsigned)q & 0xffu) << (8 * e); }
            o[j] = w; }
        __builtin_nontemporal_store(o, (v4u*)(dstl + (size_t)(lane >> 3) * (16384 * 128) + (size_t)(row + r) * 128 + 16 * (lane & 7)));
        if (lane == 0) scale_out[r] = m[r] * (1.f / 127.f); }
}
__device__ __forceinline__ float ub0(unsigned w) { return (float)(w & 0xffu); }
__device__ __forceinline__ float ub1(unsigned w) { return (float)((w >> 8) & 0xffu); }
__device__ __forceinline__ float ub2(unsigned w) { return (float)((w >> 16) & 0xffu); }
__device__ __forceinline__ float ub3(unsigned w) { return (float)(w >> 24); }
struct SliceMap { int vx, rank, cnt; };
__device__ __forceinline__ SliceMap slice_map(unsigned* bar, volatile LAS unsigned* MISC, int G, int bx, int tid) {
    if (tid == 0) { const unsigned x = xb_xcc_id(); unsigned bad = (x >= 8u) ? 1u : 0u, mine = 0u;
#pragma unroll 1
        for (unsigned j = 0; j < 16; ++j) { const unsigned c = xb_ld(&bar[XB_XCNT(j)]); bad |= (j < 8u) ? (c == 0u ? 1u : 0u) : (c != 0u ? 1u : 0u); mine = (j == x) ? c : mine; }
        if (!bad) { MISC[12] = x; MISC[13] = MISC[10]; MISC[14] = mine; }
        else { MISC[12] = (unsigned)(bx & 7); MISC[13] = (unsigned)(bx >> 3); MISC[14] = (unsigned)((G - (bx & 7) + 7) >> 3); } }
    __syncthreads();
    SliceMap m; m.vx = (int)MISC[12]; m.rank = (int)MISC[13]; m.cnt = (int)MISC[14];
    __syncthreads();
    return m;
}
#define DPP_XOR1 0xB1
#define DPP_XOR2 0x4E
#define DPP_HMIR 0x141
#define DPP_ROR8 0x128
__device__ __forceinline__ int sum8_i(int t) { t += __builtin_amdgcn_update_dpp(0, t, DPP_XOR1, 0xf, 0xf, false); t += __builtin_amdgcn_update_dpp(0, t, DPP_XOR2, 0xf, 0xf, false); t += __builtin_amdgcn_update_dpp(0, t, DPP_HMIR, 0xf, 0xf, false); return t; }
__device__ __forceinline__ void expert_u_sweep(LAS unsigned char* wl, int tok0, int step, int tend, int cg, const unsigned char* XQ, const unsigned short* RI, const unsigned char* UB, int* PD, int lane) {
    const int g = lane >> 3, c = lane & 7;
    const unsigned char* us = UB + (size_t)cg * (16384 * 128); const unsigned c16 = 16u * (unsigned)c;
    const bool b0 = c & 1, b1 = c & 2, b2 = c & 4;
    const int t0c = tok0 < tend ? tok0 : 0;
    unsigned rid = *(const unsigned*)(RI + (size_t)t0c * NSEL + 2 * lane), rx = *(const unsigned*)(XQ + (size_t)t0c * D + 256 * cg + 4 * lane);
    *(LAS v2u*)(wl + 8 * lane) = (v2u){(rid & 0xffffu) << 7, (rid >> 16) << 7}; *(LAS unsigned*)(wl + 512 + 4 * lane) = rx;
    v4u en[4];
#pragma unroll
    for (int x = 0; x < 4; ++x) en[x] = *(const LAS v4u*)(wl + 64 * g + 16 * x);
    v4u xa = *(const LAS v4u*)(wl + 512 + 32 * c), xb = *(const LAS v4u*)(wl + 512 + 32 * c + 16);
    { const int t1c = tok0 + step < tend ? tok0 + step : t0c; rid = *(const unsigned*)(RI + (size_t)t1c * NSEL + 2 * lane); rx = *(const unsigned*)(XQ + (size_t)t1c * D + 256 * cg + 4 * lane); }
#pragma unroll 1
    for (int tok = tok0; tok < tend; tok += step) {
        const v4u xwa = xa, xwb = xb;
        v4u ub[16];
#pragma unroll
        for (int kk = 0; kk < 16; ++kk) ub[kk] = *(const v4u*)(us + (en[kk >> 2][kk & 3] + c16));
        *(LAS v2u*)(wl + 8 * lane) = (v2u){(rid & 0xffffu) << 7, (rid >> 16) << 7}; *(LAS unsigned*)(wl + 512 + 4 * lane) = rx;
#pragma unroll
        for (int x = 0; x < 4; ++x) en[x] = *(const LAS v4u*)(wl + 64 * g + 16 * x);
        xa = *(const LAS v4u*)(wl + 512 + 32 * c); xb = *(const LAS v4u*)(wl + 512 + 32 * c + 16);
        { const int tn2 = tok + 2 * step < tend ? tok + 2 * step : tok; rid = *(const unsigned*)(RI + (size_t)tn2 * NSEL + 2 * lane); rx = *(const unsigned*)(XQ + (size_t)tn2 * D + 256 * cg + 4 * lane); }
        int t[16];
        int msx = __builtin_amdgcn_sdot4((int)xwa.x, 0x01010101, 0, false); msx = __builtin_amdgcn_sdot4((int)xwa.z, 0x01010101, msx, false);
        msx = __builtin_amdgcn_sdot4((int)xwb.x, 0x01010101, msx, false); msx = __builtin_amdgcn_sdot4((int)xwb.z, 0x01010101, msx, false); msx = -8 * msx;
#pragma unroll
        for (int kk = 0; kk < 16; ++kk) { const v4u w = ub[kk]; int ah, al;
            asm("v_dot4_i32_i8 %0, %1, %2, 0" : "=v"(ah) : "v"((int)(w.x & 0xF0F0F0F0u)), "v"((int)xwa.y));
            asm("v_dot4_i32_i8 %0, %1, %2, %3" : "=v"(al) : "v"((int)(w.x & 0x0F0F0F0Fu)), "v"((int)xwa.x), "v"(msx));
            ah = __builtin_amdgcn_sdot4((int)(w.y & 0xF0F0F0F0u), (int)xwa.w, ah, false); al = __builtin_amdgcn_sdot4((int)(w.y & 0x0F0F0F0Fu), (int)xwa.z, al, false);
            ah = __builtin_amdgcn_sdot4((int)(w.z & 0xF0F0F0F0u), (int)xwb.y, ah, false); al = __builtin_amdgcn_sdot4((int)(w.z & 0x0F0F0F0Fu), (int)xwb.x, al, false);
            ah = __builtin_amdgcn_sdot4((int)(w.w & 0xF0F0F0F0u), (int)xwb.w, ah, false); al = __builtin_amdgcn_sdot4((int)(w.w & 0x0F0F0F0Fu), (int)xwb.z, al, false);
            t[kk] = sum8_i(ah + 16 * al); }
        int lo, hi;
        { const int a0 = b0 ? t[2] : t[0], a1 = b0 ? t[6] : t[4], a2 = b0 ? t[10] : t[8], a3 = b0 ? t[14] : t[12]; const int c0 = b1 ? a1 : a0, c1 = b1 ? a3 : a2; lo = b2 ? c1 : c0; }
        { const int a0 = b0 ? t[3] : t[1], a1 = b0 ? t[7] : t[5], a2 = b0 ? t[11] : t[9], a3 = b0 ? t[15] : t[13]; const int c0 = b1 ? a1 : a0, c1 = b1 ? a3 : a2; hi = b2 ? c1 : c0; }
        { const int l6 = min(max((lo + 32) >> 6, -32768), 32767), h6 = min(max((hi + 32) >> 6, -32768), 32767);
          *(unsigned*)((short*)PD + ((size_t)cg * T + tok) * NSEL + 2 * lane) = ((unsigned)l6 & 0xffffu) | ((unsigned)h6 << 16); }
    }
}
template <int NT> __device__ __forceinline__ void expert_coefs(int tok, int dt, const int* PD, const float* SX, const unsigned short* RI, const float* RG, const float* SU, const float* SV, unsigned char* CQ, float* CS, int lane) {
    int pd[NT][2][8], ev[NT][2]; float gv[NT][2], sxv[NT];
#pragma unroll
    for (int t = 0; t < NT; ++t) { const int tk = (tok + t * dt < T) ? tok + t * dt : tok;
        sxv[t] = SX[tk];
#pragma unroll
        for (int kh = 0; kh < 2; ++kh) { const int k = 64 * kh + lane; ev[t][kh] = (int)RI[(size_t)tk * NSEL + k]; gv[t][kh] = RG[(size_t)tk * NSEL + k];
#pragma unroll
            for (int x = 0; x < 4; ++x) pd[t][kh][x] = (int)__builtin_nontemporal_load((const short*)PD + ((size_t)x * T + tk) * NSEL + k); } }
    float suv[NT][2], svv[NT][2];
#pragma unroll
    for (int t = 0; t < NT; ++t)
#pragma unroll
        for (int kh = 0; kh < 2; ++kh) { suv[t][kh] = SU[ev[t][kh]]; svv[t][kh] = SV[ev[t][kh]]; }
#pragma unroll
    for (int t = 0; t < NT; ++t) { const int tk = tok + t * dt; float cv[2];
#pragma unroll
        for (int kh = 0; kh < 2; ++kh) { int sum = 0;
#pragma unroll
            for (int x = 0; x < 4; ++x) sum += pd[t][kh][x];
            const float dot = (float)sum * (4.f * suv[t][kh] * sxv[t]);
            cv[kh] = gv[t][kh] * 0.5f * dot * (1.f + erff(dot * 0.7071067811865476f)) * svv[t][kh]; }
        const float mx = wave_max(fmaxf(fabsf(cv[0]), fabsf(cv[1]))), qs = mx > 0.f ? 127.f / mx : 0.f;
        const float qsum = wave_sum(rintf(cv[0] * qs) + rintf(cv[1] * qs));
        if (tk < T) { CQ[(size_t)tk * NSEL + lane] = (unsigned char)((int)rintf(cv[0] * qs) & 0xff); CQ[(size_t)tk * NSEL + 64 + lane] = (unsigned char)((int)rintf(cv[1] * qs) & 0xff);
            if (lane == 0) { CS[2 * tk] = mx * (1.f / 127.f); CS[2 * tk + 1] = __builtin_bit_cast(float, (int)qsum); } } }
}
__device__ __forceinline__ void expert_v_sweep(LAS unsigned char* wl, int tok0, int step, int tend, int cg, const unsigned short* RI, const unsigned char* CQ, const float* CS, const unsigned char* VB, bf16* FF, int lane) {
    const int g = lane >> 3, c = lane & 7;
    const unsigned char* vs = VB + (size_t)cg * (16384 * 128); const unsigned c16 = 16u * (unsigned)c;
    const bool b3 = (lane & 8) != 0; const int jj = 2 * ((lane >> 5) & 1) + ((lane >> 4) & 1), e0 = 2 * ((lane >> 3) & 1);
    const bool lo32 = lane < 32; const int hi16 = lane >= 48 ? 1 : 0, wq = lo32 ? 512 + 4 * lane : 640 + 4 * hi16;
    const int t0c = tok0 < tend ? tok0 : 0;
#define EV_RAW(tk) do { rid = *(const unsigned*)(RI + (size_t)(tk) * NSEL + 2 * lane); rq = *(lo32 ? (const unsigned*)(CQ + (size_t)(tk) * NSEL + 4 * lane) : (const unsigned*)(CS + 2 * (tk) + hi16)); } while (0)
#define EV_PASS() do { *(LAS v2u*)(wl + 8 * lane) = (v2u){(rid & 0xffffu) << 7, (rid >> 16) << 7}; *(LAS unsigned*)(wl + wq) = rq; \
        _Pragma("unroll") for (int x_ = 0; x_ < 4; ++x_) en[x_] = *(const LAS v4u*)(wl + 64 * g + 16 * x_); \
        cqn = *(const LAS v4u*)(wl + 512 + 16 * g); csn = *(const LAS float*)(wl + 640); scn = *(const LAS int*)(wl + 644); } while (0)
    unsigned rid, rq; v4u en[4]; v4u cqn; float csn; int scn;
    EV_RAW(t0c); EV_PASS();
    { const int t1c = tok0 + step < tend ? tok0 + step : t0c; EV_RAW(t1c); }
#pragma unroll 1
    for (int tok = tok0; tok < tend; tok += step) {
        const v4u cq = cqn; const float cs = csn; const int sc8 = 8 * scn;
        v4u vb[16];
#pragma unroll
        for (int kk = 0; kk < 16; ++kk) vb[kk] = *(const v4u*)(vs + (en[kk >> 2][kk & 3] + c16));
        EV_PASS();
        { const int tn2 = tok + 2 * step < tend ? tok + 2 * step : tok; EV_RAW(tn2); }
#undef EV_RAW
#undef EV_PASS
        int ap[16], al[16];
#pragma unroll
        for (int blk = 0; blk < 4; ++blk) { const int cw = (int)cq[blk];
#pragma unroll
            for (int j = 0; j < 4; ++j) { const unsigned a = vb[4 * blk][j], b = vb[4 * blk + 1][j], cc = vb[4 * blk + 2][j], d = vb[4 * blk + 3][j];
                const unsigned ablo = __builtin_amdgcn_perm(a, b, 0x01050004u), abhi = __builtin_amdgcn_perm(a, b, 0x03070206u), cdlo = __builtin_amdgcn_perm(cc, d, 0x01050004u), cdhi = __builtin_amdgcn_perm(cc, d, 0x03070206u);
                const unsigned t0 = __builtin_amdgcn_perm(cdlo, ablo, 0x05040100u), t1 = __builtin_amdgcn_perm(cdlo, ablo, 0x07060302u), t2 = __builtin_amdgcn_perm(cdhi, abhi, 0x05040100u), t3 = __builtin_amdgcn_perm(cdhi, abhi, 0x07060302u);
#define E2_ACC(A, i, v) do { if (blk == 0) { int d_; asm("v_dot4_i32_i8 %0, %1, %2, 0" : "=v"(d_) : "v"((int)(v)), "v"(cw)); A[i] = d_; } else A[i] = __builtin_amdgcn_sdot4((int)(v), cw, A[i], false); } while (0)
                E2_ACC(ap, 4 * j, t0); E2_ACC(ap, 4 * j + 1, t1); E2_ACC(ap, 4 * j + 2, t2); E2_ACC(ap, 4 * j + 3, t3);
                E2_ACC(al, 4 * j, t0 & 0x0F0F0F0Fu); E2_ACC(al, 4 * j + 1, t1 & 0x0F0F0F0Fu); E2_ACC(al, 4 * j + 2, t2 & 0x0F0F0F0Fu); E2_ACC(al, 4 * j + 3, t3 & 0x0F0F0F0Fu);
#undef E2_ACC
            } }
#define E2_RED(A, R) do { int r8_[8], r4_[4]; \
        _Pragma("unroll") for (int i = 0; i < 8; ++i) { const auto r = __builtin_amdgcn_permlane32_swap((unsigned)A[i], (unsigned)A[i + 8], false, false); unsigned r0 = r[0], r1 = r[1]; asm volatile("" : "+v"(r0), "+v"(r1)); r8_[i] = (int)(r0 + r1); } \
        _Pragma("unroll") for (int i = 0; i < 4; ++i) { const auto r = __builtin_amdgcn_permlane16_swap((unsigned)r8_[i], (unsigned)r8_[i + 4], false, false); unsigned r0 = r[0], r1 = r[1]; asm volatile("" : "+v"(r0), "+v"(r1)); r4_[i] = (int)(r0 + r1); } \
        _Pragma("unroll") for (int i = 0; i < 2; ++i) { const int keep = b3 ? r4_[i + 2] : r4_[i], send = b3 ? r4_[i] : r4_[i + 2]; R[i] = keep + __builtin_amdgcn_update_dpp(0, send, DPP_ROR8, 0xf, 0xf, false); } } while (0)
        int pr[2], lr[2];
        E2_RED(ap, pr); E2_RED(al, lr);
#undef E2_RED
        { const int hp = lane >> 5, jl = 2 * ((lane >> 4) & 1);
          bf16* fo = FF + (size_t)tok * D + 4 * (16 * cg + 2 * c + hp) + e0;
          *(unsigned*)(fo + 256 * jl) = cvtpk((float)(lr[0] - sc8) * cs, (float)(lr[1] - sc8) * cs);
          *(unsigned*)(fo + 256 * (jl + 1)) = cvtpk((float)((pr[0] - lr[0]) >> 4) * cs, (float)((pr[1] - lr[1]) >> 4) * cs); }
    }
}
__device__ __forceinline__ int xcd_row(int x, int j) { return j < 2048 ? 2048 * x + j : TP + 64 * x + (j - 2048); }
template <int NT> __device__ __forceinline__ void ln2_tokens(int xq_, int tok, int dt, const bf16* X1, const bf16* FF, const float* g2, const float* b2, float* outf, bf16* outb, int lane, int nloc = 0, int pbase = 0, int sbase = 0) {
    const int lim = nloc > 0 ? nloc : 2112;
    v2u xw[NT][4], fw[NT][4];
#pragma unroll
    for (int t = 0; t < NT; ++t) { const int jx = tok + t * dt, tk = nloc > 0 ? (jx < 64 ? pbase + jx : sbase + jx - 64) : xcd_row(xq_, jx);
#pragma unroll
        for (int j = 0; j < 4; ++j) { xw[t][j] = (v2u){0u, 0u}; fw[t][j] = (v2u){0u, 0u};
            if (jx < lim) { xw[t][j] = __builtin_nontemporal_load((const v2u*)(X1 + (size_t)tk * D + 256 * j + 4 * lane)); fw[t][j] = __builtin_nontemporal_load((const v2u*)(FF + (size_t)tk * D + 256 * j + 4 * lane)); } } }
    v4f ga[4], ba[4];
#pragma unroll
    for (int j = 0; j < 4; ++j) { ga[j] = *(const v4f*)(g2 + 256 * j + 4 * lane); ba[j] = *(const v4f*)(b2 + 256 * j + 4 * lane); }
#pragma unroll
    for (int t = 0; t < NT; ++t) { const int jx = tok + t * dt, tk = nloc > 0 ? (jx < 64 ? pbase + jx : sbase + jx - 64) : xcd_row(xq_, jx);
        float z[16]; float s = 0.f;
#pragma unroll
        for (int j = 0; j < 4; ++j) { z[4 * j] = ALPHA * bflo(xw[t][j].x) + bflo(fw[t][j].x); z[4 * j + 1] = ALPHA * bfhi(xw[t][j].x) + bfhi(fw[t][j].x); z[4 * j + 2] = ALPHA * bflo(xw[t][j].y) + bflo(fw[t][j].y); z[4 * j + 3] = ALPHA * bfhi(xw[t][j].y) + bfhi(fw[t][j].y);
            s += (z[4 * j] + z[4 * j + 1]) + (z[4 * j + 2] + z[4 * j + 3]); }
        const float mean = wave_sum(s) * (1.f / D); float q = 0.f;
#pragma unroll
        for (int i = 0; i < 16; ++i) { z[i] -= mean; q += z[i] * z[i]; }
        const float rstd = rsqrtf(wave_sum(q) * (1.f / D) + LN_EPS);
        if (jx < lim) {
#pragma unroll
            for (int j = 0; j < 4; ++j) { const int c0c = 256 * j + 4 * lane; v4f o;
#pragma unroll
                for (int e = 0; e < 4; ++e) o[e] = z[4 * j + e] * rstd * ga[j][e] + ba[j][e];
                if (outf) __builtin_nontemporal_store(o, (v4f*)(outf + (size_t)tk * D + c0c));
                if (outb) { v2u w; w.x = cvtpk(o.x, o.y); w.y = cvtpk(o.z, o.w); *(v2u*)(outb + (size_t)tk * D + c0c) = w; } } }
    }
}

#define QUANT_ITEMS(ly, lo, hi, widx, nw) do { for (int qi = (lo) + (widx); qi < (hi); qi += (nw)) { const int tb = qi >> 12, rr = (ly) * 16384 + 4 * (qi & 4095); \
        quant_rows<4>((tb ? ka->in[17] : ka->in[16]) + (size_t)rr * D, (tb ? VB : UB), rr & 16383, (tb ? SV : SU) + rr, 0, lanel, true, true); } } while (0)
__device__ __forceinline__ void xl_barrier(unsigned* xw, unsigned x, unsigned nloc, unsigned round, bool lead) {
    asm volatile("s_waitcnt vmcnt(0)" ::: "memory");
    __syncthreads();
    if (lead) {
        unsigned* sub = xw + 64 * x; unsigned* gen = xw + 1024 + 64 * x;
        const unsigned old = xb_add(sub, 1u), g = round;
        if (old + 1u == (g + 1u) * nloc) xb_add(gen, 1u);
        else { unsigned sp = 0; while (xb_ld(gen) <= g) { __builtin_amdgcn_s_sleep(1); if (++sp > (1u << 22)) break; } }
        __builtin_amdgcn_fence(__ATOMIC_ACQUIRE, "agent");
        asm volatile("s_waitcnt vmcnt(0)" ::: "memory");
    }
    __syncthreads();
}
struct Args { const float* in[20]; float* out; unsigned char* ws; int ph_lo, ph_hi; };
__global__ void __launch_bounds__(NTHR, 2) mk_fwd(Args args) {
    extern __shared__ __attribute__((aligned(16))) unsigned char lds_raw[];
    LAS unsigned char* lds = (LAS unsigned char*)lds_raw;
    volatile LAS unsigned* MISC = (volatile LAS unsigned*)(lds + MISC_OFF);
    const int G = gridDim.x, bx = blockIdx.x, vcu = (G % 8 == 0) ? (bx % 8) * (G / 8) + bx / 8 : bx;
    gu32* ctl = (gu32*)(args.ws + WS_CTL);
    { int t0 = threadIdx.x; asm volatile("" : "+v"(t0)); for (int u = t0; u < (LDS_BYTES - LDSCTL_OFF) / 4; u += NTHR) ((LAS unsigned*)(lds + LDSCTL_OFF))[u] = 0u; }
    __syncthreads();
    const int wid_s = __builtin_amdgcn_readfirstlane(threadIdx.x >> 6);
    XcdBarrier bar; bar.lead = false; bar.bar = (unsigned*)(ctl + CW_BAR); bar.x = 0; bar.st = nullptr;
    if (!MK_PER_PHASE) bar = xcd_barrier_post((unsigned*)(ctl + CW_BAR), MISC + 8);
    const int lo = args.ph_lo, hi = args.ph_hi;
    int cb_ = blockIdx.x;
#define IN(k) (lo <= (k) && (k) < hi)
#define KAS __attribute__((address_space(4)))
#define KTID(var) unsigned mm_##var = ~0u; asm volatile("" : "+s"(mm_##var)); int var = (wid_s << 6) | (int)__builtin_amdgcn_mbcnt_hi(mm_##var, __builtin_amdgcn_mbcnt_lo(mm_##var, 0u))
#define LAUNDER() KTID(tl); asm volatile("" : "+v"(tl)); const KAS Args* ka = (const KAS Args*)__builtin_amdgcn_kernarg_segment_ptr(); asm volatile("" : "+s"(ka)); int bxl = blockIdx.x; asm volatile("" : "+s"(bxl)); (void)bxl; int cbl = cb_; asm volatile("" : "+s"(cbl)); const int xv = cbl & 7, rv = cbl >> 3; (void)xv; (void)rv; \
    const int lanel = tl & 63, wavel = __builtin_amdgcn_readfirstlane(tl >> 6); const int gw = vcu * NWAVES + wavel, NGW = G * NWAVES; const size_t gtid = (size_t)vcu * NTHR + tl, NGT = (size_t)G * NTHR; (void)lanel; (void)wavel; (void)gw; (void)NGW; (void)gtid; (void)NGT; \
    unsigned char* ws = ka->ws; float* out = ka->out; (void)out; \
    float* cosT = (float*)(ws + WS_ROPE); float* sinT = cosT + 2052 * 64; (void)sinT; \
    bf16* WinT = (bf16*)(ws + WS_WIN); bf16* WoutT = (bf16*)(ws + WS_WOUT); bf16* WqT = (bf16*)(ws + WS_WQ); bf16* KEYS = (bf16*)(ws + WS_KEYS); \
    unsigned char* UB = ws + WS_UB; unsigned char* VB = ws + WS_VB; float* SU = (float*)(ws + WS_SU); float* SV = (float*)(ws + WS_SV); (void)SU; (void)SV; bf16* XB = (bf16*)(ws + WS_XB); float* XF = (float*)(ws + WS_XF); \
    bf16* Qb = (bf16*)(ws + WS_Q); bf16* Kb = (bf16*)(ws + WS_K); bf16* Vb = (bf16*)(ws + WS_V); bf16* Gb = (bf16*)(ws + WS_G); bf16* Ub = (bf16*)(ws + WS_U); \
    bf16* KV = (bf16*)(ws + WS_KV); bf16* GT = (bf16*)(ws + WS_GT); (void)GT; unsigned char* XQ = ws + WS_XQ; float* SX = (float*)(ws + WS_SX); float* CC = (float*)(ws + WS_CC); (void)XQ; (void)SX; (void)CC; int* PD = (int*)(ws + WS_PD); bf16* FF = (bf16*)(ws + WS_FF); (void)PD; (void)FF; unsigned char* CQ = ws + WS_CQ; float* CS = (float*)(ws + WS_CS); (void)CQ; (void)CS; bf16* A2 = (bf16*)(ws + WS_A2); float* Z1 = (float*)(ws + WS_Z1); bf16* X1B = (bf16*)(ws + WS_X1B); \
    bf16* QP = (bf16*)(ws + WS_QP); unsigned short* RI = (unsigned short*)(ws + WS_RI); float* RG = (float*)(ws + WS_RG); \
    (void)WinT; (void)WoutT; (void)WqT; (void)KEYS; (void)UB; (void)VB; (void)XB; (void)XF; (void)Qb; (void)Kb; (void)Vb; (void)Gb; (void)Ub; (void)KV; (void)A2; (void)Z1; (void)X1B; (void)QP; (void)RI; (void)RG
#ifndef BARX
#define BARX 1
#endif
#define SEAM(k) do { if (IN(k) && IN((k) + 1)) { KTID(bt_); XcdBarrier bl_ = bar; bl_.lead = (bt_ == 0); asm volatile("" : "+s"(bl_.bar)); for (int bq = 0; bq < BARX; ++bq) xcd_barrier(bl_); } } while (0)
#define SEAM_X(k) do { if (IN(k) && IN((k) + 1)) { if (!xl) { KTID(bt_); XcdBarrier bl_ = bar; bl_.lead = (bt_ == 0); asm volatile("" : "+s"(bl_.bar)); xcd_barrier(bl_); } \
    else { KTID(bt_); unsigned* xw_ = (unsigned*)(ctl + CW_XL); asm volatile("" : "+s"(xw_)); int cq_ = cb_; asm volatile("" : "+s"(cq_)); xl_barrier(xw_, (unsigned)(cq_ & 7), (unsigned)NXW, (unsigned)xl_round, bt_ == 0); ++xl_round; } } } while (0)
    if (IN(0) && EN(0)) {
        LAUNDER(); for (int rep = 0; rep < REP(0); ++rep) {
        LAS float* scr = (LAS float*)(lds + wavel * 16384);
        for (int it = gw; it < 6144; it += NGW) {
            const int l = it / 3072; int r = it % 3072;
            if (r < 1536) { const int kb = r / 96, nb = r % 96; transpose_item(ka->in[4] + (size_t)l * D * INW, D, INW, WinT + (size_t)l * INW * D, kb * 64, nb * 32, inproj_slot(nb * 32), scr, lanel); continue; } r -= 1536;
            if (r < 512) { const int kb = r / 32, nb = r % 32; transpose_item(ka->in[10] + (size_t)l * D * D, D, D, WoutT + (size_t)l * D * D, kb * 64, nb * 32, nb * 32, scr, lanel); continue; } r -= 512;
            { const int kb = r / 64, nb = r % 64; transpose_item(ka->in[13] + (size_t)l * D * 2048, D, 2048, WqT + (size_t)l * 2048 * D, kb * 64, nb * 32, nb * 32, scr, lanel); }
        }
        for (int l = 0; l < NL; ++l) { cvt_flat(ka->in[14] + (size_t)l * 131072, KEYS + (size_t)(l * 2 + 0) * 131072, 131072, gtid, NGT); cvt_flat(ka->in[15] + (size_t)l * 131072, KEYS + (size_t)(l * 2 + 1) * 131072, 131072, gtid, NGT); }
        cvt_flat(ka->in[0], XB, (size_t)TP * D, gtid, NGT);
        cvt_flat(ka->in[1], XB + (size_t)TP * D, (size_t)TS * D, gtid, NGT);
        for (size_t i = gtid; i < 2052 * 64; i += NGT) { const int p = (int)(i >> 6), j = (int)(i & 63); const double pos = (p < 2048) ? (double)p : (double)(16384 + (p - 2048));
            const double ang = pos * INV_FREQ[j]; const double kq = rint(ang * 0.15915494309189535); const double rr = ang - kq * 6.283185307179586;
            const float rf = (float)rr; cosT[i] = __cosf(rf); sinT[i] = __sinf(rf); }
    } }
#define XLW(k) ((unsigned*)(ctl + CW_XL) + 4096 + ((l * 8 + (cbl & 7)) * 64 + (k)) * 16)
#define XLWP(k) (XLW(k) - 8 * 64 * 16)
#define XL_ARRIVE(k) do { asm volatile("s_waitcnt vmcnt(0)" ::: "memory"); __syncthreads(); KTID(ka_); if (ka_ == 0) { unsigned* w_ = XLW(k); asm volatile("" : "+s"(w_)); xb_add(w_, 1u); } } while (0)
#define XL_WAIT(k, n) do { KTID(kw_); if (kw_ == 0) { unsigned* w_ = XLW(k); asm volatile("" : "+s"(w_)); unsigned sp_ = 0; while (xb_ld(w_) < (unsigned)(n)) { __builtin_amdgcn_s_sleep(1); if (++sp_ > (1u << 22)) break; } \
        __builtin_amdgcn_fence(__ATOMIC_ACQUIRE, "agent"); asm volatile("s_waitcnt vmcnt(0)" ::: "memory"); } __syncthreads(); } while (0)
#define XL_WAIT4(k0, k1, k2, k3, n) do { KTID(kw_); if (kw_ == 0) { unsigned* w0_ = XLW(k0); unsigned* w1_ = XLW(k1); unsigned* w2_ = XLW(k2); unsigned* w3_ = XLW(k3); asm volatile("" : "+s"(w0_), "+s"(w1_), "+s"(w2_), "+s"(w3_)); \
        unsigned sp_ = 0; while (xb_ld(w0_) < (unsigned)(n) || xb_ld(w1_) < (unsigned)(n) || xb_ld(w2_) < (unsigned)(n) || xb_ld(w3_) < (unsigned)(n)) { __builtin_amdgcn_s_sleep(1); if (++sp_ > (1u << 22)) break; } \
        __builtin_amdgcn_fence(__ATOMIC_ACQUIRE, "agent"); asm volatile("s_waitcnt vmcnt(0)" ::: "memory"); } __syncthreads(); } while (0)
    SEAM(0);
    const int NXW = G >> 3;
    int xl, xl_round = 0;
    {   KTID(t0_);
        if (t0_ == 0) { unsigned bad = MK_PER_PHASE ? 1u : 0u; const unsigned x = xb_xcc_id(); bad |= (x >= 8u) ? 1u : 0u; unsigned* bw = (unsigned*)(ctl + CW_BAR);
#pragma unroll 1
            for (unsigned j = 0; j < 16; ++j) { const unsigned c = xb_ld(&bw[XB_XCNT(j)]); bad |= (j < 8u) ? (c != (unsigned)NXW ? 1u : 0u) : (c != 0u ? 1u : 0u); }
            const unsigned rk = MISC[10]; bad |= (rk >= (unsigned)NXW) ? 1u : 0u;
#ifdef XL_OFF
            bad = 1u;
#endif
            MISC[16] = bad ? 0u : 1u; MISC[17] = bad ? (unsigned)bx : (x + 8u * rk); }
        __syncthreads();
        xl = __builtin_amdgcn_readfirstlane((int)MISC[16]); cb_ = __builtin_amdgcn_readfirstlane((int)MISC[17]);
        __syncthreads(); }
    const bool tm = xl && NXW == 32;
#pragma unroll 1
    for (int l = 0; l < NL; ++l) {
        const int pb = 1 + PPL * l;
        if (IN(pb) && EN(1)) {
            LAUNDER(); {
            pg8::Gemm g{XB, WinT + (size_t)l * INW * D, TP, INW, D}; OrderM S; S.init(TP, INW, G, cbl, REP(1));
            EpiInProj E{ka->in[5] + l * INW, Qb, Kb, Vb, Gb, Ub, cosT, sinT, out + O_CCP + (size_t)l * 8 * 30 * 512, out + O_CCS + (size_t)l * 128 * 30 * 512};
            if (tm && l > 0 && IN(pb - 1)) { KTID(kw_); if (kw_ == 0) { unsigned* w_ = XLWP((rv & 7) < 7 ? 9 + (rv & 7) : 25); asm volatile("" : "+s"(w_)); unsigned sp_ = 0; while (xb_ld(w_) < 4u) { __builtin_amdgcn_s_sleep(1); if (++sp_ > (1u << 22)) break; }
                    __builtin_amdgcn_fence(__ATOMIC_ACQUIRE, "agent"); asm volatile("s_waitcnt vmcnt(0)" ::: "memory"); } __syncthreads(); }
            pg8::gemm_phase<EpiInProj, OrderM, PG8_ALIGN, PG8_SP2>(lds, g, S, E, tl);
            if (tm && IN(pb + 1)) XL_ARRIVE(48 + (rv & 7));
            if (tm && l > 0 && IN(pb - 1) && rv < 12) { KTID(kw_); if (kw_ == 0) { unsigned* w_ = XLWP(26); asm volatile("" : "+s"(w_)); unsigned sp_ = 0; while (xb_ld(w_) < 4u) { __builtin_amdgcn_s_sleep(1); if (++sp_ > (1u << 22)) break; }
                    __builtin_amdgcn_fence(__ATOMIC_ACQUIRE, "agent"); asm volatile("s_waitcnt vmcnt(0)" ::: "memory"); } __syncthreads(); }
            { const SEpiInProj SE{ka->in[5] + l * INW, Qb, Kb, Vb, Gb, Ub, cosT, sinT, out + O_CCS + (size_t)l * 128 * 30 * 512};
              for (int sr = 0; sr < SGREP; ++sr) for (int u = rv; u < 12; u += NXW) sgemm_unit(lds, XB, WinT + (size_t)l * INW * D, u, TP + 64 * xv, SE, tl);
              if (tm && IN(pb + 1) && rv < 12) XL_ARRIVE(56);
              if (NXW > 12) { if (rv >= 12) QUANT_ITEMS(l, 0, 2272, ((rv - 12) * 8 + xv) * NWAVES + wavel, (NXW - 12) * 8 * NWAVES); }
              else QUANT_ITEMS(l, 0, 2272, gw, NGW); }
        } }
        if (!tm) SEAM_X(pb);
        if (IN(pb + 1) && EN(2)) {
            LAUNDER();
            if (tm && IN(pb)) { const int p_ = rv & 7, g2_ = 2 * (rv >> 2);
                XL_WAIT4(48 + p_, 48 + (p_ > 0 ? p_ - 1 : p_), 48 + (rv < 16 ? g2_ : p_), 48 + (rv < 16 ? g2_ + 1 : p_), 4); }
            for (int rep = 0; rep < REP(2); ++rep) {
            for (int u = rv; u < 16; u += NXW) { kvgroup_unit(lds, 16 * xv + u, Kb, Vb, KV, GT, tl);
                if (xl && IN(pb + 2)) { asm volatile("s_waitcnt vmcnt(0)" ::: "memory"); __syncthreads(); KTID(kt_); if (kt_ == 0) { unsigned* kvw = (unsigned*)(ctl + CW_XL) + 2048 + 64 * (xv + 8 * l); asm volatile("" : "+s"(kvw)); xb_add(kvw, 1u); } } }
            const bool split = (NXW == 32);
            const int u0 = split ? (rv < 16 ? rv : 32 + (rv - 16)) : rv, ust = split ? 16 : NXW, uend = split ? (rv < 16 ? 32 : 80) : 80;
#pragma unroll 1
            for (int st = 0; st < 2; ++st) {
                if (tm ? st == 1 : st == 0) { if (tm && IN(pb)) XL_WAIT(56, 12);
                    for (int u = rv; u < 32; u += NXW) sample_pair_unit(lds, 32 * xv + u, l, Qb, Kb, Vb, Gb, ka->in[2], out + O_SRS, A2, tl); }
                const int qlo = tm ? (st == 0 ? 0 : 2) : 0, qhi = tm ? (st == 0 ? 2 : (rv >= 16 ? 3 : 2)) : (st == 0 ? 0 : 1000);
                for (int q = qlo; q < qhi; ++q) { int u;
                    if (tm) u = q < 2 ? 8 * (rv & 7) + 2 * (rv >> 3) + q : 64 + (rv - 16);
                    else { u = u0 + q * ust; if (u >= uend) break; }
                    if (u < 64) conv_unit<32>(lds, 64 * xv + u, l, Ub, ka->in[3], ka->in[6] + (size_t)l * 31 * 512, ka->in[7] + l * 512, ka->in[8] + l * 512, ka->in[9] + l * 512, A2, tl);
                    else conv_unit<4>(lds, 16 * xv + (u - 64), l, Ub, ka->in[3], ka->in[6] + (size_t)l * 31 * 512, ka->in[7] + l * 512, ka->in[8] + l * 512, ka->in[9] + l * 512, A2, tl); }
                if (tm && st == 0 && rv > 0 && rv < 8 && IN(pb + 4)) XL_ARRIVE(56 + rv); }
        } }
        if (!xl) SEAM_X(pb + 1);
        if (IN(pb + 2) && EN(3)) { LAUNDER();
            if (xl && IN(pb + 1)) { KTID(kt_); if (kt_ == 0) { unsigned* kvw = (unsigned*)(ctl + CW_XL) + 2048 + 64 * (xv + 8 * l); asm volatile("" : "+s"(kvw));
                    unsigned sp = 0; while (xb_ld(kvw) < 16u) { __builtin_amdgcn_s_sleep(1); if (++sp > (1u << 22)) break; }
                    __builtin_amdgcn_fence(__ATOMIC_ACQUIRE, "agent"); asm volatile("s_waitcnt vmcnt(0)" ::: "memory"); }
                __syncthreads(); }
            for (int rep = 0; rep < REP(3); ++rep) { for (int q = 0; ; ++q) { int ui;
                if (tm) { if (q >= 2) break; ui = 4 * (2 * (rv & 7) + (rv >> 4)) + 2 * ((rv >> 3) & 1) + q; }
                else { ui = rv + q * NXW; if (ui >= 64) break; }
                ret_unit(lds, 64 * xv + ui, l, Qb, Kb, Vb, Gb, KV, GT, out + O_SRP, A2, tl); } }
            if (tm && IN(pb + 3)) { asm volatile("s_waitcnt vmcnt(0)" ::: "memory"); __syncthreads(); KTID(ka_); if (ka_ == 0) { unsigned* w_ = XLW(32 + (rv & 7)); asm volatile("" : "+s"(w_)); xb_add(w_, 1u); unsigned* w2_ = XLW(40); asm volatile("" : "+s"(w2_)); xb_add(w2_, 1u); } } }
        if (!tm) SEAM_X(pb + 2);
        if (IN(pb + 3) && EN(4)) {
            LAUNDER(); {
            pg8::Gemm g{A2, WoutT + (size_t)l * D * D, TP, D, D}; OrderM S; S.init(TP, D, G, cbl, REP(4));
            EpiOutProj E{nullptr, XB, X1B};
            if (tm && IN(pb + 2)) XL_WAIT(32 + (rv & 7), 4);
            pg8::gemm_phase<EpiOutProj, OrderM, PG8_ALIGN, PG8_SP2>(lds, g, S, E, tl);
            if (tm && IN(pb + 4)) XL_ARRIVE(rv & 7);
            { const SEpiOutProj SE{nullptr, XB, X1B};
              if (tm && IN(pb + 2) && rv < 4) XL_WAIT(40, 32);
              for (int sr = 0; sr < SGREP; ++sr) for (int u = rv; u < 4; u += NXW) sgemm_unit(lds, A2, WoutT + (size_t)l * D * D, u, TP + 64 * xv, SE, tl);
              if (tm && IN(pb + 4) && rv < 4) XL_ARRIVE(8);
              if (NXW > 4) { if (rv >= 4) QUANT_ITEMS(l, 2272, 5456, ((rv - 4) * 8 + xv) * NWAVES + wavel, (NXW - 4) * 8 * NWAVES); }
              else QUANT_ITEMS(l, 2272, 5456, gw, NGW); }
        } }
        if (!tm) SEAM_X(pb + 3);
        if (IN(pb + 4) && EN(5)) {
            LAUNDER();
            if (tm && IN(pb + 3)) { XL_WAIT(rv & 7, 4); if (rv < 4) XL_WAIT(8, 4); if ((rv & 7) < 7 && IN(pb + 1)) XL_WAIT(57 + (rv & 7), 1); }
            const float* gp = ka->in[11] + l * D; const float* bp = ka->in[12] + l * D;
            constexpr int LR = 3;
            v4f gg[4], bb[4];
#pragma unroll
            for (int j = 0; j < 4; ++j) { gg[j] = *(const v4f*)(gp + lanel * 4 + 256 * j); bb[j] = *(const v4f*)(bp + lanel * 4 + 256 * j); }
            const int pbase = 2048 * xv + 256 * (rv & 7) + 64 * (rv >> 3) + wavel, sbase = TP + 64 * xv + 16 * rv + wavel, jbase = rv * NWAVES + wavel;
            const int nk = tm ? (rv < 4 ? 10 : 8) : (2112 - jbase + 255) / 256;
            auto rowk = [&](int k) -> int { return tm ? (k < 8 ? pbase + 8 * k : sbase + 8 * (k - 8)) : xcd_row(xv, jbase + 256 * k); };
            for (int k0 = 0; k0 < nk; k0 += LR) {
                v2u zw[LR][4];
#pragma unroll
                for (int t = 0; t < LR; ++t) { const int row = rowk((k0 + t < nk) ? k0 + t : k0);
#pragma unroll
                    for (int j = 0; j < 4; ++j) zw[t][j] = *(const v2u*)(X1B + (size_t)row * D + lanel * 4 + 256 * j); }
#pragma unroll
                for (int t = 0; t < LR; ++t) { if (k0 + t < nk) { const int row = rowk(k0 + t);
                    bf16* zr = X1B + (size_t)row * D + lanel * 4; v4f v[4]; float s = 0.f;
#pragma unroll
                    for (int j = 0; j < 4; ++j) { const v2u w = zw[t][j]; v[j] = (v4f){bflo(w.x), bfhi(w.x), bflo(w.y), bfhi(w.y)}; s += (v[j].x + v[j].y) + (v[j].z + v[j].w); }
                    const float mean = wave_sum(s) * (1.f / D); float q = 0.f;
#pragma unroll
                    for (int j = 0; j < 4; ++j) { v[j] = v[j] - mean; q += (v[j].x * v[j].x + v[j].y * v[j].y) + (v[j].z * v[j].z + v[j].w * v[j].w); }
                    const float rstd = rsqrtf(wave_sum(q) * (1.f / D) + LN_EPS);
#pragma unroll
                    for (int j = 0; j < 4; ++j) { const v4f o = v[j] * rstd * gg[j] + bb[j];
                        v2u w; w.x = cvtpk(o.x, o.y); w.y = cvtpk(o.z, o.w); *(v2u*)(zr + 256 * j) = w; v[j] = o; }
                    float mx = 0.f;
#pragma unroll
                    for (int j = 0; j < 4; ++j) mx = fmaxf(mx, fmaxf(fmaxf(fabsf(v[j].x), fabsf(v[j].y)), fmaxf(fabsf(v[j].z), fabsf(v[j].w))));
                    mx = wave_max(mx); const float xs = mx > 0.f ? 127.f / mx : 0.f;
                    v4u xq;
#pragma unroll
                    for (int j = 0; j < 4; ++j) { unsigned w = 0;
#pragma unroll
                        for (int e = 0; e < 4; ++e) w |= ((unsigned)((int)rintf(v[j][e] * xs)) & 0xffu) << (8 * e);
                        xq[j] = w; }
                    *(v4u*)(XQ + (size_t)row * D + 16 * lanel) = xq; if (lanel == 0) SX[row] = mx * (1.f / 127.f);
                } }
            }
            if (tm && IN(pb + 5)) { XL_ARRIVE(16 + (rv & 7)); if (rv < 4) XL_ARRIVE(24); }
        }
        if (!tm) SEAM_X(pb + 4);
        if (IN(pb + 5) && EN(6)) {
            LAUNDER(); {
            pg8::Gemm g{X1B, WqT + (size_t)l * 2048 * D, TP, 2048, D}; OrderM S; S.init(TP, 2048, G, cbl, REP(6));
            pg8::EpiBf16<0> E{QP, 2048, nullptr, 0, 0, 1.f};
            if (tm && IN(pb + 4)) XL_WAIT(16 + (rv & 7), 4);
            pg8::gemm_phase<pg8::EpiBf16<0>, OrderM, PG8_ALIGN, PG8_SP2>(lds, g, S, E, tl);
            if (tm && IN(pb + 6)) XL_ARRIVE((rv & 7) < 7 ? 41 + (rv & 7) : 27);
            if (tm && IN(pb + 4) && rv < 8) XL_WAIT(24, 4);
            { const SEpiQ SE{QP};
              for (int sr = 0; sr < SGREP; ++sr) for (int u = rv; u < 8; u += NXW) sgemm_unit(lds, X1B, WqT + (size_t)l * 2048 * D, u, TP + 64 * xv, SE, tl);
              const bool idle = (NXW > 8);
              if (idle) { if (rv >= 8) QUANT_ITEMS(l, 5456, 8192, ((rv - 8) * 8 + xv) * NWAVES + wavel, (NXW - 8) * 8 * NWAVES); }
              else QUANT_ITEMS(l, 5456, 8192, gw, NGW);
              if (l == 0) { const size_t i0 = idle ? (rv >= 8 ? (size_t)((rv - 8) * 8 + xv) * NTHR + tl : (size_t)-1) : gtid, istep = idle ? (size_t)(NXW - 8) * 8 * NTHR : NGT;
                  if (i0 != (size_t)-1) for (size_t i = i0; i < (size_t)NL * 128 * 26 * 128; i += istep) {
                      const size_t c4 = i & 127, rr = (i >> 7) % 26, lb = (i >> 7) / 26;
                      __builtin_nontemporal_store(__builtin_nontemporal_load((const v4f*)(ka->in[3] + (lb * 30 + rr + 4) * 512 + c4 * 4)), (v4f*)(out + O_CCS + (lb * 30 + rr) * 512 + c4 * 4)); } } }
        } }
        if (IN(pb + 5) && IN(pb + 6) && EN(7)) { LAUNDER(); route_stage_keys(lds, rv & 7, l, KEYS, tl); }
        if (!tm) SEAM_X(pb + 5);
        else if (IN(pb + 5) && IN(pb + 6)) { LAUNDER(); const int s1_ = rv >> 4;
            asm volatile("s_waitcnt vmcnt(0)" ::: "memory"); __syncthreads();
            XL_WAIT4(41 + s1_, 41 + s1_ + 2, 41 + s1_ + 4, (s1_ + 6) < 7 ? 41 + s1_ + 6 : 27, 4); }
        if (IN(pb + 6) && EN(7)) { LAUNDER(); for (int rep = 0; rep < REP(7); ++rep) { { const int head = rv & 7, slot = rv >> 3, nslot = NXW >> 3; if (!IN(pb + 5)) route_stage_keys(lds, head, l, KEYS, tl);
            const int nun = (16 - slot + nslot - 1) / nslot + (slot == 0 ? 1 : 0), npr = (16 - slot + nslot - 1) / nslot;
            v4u qa[4], qb[4];
            { const int t0 = npr > 0 ? (16 * xv + slot) * 128 : TP + 64 * xv; tile_load(qa, QP, (size_t)t0, head * 256, tl, 2048); tile_load(qb, QP, (size_t)t0, head * 256 + 128, tl, 2048); }
#pragma unroll 1
            for (int u = 0; u < nun; ++u) { const int t0 = u < npr ? (16 * xv + slot + u * nslot) * 128 : TP + 64 * xv, nt = u < npr ? 128 : 64;
                const int un = u + 1, tn = un < nun ? (un < npr ? (16 * xv + slot + un * nslot) * 128 : TP + 64 * xv) : -1;
                route_unit(lds, head, t0, nt, tn, qa, qb, QP, RI, RG, tl); } } } }
        SEAM(pb + 6);
        if (IN(pb + 7) && EN(8)) {
            LAUNDER(); for (int rep = 0; rep < REP(8); ++rep) {
            const SliceMap sm = slice_map((unsigned*)((gu32*)(ws + WS_CTL) + CW_BAR), MISC, G, bxl, tl);
            const unsigned char* ub = UB;
            { const int th = sm.vx >> 2; expert_u_sweep(lds + wavel * 1024, th * (T / 2) + sm.rank * NWAVES + wavel, sm.cnt * NWAVES, (th + 1) * (T / 2), sm.vx & 3, XQ, RI, ub, PD, lanel); }
        } }
        SEAM(pb + 7);
        if (IN(pb + 8) && EN(9)) {
            LAUNDER(); for (int rep = 0; rep < REP(9); ++rep) {
            for (int tok = gw; tok < T; tok += 3 * NGW) expert_coefs<3>(tok, NGW, PD, SX, RI, RG, SU + l * 16384, SV + l * 16384, CQ, CS, lanel);
        } }
        SEAM(pb + 8);
        if (IN(pb + 9) && EN(10)) {
            LAUNDER(); for (int rep = 0; rep < REP(10); ++rep) {
            const SliceMap sm = slice_map((unsigned*)((gu32*)(ws + WS_CTL) + CW_BAR), MISC, G, bxl, tl);
            const unsigned char* vb = VB;
            { const int th = sm.vx >> 2; expert_v_sweep(lds + wavel * 1024, th * (T / 2) + sm.rank * NWAVES + wavel, sm.cnt * NWAVES, (th + 1) * (T / 2), sm.vx & 3, RI, CQ, CS, vb, FF, lanel); }
        } }
        SEAM(pb + 9);
        if (IN(pb + 10) && EN(11)) {
            LAUNDER(); for (int rep = 0; rep < REP(11); ++rep) {
            float* of = (l == NL - 1) ? out + O_YP : nullptr; bf16* ob = (l == NL - 1) ? nullptr : XB;
            const int xwv = NXW * NWAVES;
            const int nloc = tm ? 64 + (rv < 4 ? 16 : 0) : 0, j00 = tm ? wavel : rv * NWAVES + wavel, jst = tm ? NWAVES : xwv, jlim = tm ? nloc : 2112;
            for (int j0 = j00; j0 < jlim; j0 += 3 * jst) ln2_tokens<3>(xv, j0, jst, X1B, FF, ka->in[18] + l * D, ka->in[19] + l * D, of, ob, lanel, nloc, 2048 * xv + 256 * (rv & 7) + 64 * (rv >> 3), TP + 64 * xv + 16 * rv);
            if (tm && l + 1 < NL && IN(pb + 11)) { XL_ARRIVE((rv & 7) < 7 ? 9 + (rv & 7) : 25); if (rv < 4) XL_ARRIVE(26); }
        } }
        if (l + 1 < NL && !tm) SEAM_X(pb + 10);
    }
#undef IN
#undef SEAM
#undef SEAM_X
#undef LAUNDER
}

extern "C" void kernel_launch(void* const* d_in, const int* in_sizes, int n_in, void* d_out, int out_size, void* d_ws, size_t ws_size, hipStream_t stream) {
    static int grid = 0;
    if (grid == 0) {
        if (n_in != 20 || out_size != (int)O_END || ws_size < WS_END) { fprintf(stderr, "kernel_launch: unexpected shapes: n_in %d out %d ws %zu\n", n_in, out_size, ws_size); grid = -1; return; }
        int dev = 0, cus = 0, per_cu = 0;
        if (hipGetDevice(&dev) != hipSuccess || hipDeviceGetAttribute(&cus, hipDeviceAttributeMultiprocessorCount, dev) != hipSuccess) { grid = -1; return; }
        if (hipFuncSetAttribute((const void*)mk_fwd, hipFuncAttributeMaxDynamicSharedMemorySize, LDS_BYTES) != hipSuccess) { fprintf(stderr, "kernel_launch: hipFuncSetAttribute failed\n"); grid = -1; return; }
        if (hipOccupancyMaxActiveBlocksPerMultiprocessor(&per_cu, (const void*)mk_fwd, NTHR, LDS_BYTES) != hipSuccess || per_cu < 1) { fprintf(stderr, "kernel_launch: occupancy query says %d blocks per CU\n", per_cu); (void)hipGetLastError(); grid = -1; return; }
        grid = cus - (cus % 64);
        if (grid < 64) { fprintf(stderr, "kernel_launch: needs at least 64 CUs, found %d\n", cus); grid = -1; return; }
    }
    if (grid < 0) return;
    (void)hipMemsetAsync((char*)d_ws + WS_CTL, 0, CTL_ZERO_BYTES, stream);
    Args a{};
    for (int i = 0; i < 20; ++i) a.in[i] = (const float*)d_in[i];
    a.out = (float*)d_out; a.ws = (unsigned char*)d_ws;
#if MK_PER_PHASE
    for (int p = 0; p < N_PHASES; ++p) { a.ph_lo = p; a.ph_hi = p + 1; hipLaunchKernelGGL(mk_fwd, dim3(grid), dim3(NTHR), LDS_BYTES, stream, a); }
#else
    a.ph_lo = 0; a.ph_hi = N_PHASES; hipLaunchKernelGGL(mk_fwd, dim3(grid), dim3(NTHR), LDS_BYTES, stream, a);
#endif
}
```
